# Optimizing an MI355X kernel written in HIP

```python
import jax, jax.numpy as jnp
from jax import lax
import numpy as np

D_MODEL = 1024
BATCH = 16
SEQ = 4096
DEPTH = 4

N_MIXERS = 2
N_A_LAYERS = (DEPTH + 1) // 2
N_B_LAYERS = DEPTH // 2

ML_HEADS = 8
ML_DV = D_MODEL // ML_HEADS
ML_DQK = ML_DV // 2
ML_CHUNK = 64
ML_QK_W = ML_HEADS * ML_DQK
ML_V_W = ML_HEADS * ML_DV
ML_PROJ = 2 * ML_QK_W + 2 * ML_V_W + 2 * ML_HEADS

LRU_WIDTH = D_MODEL
LRU_HEADS = 4
LRU_BW = LRU_WIDTH // LRU_HEADS
CONV_W = 4
LRU_C = 8.0

D_FF = 3584
N_EXPERTS = 8
TOP_K = 2
RMS_EPS = 1e-6

kernel_name = 'hybrid_mlstm_rglru_moe_adaln'


def rms_norm(x, g):
    x32 = x.astype(jnp.float32)
    y = x32 * lax.rsqrt(jnp.mean(jnp.square(x32), axis=-1, keepdims=True) + RMS_EPS)
    return (y * g.astype(jnp.float32)).astype(x.dtype)


def modulate(h, shift, scale):
    return h * (1 + scale[:, None, :]) + shift[:, None, :]


def swiglu(h, w13, w2):
    a, b = jnp.split(h @ w13, 2, axis=-1)
    return (jax.nn.silu(a) * b) @ w2


def mlstm_chunk_step(carry, xs):
    C, n, m = carry
    q, k, v, i_pre, log_f = xs
    L = q.shape[2]
    b = jnp.cumsum(log_f, axis=-1)
    g = b[..., -1]
    causal = jnp.tril(jnp.ones((L, L), dtype=bool))
    d = jnp.where(causal, b[..., :, None] - b[..., None, :] + i_pre[..., None, :], -jnp.inf)
    inter = b + m[..., None]
    m_t = jnp.maximum(inter, jnp.max(d, axis=-1))
    w = jnp.exp(d - m_t[..., None])
    s = jnp.einsum('bhtd,bhsd->bhts', q, k) * w
    e_inter = jnp.exp(inter - m_t)
    num = jnp.einsum('bhts,bhsv->bhtv', s, v) + e_inter[..., None] * jnp.einsum('bhtd,bhdv->bhtv', q, C)
    den = jnp.sum(s, axis=-1) + e_inter * jnp.einsum('bhtd,bhd->bht', q, n)
    h = num / jnp.maximum(jnp.abs(den), jnp.exp(-m_t))[..., None]
    log_w_s = g[..., None] - b + i_pre
    m_new = jnp.maximum(g + m, jnp.max(log_w_s, axis=-1))
    w_s = jnp.exp(log_w_s - m_new[..., None])
    decay = jnp.exp(g + m - m_new)
    C_new = decay[..., None, None] * C + jnp.einsum('bhsd,bhsv->bhdv', k * w_s[..., None], v)
    n_new = decay[..., None] * n + jnp.einsum('bhs,bhsd->bhd', w_s, k)
    return (C_new, n_new, m_new), h


def mlstm_mixer(h, w_in, gate_b, head_g, w_out):
    B, S, _ = h.shape
    nc = S // ML_CHUNK
    f32 = jnp.float32
    q, k, v, o, gts = jnp.split(h @ w_in, [ML_QK_W, 2 * ML_QK_W, 2 * ML_QK_W + ML_V_W, 2 * ML_QK_W + 2 * ML_V_W], axis=-1)
    gts = gts.astype(f32) + gate_b.astype(f32)
    i_pre, f_pre = jnp.split(gts, 2, axis=-1)

    def to_chunks(t, dim):
        return t.astype(f32).reshape(B, nc, ML_CHUNK, ML_HEADS, dim).transpose(1, 0, 3, 2, 4)

    def gate_chunks(t):
        return t.reshape(B, nc, ML_CHUNK, ML_HEADS).transpose(1, 0, 3, 2)

    xs = (to_chunks(q, ML_DQK) * (ML_DQK ** -0.5), to_chunks(k, ML_DQK), to_chunks(v, ML_DV),
          gate_chunks(i_pre), gate_chunks(jax.nn.log_sigmoid(f_pre)))
    init = (jnp.zeros((B, ML_HEADS, ML_DQK, ML_DV), f32),
            jnp.zeros((B, ML_HEADS, ML_DQK), f32),
            jnp.zeros((B, ML_HEADS), f32))
    _, hs = lax.scan(mlstm_chunk_step, init, xs)
    hs = hs.transpose(1, 0, 3, 2, 4).reshape(B, S, ML_HEADS, ML_DV)
    hs = rms_norm(hs, head_g.reshape(ML_HEADS, ML_DV))
    hs = hs.reshape(B, S, ML_V_W) * jax.nn.sigmoid(o.astype(f32))
    return hs.astype(h.dtype) @ w_out


def lru_combine(left, right):
    a_l, b_l = left
    a_r, b_r = right
    return (a_l * a_r, a_r * b_l + b_r)


def rglru_mixer(h, w_in, conv_w, conv_b, gate_w, gate_b, a_param, w_out):
    B, S, _ = h.shape
    f32 = jnp.float32
    gate_branch, xr = jnp.split(h @ w_in, 2, axis=-1)
    xpad = jnp.pad(xr, ((0, 0), (CONV_W - 1, 0), (0, 0)))
    xc = conv_b + xpad[:, 0:S, :] * conv_w[0]
    for j in range(1, CONV_W):
        xc = xc + xpad[:, j:j + S, :] * conv_w[j]
    xb = xc.reshape(B, S, LRU_HEADS, LRU_BW)
    gts = jnp.einsum('bshi,hio->bsho', xb, gate_w) + gate_b
    gx, ga = jnp.split(gts.astype(f32), 2, axis=-1)
    gx = jax.nn.sigmoid(gx.reshape(B, S, LRU_WIDTH))
    ga = jax.nn.sigmoid(ga.reshape(B, S, LRU_WIDTH))
    log_a = -LRU_C * ga * jax.nn.softplus(-a_param.astype(f32))
    a = jnp.exp(log_a)
    u = xc.astype(f32) * gx * jnp.sqrt(-jnp.expm1(2.0 * log_a))
    _, hseq = lax.associative_scan(lru_combine, (a, u), axis=1)
    y = hseq * jax.nn.gelu(gate_branch.astype(f32))
    return y.astype(h.dtype) @ w_out


def moe_swiglu(h, router_w, router_b, w13, w2):
    logits = (h @ router_w).astype(jnp.float32) + router_b.astype(jnp.float32)
    top_v, top_i = lax.top_k(logits, TOP_K)
    top_w = jax.nn.softmax(top_v, axis=-1)
    combine = jnp.einsum('bsk,bske->bse', top_w, jax.nn.one_hot(top_i, N_EXPERTS, dtype=jnp.float32)).astype(h.dtype)
    y = jnp.zeros_like(h)
    for e in range(N_EXPERTS):
        y = y + combine[..., e:e + 1] * swiglu(h, w13[e], w2[e])
    return y


def setup_inputs(seed: int = 0) -> dict:
    key = jax.random.key(seed)
    ks = jax.random.split(key, 24)
    f32 = jnp.float32

    def nrm(k, shape, s):
        return jax.random.normal(k, shape, f32) * s

    D = D_MODEL
    x = nrm(ks[0], (BATCH, SEQ, D), 1.0)
    c = nrm(ks[1], (BATCH, D), 1.0)
    ada_w = nrm(ks[2], (DEPTH, D, 6 * D), 0.02)
    ada_b = nrm(ks[3], (DEPTH, 6 * D), 0.02)
    norm_g = 1.0 + nrm(ks[4], (DEPTH, 2, D), 0.02)
    ml_w_in = nrm(ks[5], (N_A_LAYERS, D, ML_PROJ), D ** -0.5)
    i_b = nrm(ks[6], (N_A_LAYERS, ML_HEADS), 0.1)
    f_b = jnp.linspace(3.0, 6.0, ML_HEADS, dtype=f32) + nrm(ks[7], (N_A_LAYERS, ML_HEADS), 0.1)
    ml_gate_b = jnp.concatenate([i_b, f_b], axis=-1)
    ml_head_g = 1.0 + nrm(ks[8], (N_A_LAYERS, ML_V_W), 0.02)
    ml_w_out = nrm(ks[9], (N_A_LAYERS, ML_V_W, D), ML_V_W ** -0.5)
    ffn_w13 = nrm(ks[10], (N_A_LAYERS, D, 2 * D_FF), D ** -0.5)
    ffn_w2 = nrm(ks[11], (N_A_LAYERS, D_FF, D), D_FF ** -0.5)
    lru_w_in = nrm(ks[12], (N_B_LAYERS, D, 2 * LRU_WIDTH), D ** -0.5)
    lru_conv_w = nrm(ks[13], (N_B_LAYERS, CONV_W, LRU_WIDTH), CONV_W ** -0.5)
    lru_conv_b = nrm(ks[14], (N_B_LAYERS, LRU_WIDTH), 0.02)
    lru_gate_w = nrm(ks[15], (N_B_LAYERS, LRU_HEADS, LRU_BW, 2 * LRU_BW), LRU_BW ** -0.5)
    lru_gate_b = nrm(ks[16], (N_B_LAYERS, LRU_HEADS, 2 * LRU_BW), 0.02)
    a0 = jax.random.uniform(ks[17], (N_B_LAYERS, LRU_WIDTH), f32, 0.9, 0.999)
    p = a0 ** (1.0 / LRU_C)
    lru_a_param = jnp.log(p) - jnp.log1p(-p)
    lru_w_out = nrm(ks[18], (N_B_LAYERS, LRU_WIDTH, D), LRU_WIDTH ** -0.5)
    moe_router_w = nrm(ks[19], (N_B_LAYERS, D, N_EXPERTS), D ** -0.5)
    moe_router_b = nrm(ks[20], (N_B_LAYERS, N_EXPERTS), 0.01)
    moe_w13 = nrm(ks[21], (N_B_LAYERS, N_EXPERTS, D, 2 * D_FF), D ** -0.5)
    moe_w2 = nrm(ks[22], (N_B_LAYERS, N_EXPERTS, D_FF, D), D_FF ** -0.5)
    final_norm_g = 1.0 + nrm(ks[23], (D,), 0.02)
    return {'x': x, 'c': c, 'ada_w': ada_w, 'ada_b': ada_b, 'norm_g': norm_g,
            'ml_w_in': ml_w_in, 'ml_gate_b': ml_gate_b, 'ml_head_g': ml_head_g, 'ml_w_out': ml_w_out,
            'ffn_w13': ffn_w13, 'ffn_w2': ffn_w2,
            'lru_w_in': lru_w_in, 'lru_conv_w': lru_conv_w, 'lru_conv_b': lru_conv_b,
            'lru_gate_w': lru_gate_w, 'lru_gate_b': lru_gate_b, 'lru_a_param': lru_a_param, 'lru_w_out': lru_w_out,
            'moe_router_w': moe_router_w, 'moe_router_b': moe_router_b, 'moe_w13': moe_w13, 'moe_w2': moe_w2,
            'final_norm_g': final_norm_g}


def reference(x, c, ada_w, ada_b, norm_g, ml_w_in, ml_gate_b, ml_head_g, ml_w_out, ffn_w13, ffn_w2,
              lru_w_in, lru_conv_w, lru_conv_b, lru_gate_w, lru_gate_b, lru_a_param, lru_w_out,
              moe_router_w, moe_router_b, moe_w13, moe_w2, final_norm_g):
    c_act = jax.nn.silu(c)
    for i in range(DEPTH):
        mod = c_act @ ada_w[i] + ada_b[i]
        sh1, sc1, g1, sh2, sc2, g2 = jnp.split(mod, 6, axis=-1)
        j = i // N_MIXERS
        h = modulate(rms_norm(x, norm_g[i, 0]), sh1, sc1)
        if i % N_MIXERS == 0:
            mix = mlstm_mixer(h, ml_w_in[j], ml_gate_b[j], ml_head_g[j], ml_w_out[j])
        else:
            mix = rglru_mixer(h, lru_w_in[j], lru_conv_w[j], lru_conv_b[j], lru_gate_w[j],
                              lru_gate_b[j], lru_a_param[j], lru_w_out[j])
        x = x + g1[:, None, :] * mix
        h = modulate(rms_norm(x, norm_g[i, 1]), sh2, sc2)
        if i % 2 == 0:
            ffn = swiglu(h, ffn_w13[j], ffn_w2[j])
        else:
            ffn = moe_swiglu(h, moe_router_w[j], moe_router_b[j], moe_w13[j], moe_w2[j])
        x = x + g2[:, None, :] * ffn
    return rms_norm(x, final_norm_g)
```

```cpp
#include <hip/hip_runtime.h>
#include <cstdio>
#include <cstdint>

#ifndef DENSE_FP8_MASK
#define DENSE_FP8_MASK 3
#endif
#define MASK_AT(M, jl) ((M) == 3 ? 1 : (M) == 0 ? 0 : (((M) >> (jl)) & 1))
#define DENSE_FP8_AT(jl) MASK_AT(DENSE_FP8_MASK, jl)
#ifndef DENSE_UP_FP8_MASK
#define DENSE_UP_FP8_MASK 2
#endif
#define DENSE_UP_FP8_AT(jl) MASK_AT(DENSE_UP_FP8_MASK, jl)
#ifndef MK_PER_PHASE
#define MK_PER_PHASE 0
#endif

#define DI __device__ __forceinline__
#define GAS __attribute__((address_space(1)))
#define LAS __attribute__((address_space(3)))
typedef unsigned short bf16_t;
typedef short bf16x8 __attribute__((ext_vector_type(8)));
typedef float f32x4 __attribute__((ext_vector_type(4)));
typedef float f32x2 __attribute__((ext_vector_type(2)));
typedef unsigned u32x4 __attribute__((ext_vector_type(4)));
typedef unsigned u32x2 __attribute__((ext_vector_type(2)));
typedef int i32x2 __attribute__((ext_vector_type(2)));

constexpr int D = 1024, BATCH = 16, SEQ = 4096, T = BATCH * SEQ;
constexpr int ML_H = 8, DV = 128, DQK = 64, CHK = 64, MLP = 3088, MLPP = 3328;
constexpr int DFF = 3584, NE = 8;
constexpr int MAXSLOT = 2 * T + 8 * 256;
constexpr float RMS_EPS = 1e-6f;
constexpr int NWAVES = 8, NTHR = 512;

enum { I_X = 0, I_C, I_ADAW, I_ADAB, I_NORMG, I_MLWIN, I_MLGB, I_MLHG, I_MLWOUT, I_FW13, I_FW2, I_LWIN, I_LCW, I_LCB, I_LGW, I_LGB, I_LAP, I_LWOUT, I_RW, I_RB, I_MW13, I_MW2, I_FNG, N_IN };

constexpr size_t MiB = 1u << 20;
constexpr size_t WS_CTL = 0, CTL_ZERO_BYTES = 1 * MiB;
constexpr size_t WS_MOD = 1 * MiB;
constexpr size_t WS_MODP = 3 * MiB;
constexpr size_t WS_SP = 15 * MiB;
constexpr size_t WS_CA1 = 15 * MiB + 64 * 1024;
constexpr size_t WS_GATES = 16 * MiB;
constexpr size_t WS_BIASP = 20 * MiB;
constexpr size_t WS_TOPE = 22 * MiB;
constexpr size_t WS_TOPW = 22 * MiB + 512 * 1024;
constexpr size_t WS_HIST = 23 * MiB;
constexpr size_t WS_SLOTTOK = 23 * MiB + 256 * 1024;
constexpr size_t WS_TOKSLOT = 24 * MiB;
constexpr size_t WS_W = 32 * MiB;
constexpr size_t WS_HN = 448 * MiB;
constexpr size_t WS_R = 576 * MiB;
constexpr size_t WS_END = WS_R + 1170 * MiB;
constexpr size_t W_WIN = 0, W_WOUT = W_WIN + (size_t)MLPP * D, W_W13 = W_WOUT + (size_t)D * D, W_W2 = W_W13 + (size_t)2 * DFF * D, W_LIN = W_W2 + (size_t)D * DFF,
                 W_GW = W_LIN + (size_t)2 * D * D, W_LOUT = W_GW + (size_t)4 * 512 * 256, W_MW13 = W_LOUT + (size_t)D * D, W_MW2 = W_MW13 + (size_t)NE * 2 * DFF * D, W_PER_J = W_MW2 + (size_t)NE * D * DFF;
static_assert(WS_W + 2 * W_PER_J * 2 <= WS_HN, "weights fit");
constexpr size_t R_Q = 0, R_K = 64 * MiB, R_V = 128 * MiB, R_O = 256 * MiB, R_HS = 384 * MiB;
constexpr size_t R_ACT = 0;
constexpr size_t R_GB = 0, R_XR = 128 * MiB, R_XC = 256 * MiB, R_LA = 384 * MiB, R_U = 512 * MiB;
constexpr size_t R_M1 = 512 * MiB;
constexpr size_t R_XSB = 640 * MiB;
constexpr size_t R_YS = 910 * MiB;
static_assert((size_t)MAXSLOT * DFF * 2 == 910 * MiB, "moe act size");
constexpr int CW_BAR = 4096, CW_META = 8192;

constexpr int LDS_BYTES = 147456, MISC_OFF = 147200;

DI float bf2f(unsigned short b) { return __uint_as_float(((unsigned)b) << 16); }
DI float bflo(unsigned u) { return __uint_as_float(u << 16); }
DI float bfhi(unsigned u) { return __uint_as_float(u & 0xffff0000u); }
DI unsigned f2bf(float f) { unsigned u = __float_as_uint(f); return (u + 0x7fffu + ((u >> 16) & 1u)) >> 16; }
DI unsigned pk2(float lo, float hi) { return f2bf(lo) | (f2bf(hi) << 16); }
DI float sigmoid_f(float x) { return __builtin_amdgcn_rcpf(1.f + __expf(-x)); }
DI float log1p_exp_neg(float x) {
    float ln2 = 0.69314718f; asm volatile("" : "+s"(ln2));
    const float e = __expf(-x), u = 1.f + e, d = u - 1.f;
    return d == 0.f ? e : ln2 * __builtin_amdgcn_logf(u) * (e / d);
}
DI float wave_sum(float v) {
#pragma unroll
    for (int o = 1; o < 64; o <<= 1) v += __shfl_xor(v, o);
    return v;
}
DI int wave_sum_i(int v) {
#pragma unroll
    for (int o = 1; o < 64; o <<= 1) v += __shfl_xor(v, o);
    return v;
}
#define LDS_WAIT() asm volatile("s_waitcnt lgkmcnt(0)" ::: "memory")

#define XB_TMO      128
#define XB_XCNT(j)  (256  + 64 * (j))
#define XB_XSUB(j)  (1280 + 64 * (j))
#define XB_XGEN(j)  (2304 + 64 * (j))
#define XB_TOP      3328
#define XB_TOPGEN   3392
#define XCD_BAR_WORDS 3456
#define XB_SPIN_CAP (1u << 19)
DI unsigned xb_ld(unsigned* p)              { return __hip_atomic_load(p, __ATOMIC_RELAXED, __HIP_MEMORY_SCOPE_AGENT); }
DI unsigned xb_add(unsigned* p, unsigned v) { return __hip_atomic_fetch_add(p, v, __ATOMIC_RELAXED, __HIP_MEMORY_SCOPE_AGENT); }
DI unsigned xb_xcc_id() { return (unsigned)__builtin_amdgcn_s_getreg((3 << 11) | 20) & 0xFu; }
#define XB_SPIN(cond, bar) do { unsigned _sp = 0; while (cond) { __builtin_amdgcn_s_sleep(1); \
    if ((++_sp & 255u) == 0u) { if (xb_ld(&(bar)[XB_TMO])) break; if (_sp > XB_SPIN_CAP) { atomicAdd(&(bar)[XB_TMO], 1u); break; } } } } while (0)
struct XcdBarrier { unsigned* bar; unsigned x; volatile LAS unsigned* st; };
DI XcdBarrier xcd_barrier_post(unsigned* bar, volatile LAS unsigned* st) {
    XcdBarrier b; b.bar = bar; b.x = xb_xcc_id(); b.st = st;
    if (threadIdx.x == 0) (void)xb_add(&bar[XB_XCNT(b.x)], 1u);
    return b;
}
DI void xcd_barrier_complete(unsigned* bar, unsigned x, unsigned& nloc, unsigned& nx) {
    const unsigned G = gridDim.x * gridDim.y * gridDim.z;
    unsigned sum, cnt, mine, sp = 0u;
    for (;;) {
        sum = 0u; cnt = 0u; mine = 0u;
#pragma unroll
        for (unsigned j = 0; j < 16; ++j) { const unsigned c = xb_ld(&bar[XB_XCNT(j)]); sum += c; cnt += (c > 0u) ? 1u : 0u; mine = (j == x) ? c : mine; }
        if (sum == G) break;
        __builtin_amdgcn_s_sleep(1);
        if ((++sp & 255u) == 0u) { if (xb_ld(&bar[XB_TMO])) break; if (sp > XB_SPIN_CAP) { atomicAdd(&bar[XB_TMO], 1u); break; } }
    }
    nloc = mine > 0u ? mine : 1u; nx = cnt > 0u ? cnt : 1u;
}
DI void xcd_barrier(const XcdBarrier& b) {
    asm volatile("s_waitcnt vmcnt(0)" ::: "memory");
    __syncthreads();
    if (threadIdx.x == 0) {
        unsigned* bar = b.bar;
        __builtin_amdgcn_s_waitcnt(0);
        unsigned nloc = b.st[0], nx = b.st[1];
        if (nloc == 0u) { xcd_barrier_complete(bar, b.x, nloc, nx); b.st[0] = nloc; b.st[1] = nx; }
        const unsigned old = xb_add(&bar[XB_XSUB(b.x)], 1u);
        const unsigned gen = old / nloc;
        if (old + 1u == (gen + 1u) * nloc) {
            __builtin_amdgcn_fence(__ATOMIC_RELEASE, "agent");
            asm volatile("s_waitcnt vmcnt(0)" ::: "memory");
            const unsigned og = xb_add(&bar[XB_TOP], 1u);
            const unsigned tg = og / nx;
            if (og + 1u == (tg + 1u) * nx) xb_add(&bar[XB_TOPGEN], 1u);
            else XB_SPIN(xb_ld(&bar[XB_TOPGEN]) == tg, bar);
            __builtin_amdgcn_fence(__ATOMIC_ACQUIRE, "agent");
            xb_add(&bar[XB_XGEN(b.x)], 1u);
            asm volatile("s_waitcnt vmcnt(0)" ::: "memory");
        } else {
            XB_SPIN(xb_ld(&bar[XB_XGEN(b.x)]) == gen, bar);
            __builtin_amdgcn_fence(__ATOMIC_ACQUIRE, "agent");
            asm volatile("s_waitcnt vmcnt(0)" ::: "memory");
        }
    }
    __syncthreads();
}

namespace pg8 {
constexpr int BM = 256, BK = 64, HALF = 128, HTB = HALF * BK * 2, STAGE_BYTES = 8 * HTB, NXCD = 8, WGM = 8;
__host__ __device__ __forceinline__ int lds_byte(int r, int c) { const int st = (r >> 4) * 2 + (c >> 5), rr = r & 15, cc = c & 31, ob = rr * 64 + cc * 2; return st * 1024 + (ob ^ (((ob >> 9) & 1) << 5)); }
__host__ __device__ __forceinline__ void stage_rc(int b, int& R, int& C) { const int st = b / 1024, sb = b % 1024, swz = sb ^ (((sb >> 9) & 1) << 5); R = (st >> 1) * 16 + swz / 64; C = (st & 1) * 32 + (swz % 64) / 2; }
__host__ __device__ __forceinline__ int perm32(int rho) { const int n = rho >> 4, i = rho & 15; return 8 * (i >> 2) + 4 * n + (i & 3); }
struct Unit { int pm, pn; };
struct Gemm { const bf16_t* A; const bf16_t* Bt; int lda, K; const int* gidx; int sc_w, sc_a; };

struct Order {
    int nM, nN, nwg, G, c;
    DI void init(int nM_, int nN_, int G_, int c_) { nM = nM_; nN = nN_; nwg = nM * nN; G = G_; c = c_; }
    DI bool next(int i, Unit& u) const {
        const long L = (long)i * G + c; if (L >= nwg) return false;
        int wgid = (int)L; { const int q = nwg / NXCD, r = nwg % NXCD, xcd = wgid % NXCD, off = wgid / NXCD; wgid = (xcd < r ? xcd * (q + 1) : r * (q + 1) + (xcd - r) * q) + off; }
        const int nig = WGM * nN, gid = wgid / nig, fm = gid * WGM, gsz = (nM - fm) < WGM ? (nM - fm) : WGM;
        u.pm = fm + ((wgid % nig) % gsz); u.pn = (wgid % nig) / gsz; return true;
    }
};
struct SchedPlain : Order { DI size_t a_off(const Unit&) const { return 0; } DI size_t b_off(const Unit&) const { return 0; } };
struct SchedLruGate : Order { DI size_t a_off(const Unit& u) const { return (size_t)(u.pn >> 1) * 256; } DI size_t b_off(const Unit&) const { return 0; } };
struct SchedMoe : Order { int ts1, ts2, ts3, ts4, ts5, ts6, ts7; size_t estride;
    DI size_t a_off(const Unit&) const { return 0; }
    DI size_t b_off(const Unit& u) const { const int e = (u.pm >= ts1) + (u.pm >= ts2) + (u.pm >= ts3) + (u.pm >= ts4) + (u.pm >= ts5) + (u.pm >= ts6) + (u.pm >= ts7); return (size_t)e * estride; } };

DI unsigned cvt_pk_bf16(float lo, float hi) { unsigned r; asm volatile("v_cvt_pk_bf16_f32 %0, %1, %2" : "=v"(r) : "v"(lo), "v"(hi)); return r; }
DI u32x4 pack8(const f32x4& v0, const f32x4& v1) { u32x4 w; w.x = cvt_pk_bf16(v0[0], v0[1]); w.y = cvt_pk_bf16(v0[2], v0[3]); w.z = cvt_pk_bf16(v1[0], v1[1]); w.w = cvt_pk_bf16(v1[2], v1[3]); return w; }

typedef f32x4 Acc[2][2][4][2];

struct EpiMlstmIn { static constexpr bool PERM = true;
    bf16_t *Q, *K, *V, *O; float* gates; const float* gate_b;
    DI void operator()(const Acc& acc, const Unit& u, int wr, int wc, int fr, int fq) const {
        const int row0 = u.pm * BM + wr * 64 + fr;
        if (u.pn < 12) {
            bf16_t* base; int ldc, colt; float sc = 1.f; bool act = false;
            if (u.pn < 2) { base = Q; ldc = 512; colt = u.pn * 256; sc = 0.125f; }
            else if (u.pn < 4) { base = K; ldc = 512; colt = (u.pn - 2) * 256; }
            else if (u.pn < 8) { base = V; ldc = 1024; colt = (u.pn - 4) * 256; }
            else { base = O; ldc = 1024; colt = (u.pn - 8) * 256; act = true; }
            const int col0 = colt + wc * 32 + 8 * fq;
#pragma unroll
            for (int ai = 0; ai < 2; ++ai)
#pragma unroll
                for (int m = 0; m < 4; ++m) { bf16_t* rowp = base + (size_t)(row0 + ai * HALF + m * 16) * ldc + col0;
#pragma unroll
                    for (int bj = 0; bj < 2; ++bj) { f32x4 v0 = acc[ai][bj][m][0], v1 = acc[ai][bj][m][1];
                        if (act) {
#pragma unroll
                            for (int j = 0; j < 4; ++j) { v0[j] = sigmoid_f(v0[j]); v1[j] = sigmoid_f(v1[j]); } }
                        v0 = v0 * sc; v1 = v1 * sc;
                        *(u32x4*)(rowp + bj * HALF) = pack8(v0, v1); } }
        }
    }
};
template <bool SB> struct EpiResidT { static constexpr bool PERM = true;
    const float* src; bf16_t* xs; const float* gmod; const bf16_t* m1;
    const float* ca; bf16_t* xa; float* ssq; LAS unsigned char* lds;
    DI void operator()(const Acc& acc, const Unit& u, int wr, int wc, int fr_, int fq_) const {
        unsigned ones = ~0u; asm volatile("" : "+s"(ones)); const int ln = (int)__builtin_amdgcn_mbcnt_hi(ones, __builtin_amdgcn_mbcnt_lo(ones, 0u)); const int fr = ln & 15, fq = ln >> 4; (void)fr_; (void)fq_;
        const int row0 = u.pm * BM + wr * 64 + fr, col0 = u.pn * BM + wc * 32 + 8 * fq;
        const int tid = (wr * 4 + wc) * 64 + ln;
        if (tid < 256) *(LAS float*)(lds + STAGE_BYTES + 6144 + tid * 4) = gmod[(size_t)(u.pm >> 4) * 6144 + u.pn * BM + tid];
        else *(LAS float*)(lds + STAGE_BYTES + 7168 + (tid - 256) * 4) = ca[(size_t)(u.pm >> 4) * D + u.pn * BM + (tid - 256)];
        asm volatile("s_waitcnt vmcnt(0) lgkmcnt(0)" ::: "memory"); __builtin_amdgcn_s_barrier(); asm volatile("" ::: "memory");
        const LAS float* GS = (const LAS float*)(lds + STAGE_BYTES + 6144) + wc * 32 + 8 * fq; const LAS float* CS = (const LAS float*)(lds + STAGE_BYTES + 7168) + wc * 32 + 8 * fq;
#pragma unroll
        for (int am = 0; am < 8; ++am) { const int ai = am >> 2, m = am & 3;
            const int row = row0 + ai * HALF + m * 16; const size_t off = (size_t)row * D + col0; float ss = 0.f;
            f32x4 sv[2][2]; u32x4 sw[2], mw[2];
#pragma unroll
            for (int bj = 0; bj < 2; ++bj) {
                if constexpr (SB) sw[bj] = *(const u32x4*)(xs + off + bj * HALF);
                else { sv[bj][0] = *(const f32x4*)(src + off + bj * HALF); sv[bj][1] = *(const f32x4*)(src + off + bj * HALF + 4); }
                mw[bj] = *(const u32x4*)(m1 + off + bj * HALF); }
#pragma unroll
            for (int bj = 0; bj < 2; ++bj) { f32x4 y[2], xo[2];
#pragma unroll
                for (int n = 0; n < 2; ++n) { const unsigned w0 = mw[bj][2 * n], w1 = mw[bj][2 * n + 1]; const f32x4 mv = (f32x4){bflo(w0), bfhi(w0), bflo(w1), bfhi(w1)};
                    f32x4 s; if constexpr (SB) { const unsigned a0 = sw[bj][2 * n], a1 = sw[bj][2 * n + 1]; s = (f32x4){bflo(a0), bfhi(a0), bflo(a1), bfhi(a1)}; } else s = sv[bj][n];
                    const f32x4 x = (s + mv) + *(const LAS f32x4*)(GS + bj * HALF + n * 4) * acc[ai][bj][m][n];
                    xo[n] = x; ss += (x[0] * x[0] + x[1] * x[1]) + (x[2] * x[2] + x[3] * x[3]); y[n] = x * *(const LAS f32x4*)(CS + bj * HALF + n * 4); }
                *(u32x4*)(xs + off + bj * HALF) = pack8(xo[0], xo[1]);
                *(u32x4*)(xa + off + bj * HALF) = pack8(y[0], y[1]); }
            ss += __shfl_xor(ss, 16); ss += __shfl_xor(ss, 32);
            if (fq == 0) *(LAS float*)(lds + STAGE_BYTES + 2048 + ((wr * 64 + ai * HALF + m * 16 + fr) * 4 + wc) * 4) = ss;
        }
        asm volatile("s_waitcnt lgkmcnt(0)" ::: "memory"); __builtin_amdgcn_s_barrier(); asm volatile("" ::: "memory");
        if (tid < 256) { const f32x4 t = *(const LAS f32x4*)(lds + STAGE_BYTES + 2048 + tid * 16); ssq[(size_t)(u.pm * BM + tid) * 4 + u.pn] = (t[0] + t[1]) + (t[2] + t[3]); }
    }
};
struct EpiMix { static constexpr bool PERM = true;
    bf16_t* M; const float* gmod;
    DI void operator()(const Acc& acc, const Unit& u, int wr, int wc, int fr, int fq) const {
        const int row0 = u.pm * BM + wr * 64 + fr, col0 = u.pn * BM + wc * 32 + 8 * fq;
        const float* gv = gmod + (size_t)(u.pm >> 4) * 6144 + col0;
        f32x4 g4[2][2];
#pragma unroll
        for (int bj = 0; bj < 2; ++bj)
#pragma unroll
            for (int n = 0; n < 2; ++n) g4[bj][n] = *(const f32x4*)(gv + bj * HALF + n * 4);
#pragma unroll
        for (int ai = 0; ai < 2; ++ai)
#pragma unroll
            for (int m = 0; m < 4; ++m) { bf16_t* rowp = M + (size_t)(row0 + ai * HALF + m * 16) * D + col0;
#pragma unroll
                for (int bj = 0; bj < 2; ++bj) *(u32x4*)(rowp + bj * HALF) = pack8(acc[ai][bj][m][0] * g4[bj][0], acc[ai][bj][m][1] * g4[bj][1]); }
    }
};
constexpr float ACT_SCALE = 4.f, HN_SCALE = 4.f, W13_SCALE = 32.f, W2_SCALE = 64.f;
constexpr int E8_ACT = 0x7d7d7d7d, E8_HN = 0x7d7d7d7d, E8_W13 = 0x7a7a7a7a, E8_W2 = 0x79797979;
DI unsigned pk4_fp8(float a, float b, float c, float d) {
    a = __builtin_amdgcn_fmed3f(a, -448.f, 448.f); b = __builtin_amdgcn_fmed3f(b, -448.f, 448.f); c = __builtin_amdgcn_fmed3f(c, -448.f, 448.f); d = __builtin_amdgcn_fmed3f(d, -448.f, 448.f);
    int w = 0; w = __builtin_amdgcn_cvt_pk_fp8_f32(a, b, w, false); w = __builtin_amdgcn_cvt_pk_fp8_f32(c, d, w, true); return (unsigned)w; }
template <bool F8> struct EpiSwigluT { static constexpr bool PERM = true;
    unsigned char* O;
    DI void operator()(const Acc& acc, const Unit& u, int wr, int wc, int fr, int fq) const {
        const int row0 = u.pm * BM + wr * 64 + fr, col0 = u.pn * HALF + wc * 32 + 8 * fq;
#pragma unroll
        for (int ai = 0; ai < 2; ++ai)
#pragma unroll
            for (int m = 0; m < 4; ++m) { f32x4 v0, v1;
#pragma unroll
                for (int j = 0; j < 4; ++j) { const float a0 = acc[ai][0][m][0][j], a1 = acc[ai][0][m][1][j];
                    if constexpr (F8) {
                        v0[j] = a0 * __builtin_amdgcn_rcpf(__builtin_fmaf(__expf(-a0), 1.f / ACT_SCALE, 1.f / ACT_SCALE)) * acc[ai][1][m][0][j];
                        v1[j] = a1 * __builtin_amdgcn_rcpf(__builtin_fmaf(__expf(-a1), 1.f / ACT_SCALE, 1.f / ACT_SCALE)) * acc[ai][1][m][1][j]; }
                    else { v0[j] = a0 * sigmoid_f(a0) * acc[ai][1][m][0][j]; v1[j] = a1 * sigmoid_f(a1) * acc[ai][1][m][1][j]; } }
                if constexpr (F8) { u32x2 w; w.x = pk4_fp8(v0[0], v0[1], v0[2], v0[3]); w.y = pk4_fp8(v1[0], v1[1], v1[2], v1[3]);
                    *(u32x2*)(O + (size_t)(row0 + ai * HALF + m * 16) * DFF + col0) = w; }
                else *(u32x4*)((bf16_t*)O + (size_t)(row0 + ai * HALF + m * 16) * DFF + col0) = pack8(v0, v1); }
    }
};
typedef EpiSwigluT<true> EpiSwiglu;
template <int K> DI float dpp_ror(float v) { const int x = __builtin_bit_cast(int, v); return __builtin_bit_cast(float, __builtin_amdgcn_update_dpp(x, x, 0x120 + K, 0xf, 0xf, true)); }
struct EpiLruIn { static constexpr bool PERM = true;
    bf16_t *GB, *XC, *XRH; const float* cw; const float* cb; LAS unsigned char* lds;
    const float* ssq; const float* biasp;
    DI void operator()(const Acc& acc, const Unit& u, int wr, int wc, int fr_, int fq_) const {
        unsigned ones = ~0u; asm volatile("" : "+s"(ones)); const int ln = (int)__builtin_amdgcn_mbcnt_hi(ones, __builtin_amdgcn_mbcnt_lo(ones, 0u)); const int fr = ln & 15, fq = ln >> 4; (void)fr_; (void)fq_;
        const int row0 = u.pm * BM + wr * 64 + fr; const bool isg = u.pn < 4; const int tid = (wr * 4 + wc) * 64 + ln;
        LAS float* RS = (LAS float*)(lds + STAGE_BYTES + 6144); LAS float* BS = (LAS float*)(lds + STAGE_BYTES + 7168); LAS float* TB = (LAS float*)(lds + STAGE_BYTES + 8192);
        if (tid < 256) { const f32x4 t = *(const f32x4*)(ssq + (size_t)(u.pm * BM + tid) * 4); RS[tid] = __builtin_amdgcn_rsqf(((t[0] + t[1]) + (t[2] + t[3])) * (1.f / D) + RMS_EPS); }
        else { const float* bp = biasp + (size_t)(u.pm >> 4) * 2048 + u.pn * BM + (tid - 256); float s = 0.f;
#pragma unroll
            for (int ks = 0; ks < 8; ++ks) s += bp[(size_t)ks * 16 * 2048];
            BS[tid - 256] = s; }
        const int c0 = (u.pn - 4) * 256;
        if (!isg) for (int idx = tid; idx < 5 * 256; idx += 512) TB[idx] = (idx < 1024) ? cw[(size_t)(idx >> 8) * D + c0 + (idx & 255)] : cb[c0 + idx - 1024];
        asm volatile("s_waitcnt vmcnt(0) lgkmcnt(0)" ::: "memory"); __builtin_amdgcn_s_barrier(); asm volatile("" ::: "memory");
        const int cl = wc * 32 + 8 * fq;
        if (isg) {
            const int col0 = u.pn * 256 + cl;
#pragma unroll
            for (int ai = 0; ai < 2; ++ai)
#pragma unroll
                for (int m = 0; m < 4; ++m) { bf16_t* rowp = GB + (size_t)(row0 + ai * HALF + m * 16) * D + col0; const float r = RS[wr * 64 + fr + ai * HALF + m * 16];
#pragma unroll
                    for (int bj = 0; bj < 2; ++bj) { f32x4 v0 = acc[ai][bj][m][0] * r + *(const LAS f32x4*)(BS + cl + bj * HALF), v1 = acc[ai][bj][m][1] * r + *(const LAS f32x4*)(BS + cl + bj * HALF + 4);
#pragma unroll
                        for (int j = 0; j < 4; ++j) { float x = v0[j]; float z = 1.5957691216f * (x + 0.044715f * x * x * x); v0[j] = x * sigmoid_f(z);
                            x = v1[j]; z = 1.5957691216f * (x + 0.044715f * x * x * x); v1[j] = x * sigmoid_f(z); }
                        *(u32x4*)(rowp + bj * HALF) = pack8(v0, v1); }
                    asm volatile("" ::: "memory"); }
        } else {
            const int col0 = c0 + cl;
#pragma unroll
            for (int ai = 0; ai < 2; ++ai)
#pragma unroll
                for (int m = 0; m < 4; ++m) { const int row = row0 + ai * HALF + m * 16; const float r = RS[wr * 64 + fr + ai * HALF + m * 16], rp = (m > 0) ? RS[wr * 64 + fr + ai * HALF + (m > 0 ? m - 1 : 0) * 16] : 0.f;
#pragma unroll
                    for (int bj = 0; bj < 2; ++bj) { f32x4 o[2], xs[2];
#pragma unroll
                        for (int n = 0; n < 2; ++n) { const LAS float* tp = TB + cl + bj * HALF + 4 * n; const f32x4 bq = *(const LAS f32x4*)(BS + cl + bj * HALF + 4 * n);
                            const f32x4 w0 = *(const LAS f32x4*)(tp), w1 = *(const LAS f32x4*)(tp + 256), w2 = *(const LAS f32x4*)(tp + 512), w3 = *(const LAS f32x4*)(tp + 768), b4 = *(const LAS f32x4*)(tp + 1024);
#pragma unroll
                            for (int j = 0; j < 4; ++j) { const float x0 = acc[ai][bj][m][n][j] * r + bq[j]; const float xp = (m > 0) ? acc[ai][bj][m > 0 ? m - 1 : 0][n][j] * rp + bq[j] : 0.f;
                                const float c1 = dpp_ror<1>(x0), c2 = dpp_ror<2>(x0), c3 = dpp_ror<3>(x0), p1 = dpp_ror<1>(xp), p2 = dpp_ror<2>(xp), p3 = dpp_ror<3>(xp);
                                const float x1 = (fr >= 1) ? c1 : p1, x2 = (fr >= 2) ? c2 : p2, x3 = (fr >= 3) ? c3 : p3;
                                xs[n][j] = x0; o[n][j] = b4[j] + w0[j] * x3 + w1[j] * x2 + w2[j] * x1 + w3[j] * x0; }
                            asm volatile("" ::: "memory"); }
                        *(u32x4*)(XC + (size_t)row * D + col0 + bj * HALF) = pack8(o[0], o[1]);
                        if (m == 0 && fr < 3) *(u32x4*)(XRH + ((size_t)(row >> 6) * 6 + fr) * D + col0 + bj * HALF) = pack8(xs[0], xs[1]);
                        if (m == 3 && fr >= 13) *(u32x4*)(XRH + ((size_t)(row >> 6) * 6 + 3 + (fr - 13)) * D + col0 + bj * HALF) = pack8(xs[0], xs[1]);
                        __builtin_amdgcn_sched_barrier(0); }
                    asm volatile("" ::: "memory"); }
        }
    }
};
template <int K> DI float dpp_shr(float v) { const int x = __builtin_bit_cast(int, v); return __builtin_bit_cast(float, __builtin_amdgcn_update_dpp(x, x, 0x110 + K, 0xf, 0xf, true)); }
struct EpiLruGate { static constexpr bool PERM = true;
    const bf16_t* XC; bf16_t *LA, *U; const float* gate_b; const float* sp; float* car64;
    DI void operator()(const Acc& acc, const Unit& u, int wr, int wc, int fr, int fq) const {
        const int row0 = u.pm * BM + wr * 64 + fr, ch0 = u.pn * HALF + wc * 32 + 8 * fq;
        const int hd = u.pn >> 1, o0 = (u.pn & 1) * HALF + wc * 32 + 8 * fq;
        u32x4 xw[2][4];
#pragma unroll
        for (int ai = 0; ai < 2; ++ai)
#pragma unroll
            for (int m = 0; m < 4; ++m) xw[ai][m] = *(const u32x4*)(XC + (size_t)(row0 + ai * HALF + m * 16) * D + ch0);
#pragma unroll
        for (int n = 0; n < 2; ++n) {
            const f32x4 bx = *(const f32x4*)(gate_b + hd * 512 + o0 + 4 * n), ba = *(const f32x4*)(gate_b + hd * 512 + 256 + o0 + 4 * n), s4 = *(const f32x4*)(sp + ch0 + 4 * n);
#pragma unroll
            for (int ai = 0; ai < 2; ++ai) {
                float Ab[4] = {1.f, 1.f, 1.f, 1.f}, Hb[4] = {0.f, 0.f, 0.f, 0.f};
#pragma unroll
                for (int m = 0; m < 4; ++m) { const size_t off = (size_t)(row0 + ai * HALF + m * 16) * D + ch0 + 4 * n;
                    float la[4], uu[4];
#pragma unroll
                    for (int j = 0; j < 4; ++j) { const unsigned w = xw[ai][m][2 * n + (j >> 1)]; const float xc = (j & 1) ? bfhi(w) : bflo(w);
                        const float ig = sigmoid_f(acc[ai][0][m][n][j] + bx[j]), rg = sigmoid_f(acc[ai][1][m][n][j] + ba[j]);
                        const float l = -8.f * rg * s4[j]; const float av = __expf(l);
                        la[j] = l; uu[j] = xc * ig * __builtin_amdgcn_sqrtf(1.f - av * av); }
                    u32x2 lw, uw; lw.x = cvt_pk_bf16(la[0], la[1]); lw.y = cvt_pk_bf16(la[2], la[3]); uw.x = cvt_pk_bf16(uu[0], uu[1]); uw.y = cvt_pk_bf16(uu[2], uu[3]);
                    *(u32x2*)(LA + off) = lw; *(u32x2*)(U + off) = uw;
#pragma unroll
                    for (int j = 0; j < 4; ++j) { const unsigned lq = (j < 2) ? lw.x : lw.y, uq = (j < 2) ? uw.x : uw.y;
                        float A = __expf((j & 1) ? bfhi(lq) : bflo(lq)), H = (j & 1) ? bfhi(uq) : bflo(uq);
                        { const float Al = dpp_shr<1>(A), Hl = dpp_shr<1>(H); H = A * Hl + H; A = Al * A; }
                        { const float Al = dpp_shr<2>(A), Hl = dpp_shr<2>(H); H = A * Hl + H; A = Al * A; }
                        { const float Al = dpp_shr<4>(A), Hl = dpp_shr<4>(H); H = A * Hl + H; A = Al * A; }
                        { const float Al = dpp_shr<8>(A), Hl = dpp_shr<8>(H); H = A * Hl + H; A = Al * A; }
                        Hb[j] = A * Hb[j] + H; Ab[j] = Ab[j] * A; } }
                if (fr == 15) { float* cp = car64 + ((size_t)(u.pm * 4 + 2 * ai + wr) * D + ch0 + 4 * n) * 2;
                    *(f32x4*)(cp) = (f32x4){Ab[0], Hb[0], Ab[1], Hb[1]}; *(f32x4*)(cp + 4) = (f32x4){Ab[2], Hb[2], Ab[3], Hb[3]}; }
            }
        }
    }
};
struct EpiBf16 { static constexpr bool PERM = true;
    bf16_t* O; int ldc;
    DI void operator()(const Acc& acc, const Unit& u, int wr, int wc, int fr, int fq) const {
        const int row0 = u.pm * BM + wr * 64 + fr, col0 = u.pn * BM + wc * 32 + 8 * fq;
#pragma unroll
        for (int ai = 0; ai < 2; ++ai)
#pragma unroll
            for (int m = 0; m < 4; ++m) { bf16_t* rowp = O + (size_t)(row0 + ai * HALF + m * 16) * ldc + col0;
#pragma unroll
                for (int bj = 0; bj < 2; ++bj) *(u32x4*)(rowp + bj * HALF) = pack8(acc[ai][bj][m][0], acc[ai][bj][m][1]); }
    }
};

typedef int i32x4 __attribute__((ext_vector_type(4)));
typedef int i32x8 __attribute__((ext_vector_type(8)));
template <class Epi, class Sched, bool GATHER, bool FP8 = false>
DI void gemm_phase(LAS unsigned char* lds, const int tid, const Gemm g, const Sched& S, const Epi& E) {
    const int wid = __builtin_amdgcn_readfirstlane(tid >> 6), lane = tid & 63, wr = wid >> 2, wc = wid & 3, fr = lane & 15, fq = lane >> 4;
    const int K = g.K, lda = g.lda, nt = K / BK;
    unsigned voffA[2], voffB[2]; int RA[2]; unsigned CA2[2];
#pragma unroll
    for (int i = 0; i < 2; ++i) { int R, C; stage_rc(tid * 16 + i * 8192, R, C); const int Rb = Epi::PERM ? ((R & ~31) + perm32(R & 31)) : R;
        voffA[i] = (unsigned)(R * lda + C) * 2u; voffB[i] = (unsigned)(Rb * K + C) * 2u; RA[i] = R; CA2[i] = (unsigned)C * 2u; }
    const size_t kstep = (size_t)(BK * 2);
    const size_t hstepA = GATHER ? 0 : (size_t)HALF * lda * 2, hstepB = (size_t)HALF * K * 2;
    const size_t tstepA = GATHER ? 0 : 2 * hstepA, tstepB = 2 * hstepB;
    const unsigned ldsw = (unsigned)wid * 1024u;
    const int aoff = lds_byte(wr * 64 + fr, fq * 8), boff = lds_byte(wc * 32 + fr, fq * 8);
    unsigned vc[2][2];
#define PG8_SA(b, h) (((b) * 2 + (h)) * HTB)
#define PG8_SB(b, h) ((4 + (b) * 2 + (h)) * HTB)
#define PG8_STAGE(bufoff, gbase, voff) do { _Pragma("unroll") for (int _i = 0; _i < 2; ++_i) \
        __builtin_amdgcn_global_load_lds((const unsigned*)((const char*)(gbase) + (voff)[_i]), (LAS unsigned*)(lds + (bufoff) + ldsw + _i * 8192), 16, 0, 0); } while (0)
#define PG8_STAGE_A(bufoff, kptr, h, VV) do { if constexpr (GATHER) { PG8_STAGE(bufoff, kptr, (VV)[h]); } else { PG8_STAGE(bufoff, (kptr) + (h) * hstepA, voffA); } } while (0)
#define PG8_LDA(dst, b, h) do { _Pragma("unroll") for (int m = 0; m < 4; ++m) _Pragma("unroll") for (int k = 0; k < 2; ++k) dst[m][k] = *(const LAS bf16x8*)(lds + PG8_SA(b, h) + aoff + m * 2048 + k * 1024); } while (0)
#define PG8_LDB(dst, b, h) do { _Pragma("unroll") for (int n = 0; n < 2; ++n) _Pragma("unroll") for (int k = 0; k < 2; ++k) dst[n][k] = *(const LAS bf16x8*)(lds + PG8_SB(b, h) + boff + n * 2048 + k * 1024); } while (0)
#define PG8_CAT(f) __builtin_shufflevector(__builtin_bit_cast(i32x4, (f)[0]), __builtin_bit_cast(i32x4, (f)[1]), 0, 1, 2, 3, 4, 5, 6, 7)
#define PG8_MMA(ai, bj, At, Bt) do { __builtin_amdgcn_s_setprio(1); _Pragma("unroll") for (int m = 0; m < 4; ++m) _Pragma("unroll") for (int n = 0; n < 2; ++n) { \
        if constexpr (FP8) { const i32x8 _b = PG8_CAT(Bt[n]), _a = PG8_CAT(At[m]); asm volatile("v_mfma_scale_f32_16x16x128_f8f6f4 %0, %1, %2, %0, %3, %4 op_sel_hi:[0,0,0]" : "+v"(acc[ai][bj][m][n]) : "v"(_b), "v"(_a), "v"(scw), "v"(sca)); } \
        else { _Pragma("unroll") for (int k = 0; k < 2; ++k) acc[ai][bj][m][n] = __builtin_amdgcn_mfma_f32_16x16x32_bf16(Bt[n][k], At[m][k], acc[ai][bj][m][n], 0, 0, 0); } } __builtin_amdgcn_s_setprio(0); } while (0)
#define PG8_WAIT_V(n) asm volatile("s_waitcnt vmcnt(" #n ")" ::: "memory")
#define PG8_WAIT_L(n) asm volatile("s_waitcnt lgkmcnt(" #n ")" ::: "memory")
#define PG8_BAR __builtin_amdgcn_s_barrier()
#define PG8_SCHED __builtin_amdgcn_sched_barrier(0)
#define PG8_GIDX(VV, U) do { if constexpr (GATHER) { _Pragma("unroll") for (int _h = 0; _h < 2; ++_h) _Pragma("unroll") for (int _i = 0; _i < 2; ++_i) { \
        const int _tok = g.gidx[(U).pm * BM + _h * HALF + RA[_i]]; (VV)[_h][_i] = (unsigned)_tok * (unsigned)(lda * 2) + CA2[_i]; } } } while (0)
#define PG8_GIDX_LDS(VV, BUF) do { if constexpr (GATHER) { _Pragma("unroll") for (int _h = 0; _h < 2; ++_h) _Pragma("unroll") for (int _i = 0; _i < 2; ++_i) { \
        const int _tok = *(const LAS int*)(lds + STAGE_BYTES + (BUF) * 1024 + (_h * HALF + RA[_i]) * 4); (VV)[_h][_i] = (unsigned)_tok * (unsigned)(lda * 2) + CA2[_i]; } } } while (0)
    Unit cur, nxt; int ui = 0;
    if (!S.next(0, cur)) return;
    int scw = 0, sca = 0; if constexpr (FP8) { scw = g.sc_w; sca = g.sc_a; asm volatile("" : "+v"(scw), "+v"(sca)); }
    Acc acc;
#pragma unroll
    for (int a = 0; a < 2; ++a)
#pragma unroll
        for (int b = 0; b < 2; ++b)
#pragma unroll
            for (int m = 0; m < 4; ++m)
#pragma unroll
                for (int n = 0; n < 2; ++n) acc[a][b][m][n] = (f32x4){0.f, 0.f, 0.f, 0.f};
    bf16x8 At[4][2], B0[2][2], B1[2][2];
    const char* cA = (const char*)(g.A + S.a_off(cur)) + (size_t)cur.pm * tstepA; const char* cB = (const char*)(g.Bt + S.b_off(cur)) + (size_t)cur.pn * tstepB;
    vc[0][0] = vc[0][1] = vc[1][0] = vc[1][1] = 0u;
    PG8_GIDX(vc, cur);
    PG8_STAGE(PG8_SB(0, 0), cB, voffB); PG8_STAGE(PG8_SB(0, 1), cB + hstepB, voffB); PG8_STAGE_A(PG8_SA(0, 0), cA, 0, vc); PG8_STAGE_A(PG8_SA(0, 1), cA, 1, vc);
    if (wr == 1) PG8_BAR;
    PG8_WAIT_V(2); PG8_BAR;
    PG8_STAGE(PG8_SB(1, 0), cB + kstep, voffB); PG8_STAGE_A(PG8_SA(1, 0), cA + kstep, 0, vc); PG8_STAGE(PG8_SB(1, 1), cB + hstepB + kstep, voffB);
    PG8_WAIT_V(6); PG8_BAR;
    for (;;) {
        const bool has_next = S.next(ui + 1, nxt);
        const char* nA = has_next ? (const char*)(g.A + S.a_off(nxt)) + (size_t)nxt.pm * tstepA : cA; const char* nB = has_next ? (const char*)(g.Bt + S.b_off(nxt)) + (size_t)nxt.pn * tstepB : cB;
        if constexpr (GATHER) { if (has_next && wid == 0)
            __builtin_amdgcn_global_load_lds((const unsigned*)(g.gidx + (size_t)nxt.pm * BM + lane * 4), (LAS unsigned*)(lds + STAGE_BYTES + (ui & 1) * 1024), 16, 0, 0); }
#pragma nounroll
        for (int t = 0; t < nt; t += 2) {
            const bool last = (t == nt - 2);
            const char* a1 = cA + (size_t)(t + 1) * kstep;
            const char* a2 = last ? nA : cA + (size_t)(t + 2) * kstep; const char* b2 = last ? nB : cB + (size_t)(t + 2) * kstep;
            const char* a3 = a2 + kstep; const char* b3 = b2 + kstep;
            unsigned v2[2][2];
#pragma unroll
            for (int h = 0; h < 2; ++h)
#pragma unroll
                for (int i = 0; i < 2; ++i) v2[h][i] = vc[h][i];
            if (last && has_next) { PG8_GIDX_LDS(v2, ui & 1); }
            PG8_LDB(B0, 0, 0); PG8_LDB(B1, 0, 1); PG8_SCHED; PG8_LDA(At, 0, 0); PG8_STAGE_A(PG8_SA(1, 1), a1, 1, vc);
            PG8_WAIT_V(8); PG8_WAIT_L(0); PG8_BAR; PG8_MMA(0, 0, At, B0); PG8_MMA(0, 1, At, B1); PG8_BAR; PG8_SCHED;
            PG8_LDA(At, 0, 1); PG8_STAGE(PG8_SB(0, 0), b2, voffB); PG8_STAGE(PG8_SB(0, 1), b2 + hstepB, voffB); PG8_STAGE_A(PG8_SA(0, 0), a2, 0, v2);
            PG8_WAIT_V(8); PG8_WAIT_L(0); PG8_BAR; PG8_MMA(1, 0, At, B0); PG8_MMA(1, 1, At, B1); PG8_BAR; PG8_SCHED;
            PG8_LDB(B0, 1, 0); PG8_LDB(B1, 1, 1); PG8_SCHED; PG8_LDA(At, 1, 0); PG8_STAGE_A(PG8_SA(0, 1), a2, 1, v2);
            PG8_WAIT_V(8); PG8_WAIT_L(0); PG8_BAR; PG8_MMA(0, 0, At, B0); PG8_MMA(0, 1, At, B1); PG8_BAR; PG8_SCHED;
            PG8_LDA(At, 1, 1); PG8_STAGE(PG8_SB(1, 0), b3, voffB); PG8_STAGE(PG8_SB(1, 1), b3 + hstepB, voffB); PG8_STAGE_A(PG8_SA(1, 0), a3, 0, v2);
            PG8_WAIT_V(8); PG8_WAIT_L(0); PG8_BAR; PG8_MMA(1, 0, At, B0); PG8_MMA(1, 1, At, B1); PG8_BAR; PG8_SCHED;
            if constexpr (GATHER) { if (last) {
#pragma unroll
                for (int h = 0; h < 2; ++h)
#pragma unroll
                    for (int i = 0; i < 2; ++i) vc[h][i] = v2[h][i]; } }
        }
        if (wr == 0) PG8_BAR;
        if constexpr (FP8) asm volatile("s_nop 15\n\ts_nop 15\n\ts_nop 15\n\ts_nop 15\n\ts_nop 15" ::: "memory");
        E(acc, cur, wr, wc, fr, fq);
        if (!has_next) break;
#pragma unroll
        for (int a = 0; a < 2; ++a)
#pragma unroll
            for (int b = 0; b < 2; ++b)
#pragma unroll
                for (int m = 0; m < 4; ++m)
#pragma unroll
                    for (int n = 0; n < 2; ++n) acc[a][b][m][n] = (f32x4){0.f, 0.f, 0.f, 0.f};
        cur = nxt; cA = nA; cB = nB; ++ui;
        if (wr == 1) PG8_BAR;
    }
    PG8_WAIT_V(0);
    PG8_BAR;
#undef PG8_SA
#undef PG8_SB
#undef PG8_STAGE
#undef PG8_STAGE_A
#undef PG8_LDA
#undef PG8_LDB
#undef PG8_MMA
#undef PG8_CAT
#undef PG8_WAIT_V
#undef PG8_WAIT_L
#undef PG8_BAR
#undef PG8_SCHED
#undef PG8_GIDX
#undef PG8_GIDX_LDS
}
}

struct Args { const float* in[N_IN]; float* out; unsigned char* ws; int ph_lo, ph_hi; };
static_assert(sizeof(Args) == (N_IN + 2) * 8 + 8, "Args has no padding");

typedef const Args __attribute__((address_space(4))) CArgs;
DI const CArgs* kargs() { const CArgs* p = (const CArgs*)__builtin_amdgcn_kernarg_segment_ptr(); asm volatile("" : "+s"(p)); return p; }
struct Frame { LAS unsigned char* lds; int tid, lane, wave, vcu, G; };
extern __shared__ __attribute__((aligned(16))) unsigned char lds_raw[];
DI Frame make_frame(int wv) { Frame F; F.lds = (LAS unsigned char*)lds_raw; unsigned ones = ~0u; asm volatile("" : "+s"(ones)); int t = wv * 64 + (int)__builtin_amdgcn_mbcnt_hi(ones, __builtin_amdgcn_mbcnt_lo(ones, 0u)); asm volatile("" : "+v"(t)); F.tid = t; F.lane = t & 63; F.wave = __builtin_amdgcn_readfirstlane(t >> 6);
    F.G = gridDim.x; { int bx = blockIdx.x; asm volatile("" : "+s"(bx)); F.vcu = (F.G % 8 == 0) ? (bx % 8) * (F.G / 8) + bx / 8 : bx; } return F; }

struct TrItem { const float* W; bf16_t* WT; int K, N, half, item; float f8scale; };
DI void tr_load(const TrItem& q, int lane, float (&v)[32]) {
    const int nblk = (q.N + 31) >> 5, kb = q.item / nblk, nb = q.item - kb * nblk, k0 = 64 * kb, n0 = 32 * nb;
    const int n = n0 + (lane & 31); const bool ok = n < q.N; const int nc = ok ? n : q.N - 1;
    const float* p = q.W + (size_t)(k0 + (lane >> 5)) * q.N + nc; const size_t rs = (size_t)2 * q.N;
#pragma unroll
    for (int i = 0; i < 32; ++i) v[i] = __builtin_nontemporal_load(p + (size_t)i * rs);
    if (!ok) {
#pragma unroll
        for (int i = 0; i < 32; ++i) v[i] = 0.f; }
}
DI void tr_store(const TrItem& q, int lane, const float (&v)[32], LAS float* scr) {
    const int nblk = (q.N + 31) >> 5, kb = q.item / nblk, nb = q.item - kb * nblk, k0 = 64 * kb, n0 = 32 * nb;
#pragma unroll
    for (int i = 0; i < 32; ++i) { const int kk = 2 * i + (lane >> 5); scr[kk * 33 + (lane & 31)] = v[i]; }
    LDS_WAIT(); asm volatile("" ::: "memory");
    const int c = lane & 7;
#pragma unroll
    for (int j = 0; j < 4; ++j) { const int nl = (lane >> 3) + 8 * j; const LAS float* s = scr + (8 * c) * 33 + nl;
        u32x4 o; o.x = pk2(s[0 * 33], s[1 * 33]); o.y = pk2(s[2 * 33], s[3 * 33]); o.z = pk2(s[4 * 33], s[5 * 33]); o.w = pk2(s[6 * 33], s[7 * 33]);
        const int n = n0 + nl; int rho = n;
        if (q.half) { const int nn = (n < q.half) ? n : n - q.half; rho = ((nn >> 7) << 8) + (nn & 127) + ((n < q.half) ? 0 : 128); }
        if (q.f8scale != 0.f) { const float f = q.f8scale; u32x2 o8; o8.x = pg8::pk4_fp8(s[0 * 33] * f, s[1 * 33] * f, s[2 * 33] * f, s[3 * 33] * f); o8.y = pg8::pk4_fp8(s[4 * 33] * f, s[5 * 33] * f, s[6 * 33] * f, s[7 * 33] * f);
            *(u32x2*)((unsigned char*)q.WT + (size_t)rho * q.K + k0 + 8 * c) = o8; }
        else *(u32x4*)(q.WT + (size_t)rho * q.K + k0 + 8 * c) = o; }
    LDS_WAIT(); asm volatile("" ::: "memory");
}
constexpr int CI0 = 16 * 97, CI1 = 512, CI2 = 3584, CI3 = 1792, CI4 = 1024, CI5 = 256, CI6 = 512, CI7 = 8 * 3584, CI8 = 8 * 1792, CI_PER_J = CI0 + CI1 + CI2 + CI3 + CI4 + CI5 + CI6 + CI7 + CI8;
constexpr int N_MODIT = 4 * 24 * 8;
constexpr int CI_A_FWD = CI0 + CI1 + CI2 + CI3 + CI4 + CI5 + CI6;
DI TrItem conv_desc(const CArgs* a, int it) {
    const int j = it / CI_PER_J; int r = it - j * CI_PER_J;
    bf16_t* wb = (bf16_t*)(a->ws + WS_W) + (size_t)j * W_PER_J;
    if (r < CI0) return TrItem{a->in[I_MLWIN] + (size_t)j * D * MLP, wb + W_WIN, D, MLP, 0, r, 0.f}; r -= CI0;
    if (r < CI1) return TrItem{a->in[I_MLWOUT] + (size_t)j * D * D, wb + W_WOUT, D, D, 0, r, 0.f}; r -= CI1;
    if (r < CI2) return TrItem{a->in[I_FW13] + (size_t)j * D * 2 * DFF, wb + W_W13, D, 2 * DFF, DFF, r, DENSE_UP_FP8_AT(j) ? pg8::W13_SCALE : 0.f}; r -= CI2;
    if (r < CI3) return TrItem{a->in[I_FW2] + (size_t)j * DFF * D, wb + W_W2, DFF, D, 0, r, DENSE_FP8_AT(j) ? pg8::W2_SCALE : 0.f}; r -= CI3;
    if (r < CI4) return TrItem{a->in[I_LWIN] + (size_t)j * D * 2 * D, wb + W_LIN, D, 2 * D, 0, r, 0.f}; r -= CI4;
    if (r < CI5) { const int hd = r >> 6; return TrItem{a->in[I_LGW] + (size_t)(j * 4 + hd) * 256 * 512, wb + W_GW + (size_t)hd * 512 * 256, 256, 512, 256, r & 63, 0.f}; } r -= CI5;
    if (r < CI6) return TrItem{a->in[I_LWOUT] + (size_t)j * D * D, wb + W_LOUT, D, D, 0, r, 0.f}; r -= CI6;
    if (r < CI7) { const int e = r / 3584; return TrItem{a->in[I_MW13] + (size_t)(j * NE + e) * D * 2 * DFF, wb + W_MW13 + (size_t)e * DFF * D, D, 2 * DFF, DFF, r - e * 3584, pg8::W13_SCALE}; } r -= CI7;
    { const int e = r / 1792; return TrItem{a->in[I_MW2] + (size_t)(j * NE + e) * DFF * D, wb + W_MW2 + (size_t)e * (D * DFF / 2), DFF, D, 0, r - e * 1792, pg8::W2_SCALE}; }
}
DI void conv_stream(const CArgs* a, int first, int step, int end, LAS float* scr, int lane) {
    if (first >= end) return;
    float va[32], vb[32];
    TrItem qa = conv_desc(a, first), qb = qa;
    tr_load(qa, lane, va);
    for (int it = first; it < end; it += 2 * step) {
        const bool hb = it + step < end;
        if (hb) { qb = conv_desc(a, it + step); tr_load(qb, lane, vb); }
        tr_store(qa, lane, va, scr);
        if (!hb) break;
        const bool ha = it + 2 * step < end;
        if (ha) { qa = conv_desc(a, it + 2 * step); tr_load(qa, lane, va); }
        tr_store(qb, lane, vb, scr);
        if (!ha) break;
    }
}
DI void mod_item(const CArgs* a, int it, const LAS float* cact, int lane) {
    const int i = it / 192, rem = it - i * 192, cg = rem >> 3, ks = rem & 7;
    const float* w = a->in[I_ADAW] + ((size_t)i * D + ks * 128) * 6144 + cg * 256 + lane * 4;
    f32x4 acc[16];
#pragma unroll
    for (int b = 0; b < 16; ++b) acc[b] = (f32x4){0.f, 0.f, 0.f, 0.f};
#pragma unroll 4
    for (int k = 0; k < 128; ++k) { const f32x4 w4 = *(const f32x4*)(w + (size_t)k * 6144);
#pragma unroll
        for (int b = 0; b < 16; ++b) acc[b] += w4 * cact[b * D + ks * 128 + k]; }
    float* o = (float*)(a->ws + WS_MODP) + ((size_t)(ks * 4 + i) * 16) * 6144 + cg * 256 + lane * 4;
#pragma unroll
    for (int b = 0; b < 16; ++b) *(f32x4*)(o + (size_t)b * 6144) = acc[b];
}
DI void mod_item_full(const CArgs* a, int it, const LAS float* cact, int lane) {
    const int i = it / 24, cg = it - i * 24;
    const float* w = a->in[I_ADAW] + (size_t)i * D * 6144 + cg * 256 + lane * 4;
    f32x4 acc[16];
#pragma unroll
    for (int b = 0; b < 16; ++b) acc[b] = (f32x4){0.f, 0.f, 0.f, 0.f};
    for (int k0 = 0; k0 < D; k0 += 16) { f32x4 w4[16];
#pragma unroll
        for (int kk = 0; kk < 16; ++kk) w4[kk] = __builtin_nontemporal_load((const f32x4*)(w + (size_t)(k0 + kk) * 6144));
#pragma unroll
        for (int kk = 0; kk < 16; ++kk)
#pragma unroll
            for (int b = 0; b < 16; ++b) acc[b] += w4[kk] * cact[b * D + k0 + kk]; }
    const f32x4 bias = *(const f32x4*)(a->in[I_ADAB] + (size_t)i * 6144 + cg * 256 + lane * 4);
    float* o = (float*)(a->ws + WS_MOD) + ((size_t)i * 16) * 6144 + cg * 256 + lane * 4;
#pragma unroll
    for (int b = 0; b < 16; ++b) *(f32x4*)(o + (size_t)b * 6144) = acc[b] + bias;
}
DI void ph_prologue_a(int wv) {
    const CArgs* a = kargs(); const Frame F = make_frame(wv);
    LAS float* cact = (LAS float*)(F.lds + 8 * 8448);
    LAS float* scr = (LAS float*)(F.lds + F.wave * 8448);
    for (int idx = F.tid; idx < 16 * D; idx += NTHR) { const float c = a->in[I_C][idx]; cact[idx] = c * sigmoid_f(c); }
    __syncthreads();
    const int gw = F.vcu * NWAVES + F.wave, NGW = F.G * NWAVES;
    for (int it = gw; it < 64; it += NGW) mod_item(a, it, cact, F.lane);
    {
        float va[32];
        for (int r = gw; r < CI0; r += NGW) { const TrItem q = conv_desc(a, r); tr_load(q, F.lane, va); tr_store(q, F.lane, va, scr); }
    }
    for (int idx = F.vcu * NTHR + F.tid; idx < 2 * 28672; idx += F.G * NTHR) { const int j = idx / 28672, o = idx - j * 28672;
        ((u32x4*)((bf16_t*)(a->ws + WS_W) + (size_t)j * W_PER_J + W_WIN + (size_t)3104 * D))[o] = (u32x4){0u, 0u, 0u, 0u}; }
}
DI void ph_prologue_b(int wv) {
    const CArgs* a = kargs(); const Frame F = make_frame(wv);
    const f32x4* P = (const f32x4*)(a->ws + WS_MODP); f32x4* M = (f32x4*)(a->ws + WS_MOD); const f32x4* B4 = (const f32x4*)a->in[I_ADAB];
    for (int idx = F.vcu * NTHR + F.tid; idx < 4 * 16 * 1536; idx += F.G * NTHR) { const int i = idx / (16 * 1536), n4 = idx % 1536;
        f32x4 s = B4[i * 1536 + n4];
#pragma unroll
        for (int ks = 0; ks < 8; ++ks) s += P[(size_t)ks * (4 * 16 * 1536) + idx];
        M[idx] = s; }
    for (int idx = F.vcu * NTHR + F.tid; idx < 2 * D; idx += F.G * NTHR) ((float*)(a->ws + WS_SP))[idx] = log1p_exp_neg(a->in[I_LAP][idx]);
}

template <bool SB> DI void ld_src(const float* src, const bf16_t* xsb, int r, int lane, u32x4 (&raw)[4]) {
    if constexpr (SB) { const u32x2* xr = (const u32x2*)(xsb + (size_t)r * D) + lane;
#pragma unroll
        for (int j = 0; j < 4; ++j) { const u32x2 t = __builtin_nontemporal_load(xr + 64 * j); raw[j].x = t.x; raw[j].y = t.y; } }
    else { const u32x4* xr = (const u32x4*)(src + (size_t)r * D) + lane;
#pragma unroll
        for (int j = 0; j < 4; ++j) raw[j] = __builtin_nontemporal_load(xr + 64 * j); }
}
template <int MODE, bool SB>
DI void row_pass(int wv, int srcsel, int ngsel, int layer, int sub, int jl, int addm) {
    const CArgs* a = kargs(); const Frame F = make_frame(wv); asm volatile("" : "+s"(layer), "+s"(jl));
    (void)srcsel; const float* src = a->in[I_X]; bf16_t* XSB = (bf16_t*)(a->ws + WS_R + R_XSB); const float* ngain = ngsel < 0 ? a->in[I_FNG] : a->in[I_NORMG] + (size_t)ngsel * D;
    float* XS = a->out; bf16_t* HN = (bf16_t*)(a->ws + WS_HN); const bf16_t* M1 = (const bf16_t*)(a->ws + WS_R + R_M1); asm volatile("" : "+s"(addm));
    const int gw = F.vcu * NWAVES + F.wave, lane = F.lane;
    LAS float* rw = (LAS float*)F.lds;
    if (MODE == 1) { const float* RW = a->in[I_RW] + (size_t)jl * D * NE; for (int idx = F.tid; idx < D * NE; idx += NTHR) { const int d = idx >> 3, e = idx & 7;
            rw[((((d >> 8) * 4 + (d & 3)) * 2 + (e >> 2)) * 64 + ((d & 255) >> 2)) * 4 + (e & 3)] = RW[idx]; }
        __syncthreads(); }
    int cnt0 = 0, cnt1 = 0, cnt2 = 0, cnt3 = 0, cnt4 = 0, cnt5 = 0, cnt6 = 0, cnt7 = 0;
    float rb[8];
    if (MODE == 1) {
#pragma unroll
        for (int e = 0; e < 8; ++e) rb[e] = a->in[I_RB][jl * NE + e]; }
    for (int blk = gw; blk < T / 32; blk += F.G * NWAVES) {
        const int r0 = blk * 32, b = r0 >> 12;
        const float* mod = (const float*)(a->ws + WS_MOD) + ((size_t)layer * 16 + b) * 6144;
        f32x4 CA[4], CB[4], G2[4];
#pragma unroll
        for (int j = 0; j < 4; ++j) { const int c = 256 * j + 4 * lane; const f32x4 g = *(const f32x4*)(ngain + c);
            if (MODE == 3) { CA[j] = g; CB[j] = (f32x4){0.f, 0.f, 0.f, 0.f}; }
            else if (MODE == 0 && layer == 0 && sub == 0) {
                f32x4 sh = *(const f32x4*)(a->in[I_ADAB] + c), sc = *(const f32x4*)(a->in[I_ADAB] + 1024 + c);
#pragma unroll
                for (int ks = 0; ks < 8; ++ks) { const float* pp = (const float*)(a->ws + WS_MODP) + ((size_t)(ks * 4) * 16 + b) * 6144; sh += *(const f32x4*)(pp + c); sc += *(const f32x4*)(pp + 1024 + c); }
                CA[j] = g * (sc + 1.f); CB[j] = sh; }
            else { const f32x4 sh = *(const f32x4*)(mod + sub * 3072 + c), sc = *(const f32x4*)(mod + sub * 3072 + 1024 + c); CA[j] = g * (sc + 1.f); CB[j] = sh; }
            if (MODE >= 2) G2[j] = *(const f32x4*)((const float*)(a->ws + WS_MOD) + ((size_t)(layer - (MODE == 2 ? 1 : 0)) * 16 + b) * 6144 + 5120 + c); }
        u32x4 vnx[4]; u32x2 mnx[4]; i32x2 slnx = (i32x2){0, 0}; f32x2 twnx = (f32x2){0.f, 0.f};
#pragma unroll
        for (int j = 0; j < 4; ++j) { mnx[j] = (u32x2){0u, 0u}; vnx[j] = (u32x4){0u, 0u, 0u, 0u}; }
        { ld_src<SB>(src, XSB, r0, lane, vnx);
          if (addm) { const u32x2* mr = (const u32x2*)(M1 + (size_t)r0 * D) + lane;
#pragma unroll
              for (int j = 0; j < 4; ++j) mnx[j] = __builtin_nontemporal_load(mr + 64 * j); }
          if (MODE >= 2) { slnx = ((const i32x2*)(a->ws + WS_TOKSLOT))[r0]; twnx = ((const f32x2*)(a->ws + WS_TOPW))[r0]; } }
        for (int rr = 0; rr < 32; ++rr) {
            const int row = r0 + rr;
            f32x4 v[4];
#pragma unroll
            for (int j = 0; j < 4; ++j) { const u32x4 rw_ = vnx[j]; if constexpr (SB) v[j] = (f32x4){bflo(rw_.x), bfhi(rw_.x), bflo(rw_.y), bfhi(rw_.y)}; else v[j] = __builtin_bit_cast(f32x4, rw_);
                const u32x2 mw = mnx[j]; v[j] += (f32x4){bflo(mw.x), bfhi(mw.x), bflo(mw.y), bfhi(mw.y)}; }
            const i32x2 sl = slnx; const f32x2 tw = twnx;
            { const int rnx = (rr + 1 < 32) ? row + 1 : row; ld_src<SB>(src, XSB, rnx, lane, vnx);
              if (addm) { const u32x2* mr = (const u32x2*)(M1 + (size_t)rnx * D) + lane;
#pragma unroll
                  for (int j = 0; j < 4; ++j) mnx[j] = __builtin_nontemporal_load(mr + 64 * j); }
              if (MODE >= 2) { slnx = ((const i32x2*)(a->ws + WS_TOKSLOT))[rnx]; twnx = ((const f32x2*)(a->ws + WS_TOPW))[rnx]; } }
            if (MODE >= 2) {
                const bf16_t* YS = (const bf16_t*)(a->ws + WS_R + R_YS);
                const u32x2* y0 = (const u32x2*)(YS + (size_t)sl.x * D) + lane; const u32x2* y1 = (const u32x2*)(YS + (size_t)sl.y * D) + lane;
#pragma unroll
                for (int j = 0; j < 4; ++j) { const u32x2 p = y0[64 * j], q = y1[64 * j];
                    f32x4 m; m[0] = tw.x * bflo(p.x) + tw.y * bflo(q.x); m[1] = tw.x * bfhi(p.x) + tw.y * bfhi(q.x); m[2] = tw.x * bflo(p.y) + tw.y * bflo(q.y); m[3] = tw.x * bfhi(p.y) + tw.y * bfhi(q.y);
                    v[j] += G2[j] * m; }
                if (MODE == 2) {
#pragma unroll
                    for (int j = 0; j < 4; ++j) { u32x2 w; w.x = pk2(v[j][0], v[j][1]); w.y = pk2(v[j][2], v[j][3]); ((u32x2*)(XSB + (size_t)row * D) + lane)[64 * j] = w; } }
            }
            float ss = 0.f;
#pragma unroll
            for (int j = 0; j < 4; ++j) ss += (v[j][0] * v[j][0] + v[j][1] * v[j][1]) + (v[j][2] * v[j][2] + v[j][3] * v[j][3]);
            const float rstd = 1.0f / sqrtf(wave_sum(ss) * (1.f / D) + RMS_EPS);
            f32x4 y[4];
#pragma unroll
            for (int j = 0; j < 4; ++j) y[j] = v[j] * rstd * CA[j] + CB[j];
            if (MODE == 3) {
#pragma unroll
                for (int j = 0; j < 4; ++j) ((f32x4*)(XS + (size_t)row * D) + lane)[64 * j] = y[j];
            } else if ((MODE == 0 && sub == 1 && DENSE_UP_FP8_AT(jl)) || MODE == 1) {
                unsigned* o4 = (unsigned*)((unsigned char*)HN + (size_t)row * D) + lane;
#pragma unroll
                for (int j = 0; j < 4; ++j) o4[64 * j] = pg8::pk4_fp8(y[j][0] * pg8::HN_SCALE, y[j][1] * pg8::HN_SCALE, y[j][2] * pg8::HN_SCALE, y[j][3] * pg8::HN_SCALE);
            } else {
                u32x2* o8 = (u32x2*)(HN + (size_t)row * D) + lane;
#pragma unroll
                for (int j = 0; j < 4; ++j) { u32x2 w; w.x = pk2(y[j][0], y[j][1]); w.y = pk2(y[j][2], y[j][3]); o8[64 * j] = w; }
            }
            if (MODE == 1) {
                float lg[8];
#pragma unroll
                for (int e = 0; e < 8; ++e) lg[e] = 0.f;
#pragma unroll
                for (int j = 0; j < 4; ++j)
#pragma unroll
                    for (int q = 0; q < 4; ++q) { const LAS float* wp = rw + (((j * 4 + q) * 2) * 64 + lane) * 4; const f32x4 w0 = *(const LAS f32x4*)(wp), w1 = *(const LAS f32x4*)(wp + 256); const float yv = y[j][q];
                        lg[0] += yv * w0[0]; lg[1] += yv * w0[1]; lg[2] += yv * w0[2]; lg[3] += yv * w0[3]; lg[4] += yv * w1[0]; lg[5] += yv * w1[1]; lg[6] += yv * w1[2]; lg[7] += yv * w1[3];
                        if (q & 1) asm volatile("" ::: "memory"); }
#pragma unroll
                for (int e = 0; e < 8; ++e) lg[e] = wave_sum(lg[e]) + rb[e];
                int e0 = 0; float l0 = lg[0];
#pragma unroll
                for (int e = 1; e < 8; ++e) if (lg[e] > l0) { l0 = lg[e]; e0 = e; }
                int e1 = -1; float l1 = -3.0e38f;
#pragma unroll
                for (int e = 0; e < 8; ++e) if (e != e0 && lg[e] > l1) { l1 = lg[e]; e1 = e; }
                const float w0 = 1.f / (1.f + __expf(l1 - l0)), w1 = 1.f - w0;
                if (lane == 0) { ((int*)(a->ws + WS_TOPE))[row] = e0 | (e1 << 8); ((f32x2*)(a->ws + WS_TOPW))[row] = (f32x2){w0, w1}; }
                cnt0 += (e0 == 0) + (e1 == 0); cnt1 += (e0 == 1) + (e1 == 1); cnt2 += (e0 == 2) + (e1 == 2); cnt3 += (e0 == 3) + (e1 == 3);
                cnt4 += (e0 == 4) + (e1 == 4); cnt5 += (e0 == 5) + (e1 == 5); cnt6 += (e0 == 6) + (e1 == 6); cnt7 += (e0 == 7) + (e1 == 7);
            }
        }
        if (MODE == 1) {
            const int cv = lane == 0 ? cnt0 : lane == 1 ? cnt1 : lane == 2 ? cnt2 : lane == 3 ? cnt3 : lane == 4 ? cnt4 : lane == 5 ? cnt5 : lane == 6 ? cnt6 : cnt7;
            if (lane < 8) ((int*)(a->ws + WS_HIST))[blk * 8 + lane] = cv;
            cnt0 = cnt1 = cnt2 = cnt3 = cnt4 = cnt5 = cnt6 = cnt7 = 0;
        }
    }
}

DI void ph_lru_tables(int wv, int jl) {
    const CArgs* a = kargs(); const Frame F = make_frame(wv); asm volatile("" : "+s"(jl));
    const float* MODL = (const float*)(a->ws + WS_MOD) + (size_t)(2 * jl + 1) * 16 * 6144;
    for (int idx = F.vcu * NTHR + F.tid; idx < 16 * D; idx += F.G * NTHR) { const int col = idx & (D - 1), b = idx >> 10;
        ((float*)(a->ws + WS_CA1))[(size_t)jl * 16 * D + idx] = a->in[I_NORMG][(size_t)((2 * jl + 1) * 2) * D + col] * (1.f + MODL[(size_t)b * 6144 + 1024 + col]); }
    LAS float* shl = (LAS float*)(F.lds + F.wave * 8192);
    for (int it = F.vcu * NWAVES + F.wave; it < 64; it += F.G * NWAVES) { const int ks = it & 7, cg = it >> 3, lane = F.lane;
        const float* W = a->in[I_LWIN] + (size_t)jl * D * 2 * D + (size_t)(ks * 128) * (2 * D) + cg * 256 + lane * 4;
        for (int idx = lane; idx < 16 * 128; idx += 64) shl[idx] = MODL[(size_t)(idx >> 7) * 6144 + ks * 128 + (idx & 127)];
        LDS_WAIT(); asm volatile("" ::: "memory");
        f32x4 acc[16];
#pragma unroll
        for (int b = 0; b < 16; ++b) acc[b] = (f32x4){0.f, 0.f, 0.f, 0.f};
        for (int k0 = 0; k0 < 128; k0 += 16) { f32x4 w4[16];
#pragma unroll
            for (int kk = 0; kk < 16; ++kk) w4[kk] = *(const f32x4*)(W + (size_t)(k0 + kk) * (2 * D));
#pragma unroll
            for (int kk = 0; kk < 16; ++kk)
#pragma unroll
                for (int b = 0; b < 16; ++b) acc[b] += w4[kk] * shl[b * 128 + k0 + kk]; }
        float* o = (float*)(a->ws + WS_BIASP) + ((size_t)(jl * 8 + ks) * 16) * 2048 + cg * 256 + lane * 4;
#pragma unroll
        for (int b = 0; b < 16; ++b) *(f32x4*)(o + (size_t)b * 2048) = acc[b];
        LDS_WAIT(); asm volatile("" ::: "memory"); }
}
DI void ph_slots(int wv) {
    const CArgs* a = kargs(); const Frame F = make_frame(wv);
    LAS int* H = (LAS int*)F.lds;
    const int* HIST = (const int*)(a->ws + WS_HIST);
    for (int idx = F.tid; idx < 2048 * 8; idx += NTHR) H[idx] = HIST[idx];
    __syncthreads();
    const int lane = F.lane;
    int* SLOTTOK = (int*)(a->ws + WS_SLOTTOK); i32x2* TOKSLOT = (i32x2*)(a->ws + WS_TOKSLOT); const int* TOPE = (const int*)(a->ws + WS_TOPE);
    for (int blk = F.vcu * NWAVES + F.wave; blk < T / 32; blk += F.G * NWAVES) {
        int tot[8], pre[8];
#pragma unroll
        for (int e = 0; e < 8; ++e) { tot[e] = 0; pre[e] = 0; }
#pragma unroll 2
        for (int bb = lane; bb < 2048; bb += 64) { const LAS int* hp = H + ((bb * 8) ^ ((bb >> 2) & 4) * 0);
            typedef int i32x4 __attribute__((ext_vector_type(4)));
            const i32x4 h0 = *(const LAS i32x4*)(hp), h1 = *(const LAS i32x4*)(hp + 4); const bool lt = bb < blk;
            tot[0] += h0[0]; tot[1] += h0[1]; tot[2] += h0[2]; tot[3] += h0[3]; tot[4] += h1[0]; tot[5] += h1[1]; tot[6] += h1[2]; tot[7] += h1[3];
            pre[0] += lt ? h0[0] : 0; pre[1] += lt ? h0[1] : 0; pre[2] += lt ? h0[2] : 0; pre[3] += lt ? h0[3] : 0; pre[4] += lt ? h1[0] : 0; pre[5] += lt ? h1[1] : 0; pre[6] += lt ? h1[2] : 0; pre[7] += lt ? h1[3] : 0;
            asm volatile("" ::: "memory"); }
#pragma unroll
        for (int e = 0; e < 8; ++e) { tot[e] = wave_sum_i(tot[e]); pre[e] = wave_sum_i(pre[e]); }
        int sb[8]; int ts = 0;
#pragma unroll
        for (int e = 0; e < 8; ++e) { sb[e] = ts * 256; ts += (tot[e] + 255) >> 8; }
        const int row = blk * 32 + (lane & 31);
        int e0 = 255, e1 = 255;
        if (lane < 32) { const int pe = TOPE[row]; e0 = pe & 255; e1 = (pe >> 8) & 255; }
        int s0 = 0, s1 = 0;
        const unsigned long long below = (1ull << lane) - 1ull;
#pragma unroll
        for (int e = 0; e < 8; ++e) { const unsigned long long m = __ballot(e0 == e || e1 == e); const int rank = __popcll(m & below);
            if (e0 == e) s0 = sb[e] + pre[e] + rank; if (e1 == e) s1 = sb[e] + pre[e] + rank; }
        if (lane < 32) { SLOTTOK[s0] = row; SLOTTOK[s1] = row; TOKSLOT[row] = (i32x2){s0, s1}; }
        if (blk < 8) {
            int sbe = 0, tote = 0;
#pragma unroll
            for (int e = 0; e < 8; ++e) if (e == blk) { sbe = sb[e]; tote = tot[e]; }
            const int end = sbe + (((tote + 255) >> 8) << 8);
            for (int s = sbe + tote + lane; s < end; s += 64) SLOTTOK[s] = 0;
        }
        if (blk == 0 && lane == 0) { unsigned* META = (unsigned*)(a->ws + WS_CTL) + CW_META; int t2 = 0;
#pragma unroll
            for (int e = 0; e < 8; ++e) { META[1 + e] = (unsigned)t2; t2 += (tot[e] + 255) >> 8; }
            META[9] = (unsigned)t2; META[0] = (unsigned)t2; }
    }
}

DI bf16x8 gather8(const LAS bf16_t* p, int stride) {
    u32x4 w;
#pragma unroll
    for (int q = 0; q < 4; ++q) w[q] = (unsigned)p[(2 * q) * stride] | ((unsigned)p[(2 * q + 1) * stride] << 16);
    return __builtin_bit_cast(bf16x8, w);
}
#define CHAIN_BAR() do { asm volatile("s_waitcnt lgkmcnt(0)" ::: "memory"); __builtin_amdgcn_s_barrier(); asm volatile("" ::: "memory"); } while (0)
DI void tr_frag10(unsigned ak, unsigned av, bf16x8 (&fk)[2], bf16x8 (&fv)[4][2]) {
    u32x2 r[20];
    asm volatile("ds_read_b64_tr_b16 %0, %20\n\tds_read_b64_tr_b16 %1, %20 offset:576\n\tds_read_b64_tr_b16 %2, %20 offset:4608\n\tds_read_b64_tr_b16 %3, %20 offset:5184\n\t"
                 "ds_read_b64_tr_b16 %4, %21\n\tds_read_b64_tr_b16 %5, %21 offset:1088\n\tds_read_b64_tr_b16 %6, %21 offset:8704\n\tds_read_b64_tr_b16 %7, %21 offset:9792\n\t"
                 "ds_read_b64_tr_b16 %8, %21 offset:32\n\tds_read_b64_tr_b16 %9, %21 offset:1120\n\tds_read_b64_tr_b16 %10, %21 offset:8736\n\tds_read_b64_tr_b16 %11, %21 offset:9824\n\t"
                 "ds_read_b64_tr_b16 %12, %21 offset:64\n\tds_read_b64_tr_b16 %13, %21 offset:1152\n\tds_read_b64_tr_b16 %14, %21 offset:8768\n\tds_read_b64_tr_b16 %15, %21 offset:9856\n\t"
                 "ds_read_b64_tr_b16 %16, %21 offset:96\n\tds_read_b64_tr_b16 %17, %21 offset:1184\n\tds_read_b64_tr_b16 %18, %21 offset:8800\n\tds_read_b64_tr_b16 %19, %21 offset:9888\n\ts_waitcnt lgkmcnt(0)"
                 : "=&v"(r[0]), "=&v"(r[1]), "=&v"(r[2]), "=&v"(r[3]), "=&v"(r[4]), "=&v"(r[5]), "=&v"(r[6]), "=&v"(r[7]), "=&v"(r[8]), "=&v"(r[9]),
                   "=&v"(r[10]), "=&v"(r[11]), "=&v"(r[12]), "=&v"(r[13]), "=&v"(r[14]), "=&v"(r[15]), "=&v"(r[16]), "=&v"(r[17]), "=&v"(r[18]), "=&v"(r[19])
                 : "v"(ak), "v"(av) : "memory");
#define TRCAT(i) __builtin_bit_cast(bf16x8, (u32x4){r[i].x, r[i].y, r[(i) + 1].x, r[(i) + 1].y})
    fk[0] = TRCAT(0); fk[1] = TRCAT(2);
    fv[0][0] = TRCAT(4); fv[0][1] = TRCAT(6); fv[1][0] = TRCAT(8); fv[1][1] = TRCAT(10); fv[2][0] = TRCAT(12); fv[2][1] = TRCAT(14); fv[3][0] = TRCAT(16); fv[3][1] = TRCAT(18);
#undef TRCAT
}
DI void tr_frag2(unsigned a0, unsigned rs, bf16x8& f0, bf16x8& f1) {
    u32x2 r0, r1, r2, r3; const unsigned a1 = a0 + 4u * rs, a2 = a0 + 32u * rs, a3 = a0 + 36u * rs;
    asm volatile("ds_read_b64_tr_b16 %0, %4\n\tds_read_b64_tr_b16 %1, %5\n\tds_read_b64_tr_b16 %2, %6\n\tds_read_b64_tr_b16 %3, %7\n\ts_waitcnt lgkmcnt(0)"
                 : "=&v"(r0), "=&v"(r1), "=&v"(r2), "=&v"(r3) : "v"(a0), "v"(a1), "v"(a2), "v"(a3) : "memory");
    u32x4 w0, w1; w0.x = r0.x; w0.y = r0.y; w0.z = r1.x; w0.w = r1.y; w1.x = r2.x; w1.y = r2.y; w1.z = r3.x; w1.w = r3.y;
    f0 = __builtin_bit_cast(bf16x8, w0); f1 = __builtin_bit_cast(bf16x8, w1);
}
DI void ph_moe_convert(int wv, int jl) {
    const CArgs* a = kargs(); const Frame F = make_frame(wv); asm volatile("" : "+s"(jl));
    LAS float* scr = (LAS float*)(F.lds + F.wave * 8448);
    const int nw = ((int)gridDim.x - BATCH * ML_H) * NWAVES;
    const int cw0 = ((int)blockIdx.x - BATCH * ML_H) * NWAVES + F.wave;
    if (jl == 0) {
        LAS float* cact = (LAS float*)(F.lds + 8 * 8448);
        for (int idx = F.tid; idx < 16 * D; idx += NTHR) { const float c = a->in[I_C][idx]; cact[idx] = c * sigmoid_f(c); }
        __syncthreads();
        if (F.wave == 0 && (int)blockIdx.x - BATCH * ML_H < 96) mod_item_full(a, (int)blockIdx.x - BATCH * ML_H, cact, F.lane);
        for (int idx = cw0 * 64 + F.lane; idx < 2 * D; idx += nw * 64) ((float*)(a->ws + WS_SP))[idx] = log1p_exp_neg(a->in[I_LAP][idx]);
    }
    const int first = jl == 0 ? CI0 : CI_PER_J + CI0, end = jl == 0 ? CI_PER_J + CI0 : 2 * CI_PER_J;
    if (jl == 0) { if (F.wave != 0) conv_stream(a, first + ((int)blockIdx.x - BATCH * ML_H) * (NWAVES - 1) + F.wave - 1, ((int)gridDim.x - BATCH * ML_H) * (NWAVES - 1), end, scr, F.lane); }
    else conv_stream(a, first + cw0, nw, end, scr, F.lane);
}
DI float dpp_f(float v, int ctrl_sel) {
    const int x = __builtin_bit_cast(int, v); int r;
    if (ctrl_sel == 0) r = __builtin_amdgcn_update_dpp(x, x, 0xB1, 0xf, 0xf, true); else if (ctrl_sel == 1) r = __builtin_amdgcn_update_dpp(x, x, 0x4E, 0xf, 0xf, true);
    else if (ctrl_sel == 2) r = __builtin_amdgcn_update_dpp(x, x, 0x141, 0xf, 0xf, true); else r = __builtin_amdgcn_update_dpp(x, x, 0x140, 0xf, 0xf, true);
    return __builtin_bit_cast(float, r); }
DI float row16_sum(float p) { p += dpp_f(p, 0); p += dpp_f(p, 1); p += dpp_f(p, 2); p += dpp_f(p, 3); return p; }
DI unsigned cvtpk(float lo, float hi) { unsigned r; asm("v_cvt_pk_bf16_f32 %0, %1, %2" : "=v"(r) : "v"(lo), "v"(hi)); return r; }
DI void ph_mlstm(int wv, int jl) {
    const CArgs* a = kargs(); const Frame F = make_frame(wv); asm volatile("" : "+s"(jl));
    const int chain = blockIdx.x, b = chain >> 3, h = chain & 7;
    const int tid = F.tid, lane = F.lane, w = F.wave, fr = lane & 15, fq = lane >> 4;
    LAS bf16_t* Qs = (LAS bf16_t*)(F.lds);
    LAS bf16_t* Ks = (LAS bf16_t*)(F.lds + 9216);
    LAS bf16_t* Vs = (LAS bf16_t*)(F.lds + 18432);
    LAS bf16_t* Sp = (LAS bf16_t*)(F.lds + 35840);
    LAS bf16_t* CT = (LAS bf16_t*)(F.lds + 45056);
    LAS bf16_t* Hs = (LAS bf16_t*)(F.lds + 63488);
    LAS float* nvec = (LAS float*)(F.lds + 80896);
    LAS float* rss = nvec + 64;
    LAS float* npart = nvec + 192;
    LAS float* GA = (LAS float*)(F.lds + 86016);
    LAS float* GB = GA + 4096;
    LAS float* GP = GA + 8192;
    LAS float* MR = GA + 12288;
    const bf16_t* Qg = (const bf16_t*)(a->ws + WS_R + R_Q) + (size_t)b * SEQ * 512 + h * 64;
    const bf16_t* Kg = (const bf16_t*)(a->ws + WS_R + R_K) + (size_t)b * SEQ * 512 + h * 64;
    const bf16_t* Vg = (const bf16_t*)(a->ws + WS_R + R_V) + (size_t)b * SEQ * 1024 + h * 128;
    const bf16_t* Og = (const bf16_t*)(a->ws + WS_R + R_O) + (size_t)b * SEQ * 1024 + h * 128;
    bf16_t* Hg = (bf16_t*)(a->ws + WS_R + R_HS) + (size_t)b * SEQ * 1024 + h * 128;
    const float* Gg = (const float*)(a->ws + WS_GATES) + (size_t)b * SEQ * 16 + h;
    const int qrow = tid >> 3, qch = tid & 7;
    u32x4 qreg, kreg, vreg[2], oreg[2], qN, kN, vN[2];
    qreg = *(const u32x4*)(Qg + (size_t)qrow * 512 + qch * 8); kreg = *(const u32x4*)(Kg + (size_t)qrow * 512 + qch * 8);
    qN = *(const u32x4*)(Qg + (size_t)(CHK + qrow) * 512 + qch * 8); kN = *(const u32x4*)(Kg + (size_t)(CHK + qrow) * 512 + qch * 8);
#pragma unroll
    for (int i = 0; i < 2; ++i) { const int id = tid + 512 * i; vreg[i] = *(const u32x4*)(Vg + (size_t)(id >> 4) * 1024 + (id & 15) * 8); oreg[i] = (u32x4){0u, 0u, 0u, 0u};
        vN[i] = *(const u32x4*)(Vg + (size_t)(CHK + (id >> 4)) * 1024 + (id & 15) * 8); }
    for (int idx = tid; idx < 128 * 72 / 2; idx += NTHR) ((LAS unsigned*)CT)[idx] = 0u;
    if (tid < 64) nvec[tid] = 0.f;
    for (int cc = 0; cc < 8; ++cc) { const int c = 8 * w + cc; const float gi = Gg[(size_t)(c * CHK + lane) * 16], gf = Gg[(size_t)(c * CHK + lane) * 16 + 8];
        float bsum = gf;
#pragma unroll
        for (int o = 1; o < 64; o <<= 1) { const float t = __shfl_up(bsum, o); if (lane >= o) bsum += t; }
        const float av = gi - bsum; float pm = av;
#pragma unroll
        for (int o = 1; o < 64; o <<= 1) { const float t = __shfl_up(pm, o); if (lane >= o) pm = fmaxf(pm, t); }
        GA[c * 64 + lane] = av; GB[c * 64 + lane] = bsum; GP[c * 64 + lane] = pm; }
    __syncthreads();
    if (tid == 0) { float m = 0.f; MR[0] = 0.f; for (int c = 0; c < 64; ++c) { m = GB[c * 64 + 63] + fmaxf(m, GP[c * 64 + 63]); MR[c + 1] = m; } }
    const int ti = w >> 1, vi0 = 4 * (w & 1);
    const int trq = (lane & 15) >> 2, trp = lane & 3;
    const unsigned vs_tr = (unsigned)(size_t)Vs + (unsigned)(((8 * fq + trq) * 136 + 16 * vi0 + 4 * trp) * 2);
    const unsigned ks_tr = (unsigned)(size_t)Ks + (unsigned)(((8 * fq + trq) * 72 + 16 * ti + 4 * trp) * 2);
    float hg[4];
#pragma unroll
    for (int x = 0; x < 4; ++x) hg[x] = a->in[I_MLHG][(size_t)jl * 1024 + h * 128 + 16 * (vi0 + x) + fr];
    f32x4 Cacc[4];
#pragma unroll
    for (int x = 0; x < 4; ++x) Cacc[x] = (f32x4){0.f, 0.f, 0.f, 0.f};
    __syncthreads();
    for (int c = 0; c <= SEQ / CHK; ++c) {
        const int r0 = c * CHK;
        if (c < SEQ / CHK) {
            *(LAS u32x4*)(Qs + qrow * 72 + qch * 8) = qreg; *(LAS u32x4*)(Ks + qrow * 72 + qch * 8) = kreg;
#pragma unroll
            for (int i = 0; i < 2; ++i) { const int id = tid + 512 * i; *(LAS u32x4*)(Vs + (id >> 4) * 136 + (id & 15) * 8) = vreg[i]; }
            if (w == 0 && c > 0) { const float mp = MR[c - 1]; float n = nvec[lane] * __expf(mp - fmaxf(mp, GP[(c - 1) * 64 + 63]));
#pragma unroll
                for (int sp = 0; sp < 8; ++sp) n += npart[sp * 64 + lane];
                nvec[lane] = n; }
            CHAIN_BAR();
            {
                const int si = w >> 1; const float mr = MR[c];
                bf16x8 ak[2];
#pragma unroll
                for (int kk = 0; kk < 2; ++kk) ak[kk] = *(const LAS bf16x8*)(Ks + (16 * si + fr) * 72 + 32 * kk + 8 * fq);
                const f32x4 a4 = *(const LAS f32x4*)(GA + c * 64 + 16 * si + 4 * fq);
#pragma unroll
                for (int tt = 0; tt < 2; ++tt) { const int tj = 2 * (w & 1) + tt;
                    f32x4 s4 = (f32x4){0.f, 0.f, 0.f, 0.f};
#pragma unroll
                    for (int kk = 0; kk < 2; ++kk) { const bf16x8 bq = *(const LAS bf16x8*)(Qs + (16 * tj + fr) * 72 + 32 * kk + 8 * fq); s4 = __builtin_amdgcn_mfma_f32_16x16x32_bf16(ak[kk], bq, s4, 0, 0, 0); }
                    const int t = 16 * tj + fr; const float Mt = fmaxf(mr, GP[c * 64 + t]); float vv[4];
#pragma unroll
                    for (int r = 0; r < 4; ++r) { const int s = 16 * si + 4 * fq + r; vv[r] = (s <= t) ? s4[r] * __expf(a4[r] - Mt) : 0.f; }
                    u32x2 pw; pw.x = cvtpk(vv[0], vv[1]); pw.y = cvtpk(vv[2], vv[3]);
                    *(LAS u32x2*)(Sp + t * 72 + 16 * si + 4 * fq) = pw; }
            }
            CHAIN_BAR();
        }
        else CHAIN_BAR();
        if (c > 0) {
#pragma unroll
            for (int i = 0; i < 2; ++i) { const int id = tid + 512 * i, row = id >> 4, ch = id & 15;
                const u32x4 hs = *(const LAS u32x4*)(Hs + row * 136 + ch * 8); u32x4 o;
#pragma unroll
                for (int q = 0; q < 4; ++q) o[q] = cvtpk(bflo(hs[q]) * bflo(oreg[i][q]), bfhi(hs[q]) * bfhi(oreg[i][q]));
                *(u32x4*)(Hg + (size_t)(r0 - CHK + row) * 1024 + ch * 8) = o; }
        }
        if (c == SEQ / CHK) break;
        {
            const int rn = (c + 2 < SEQ / CHK) ? r0 + 2 * CHK : r0;
            qreg = qN; kreg = kN; vreg[0] = vN[0]; vreg[1] = vN[1];
            qN = *(const u32x4*)(Qg + (size_t)(rn + qrow) * 512 + qch * 8); kN = *(const u32x4*)(Kg + (size_t)(rn + qrow) * 512 + qch * 8);
#pragma unroll
            for (int i = 0; i < 2; ++i) { const int id = tid + 512 * i; vN[i] = *(const u32x4*)(Vg + (size_t)(rn + (id >> 4)) * 1024 + (id & 15) * 8);
                oreg[i] = *(const u32x4*)(Og + (size_t)(r0 + (id >> 4)) * 1024 + (id & 15) * 8); }
        }
        float hv[4][4];
        {
            const float mr = MR[c]; const float M63 = fmaxf(mr, GP[c * 64 + 63]); const float decay = __expf(mr - M63);
            float den[4], et[4], enm[4];
            {
                const f32x4 n4 = *(const LAS f32x4*)(nvec + 4 * fr);
                const f32x4 p4 = *(const LAS f32x4*)(GP + c * 64 + 16 * ti + 4 * fq), b4 = *(const LAS f32x4*)(GB + c * 64 + 16 * ti + 4 * fq);
#pragma unroll
                for (int r = 0; r < 4; ++r) { const int t = 16 * ti + 4 * fq + r;
                    const u32x2 sp = *(const LAS u32x2*)(Sp + t * 72 + 4 * fr), qq = *(const LAS u32x2*)(Qs + t * 72 + 4 * fr);
                    const float ssum = (bflo(sp.x) + bfhi(sp.x)) + (bflo(sp.y) + bfhi(sp.y));
                    const float qn = (bflo(qq.x) * n4[0] + bfhi(qq.x) * n4[1]) + (bflo(qq.y) * n4[2] + bfhi(qq.y) * n4[3]);
                    const float Mt = fmaxf(mr, p4[r]); et[r] = __expf(mr - Mt); enm[r] = __expf(-(b4[r] + Mt));
                    float p = ssum + et[r] * qn;
                    p = row16_sum(p);
                    den[r] = __builtin_amdgcn_rcpf(fmaxf(fabsf(p), enm[r])); }
            }
            bf16x8 as_[2], aq[2], akw[2], kf[2], bVall[4][2];
            tr_frag10(ks_tr, vs_tr, kf, bVall);
#pragma unroll
            for (int kk = 0; kk < 2; ++kk) { as_[kk] = *(const LAS bf16x8*)(Sp + (16 * ti + fr) * 72 + 32 * kk + 8 * fq); aq[kk] = *(const LAS bf16x8*)(Qs + (16 * ti + fr) * 72 + 32 * kk + 8 * fq); }
            {
                const bf16x8 k0 = kf[0], k1 = kf[1];
#pragma unroll
                for (int kk = 0; kk < 2; ++kk) { const u32x4 kw = __builtin_bit_cast(u32x4, kk ? k1 : k0);
                    const f32x4 a0 = *(const LAS f32x4*)(GA + c * 64 + 32 * kk + 8 * fq), a1 = *(const LAS f32x4*)(GA + c * 64 + 32 * kk + 8 * fq + 4);
                    u32x4 pk; pk.x = cvtpk(bflo(kw.x) * __expf(a0[0] - M63), bfhi(kw.x) * __expf(a0[1] - M63)); pk.y = cvtpk(bflo(kw.y) * __expf(a0[2] - M63), bfhi(kw.y) * __expf(a0[3] - M63));
                    pk.z = cvtpk(bflo(kw.z) * __expf(a1[0] - M63), bfhi(kw.z) * __expf(a1[1] - M63)); pk.w = cvtpk(bflo(kw.w) * __expf(a1[2] - M63), bfhi(kw.w) * __expf(a1[3] - M63));
                    akw[kk] = __builtin_bit_cast(bf16x8, pk); }
            }
            float ssq[4] = {0.f, 0.f, 0.f, 0.f};
#pragma unroll
            for (int x = 0; x < 4; ++x) { const int vi = vi0 + x;
                bf16x8 bV[2], bC[2]; bV[0] = bVall[x][0]; bV[1] = bVall[x][1];
#pragma unroll
                for (int kk = 0; kk < 2; ++kk) bC[kk] = *(const LAS bf16x8*)(CT + (16 * vi + fr) * 72 + 32 * kk + 8 * fq);
                f32x4 a1 = (f32x4){0.f, 0.f, 0.f, 0.f}, a2 = (f32x4){0.f, 0.f, 0.f, 0.f};
                a1 = __builtin_amdgcn_mfma_f32_16x16x32_bf16(as_[0], bV[0], a1, 0, 0, 0); a1 = __builtin_amdgcn_mfma_f32_16x16x32_bf16(as_[1], bV[1], a1, 0, 0, 0);
                a2 = __builtin_amdgcn_mfma_f32_16x16x32_bf16(aq[0], bC[0], a2, 0, 0, 0); a2 = __builtin_amdgcn_mfma_f32_16x16x32_bf16(aq[1], bC[1], a2, 0, 0, 0);
                Cacc[x] = Cacc[x] * decay;
                Cacc[x] = __builtin_amdgcn_mfma_f32_16x16x32_bf16(akw[0], bV[0], Cacc[x], 0, 0, 0); Cacc[x] = __builtin_amdgcn_mfma_f32_16x16x32_bf16(akw[1], bV[1], Cacc[x], 0, 0, 0);
#pragma unroll
                for (int r = 0; r < 4; ++r) { const float hh = (a1[r] + et[r] * a2[r]) * den[r]; hv[x][r] = hh; ssq[r] += hh * hh; } }
#pragma unroll
            for (int r = 0; r < 4; ++r) { const float p = row16_sum(ssq[r]);
                if (fr == 0) rss[(16 * ti + 4 * fq + r) * 2 + (w & 1)] = p; }
            { float pn = 0.f; const int d = tid & 63; const f32x4 a0 = *(const LAS f32x4*)(GA + c * 64 + 8 * w), a1 = *(const LAS f32x4*)(GA + c * 64 + 8 * w + 4);
#pragma unroll
              for (int s = 0; s < 8; ++s) pn += __expf((s < 4 ? a0[s & 3] : a1[s & 3]) - M63) * bf2f(Ks[(8 * w + s) * 72 + d]);
              npart[w * 64 + d] = pn; }
        }
        CHAIN_BAR();
        {
#pragma unroll
            for (int r = 0; r < 4; ++r) { const int t = 16 * ti + 4 * fq + r; const float rstd = __builtin_amdgcn_rsqf((rss[t * 2] + rss[t * 2 + 1]) * (1.f / DV) + RMS_EPS);
#pragma unroll
                for (int x = 0; x < 4; ++x) Hs[t * 136 + 16 * (vi0 + x) + fr] = (bf16_t)f2bf(hv[x][r] * rstd * hg[x]); }
#pragma unroll
            for (int x = 0; x < 4; ++x) { u32x2 pw; pw.x = cvtpk(Cacc[x][0], Cacc[x][1]); pw.y = cvtpk(Cacc[x][2], Cacc[x][3]);
                *(LAS u32x2*)(CT + (16 * (vi0 + x) + fr) * 72 + 16 * ti + 4 * fq) = pw; }
        }
    }
}

DI void ph_conv(int wv, int jl) {
    const CArgs* a = kargs(); const Frame F = make_frame(wv); asm volatile("" : "+s"(jl));
    const bf16_t* XRH = (const bf16_t*)(a->ws + WS_R + R_XR); bf16_t* XC = (bf16_t*)(a->ws + WS_R + R_XC);
    for (int it = F.vcu * NTHR + F.tid; it < (T / 64) * 3 * 128; it += F.G * NTHR) {
        const int chg = it & 127, i = (it >> 7) % 3, blk = it / (3 * 128), c0 = chg * 8;
        const u32x4 z = (u32x4){0u, 0u, 0u, 0u}; u32x4 x[4];
#pragma unroll
        for (int j = 0; j < 4; ++j) { const int rel = i - 3 + j;
            if (rel >= 0) x[j] = *(const u32x4*)(XRH + ((size_t)blk * 6 + rel) * D + c0);
            else if ((blk & 63) == 0) x[j] = z;
            else x[j] = *(const u32x4*)(XRH + ((size_t)(blk - 1) * 6 + 6 + rel) * D + c0); }
        u32x4 o;
#pragma unroll
        for (int q = 0; q < 4; ++q) { float lo = a->in[I_LCB][jl * D + c0 + 2 * q], hi = a->in[I_LCB][jl * D + c0 + 2 * q + 1];
#pragma unroll
            for (int j = 0; j < 4; ++j) { lo += a->in[I_LCW][((size_t)jl * 4 + j) * D + c0 + 2 * q] * bflo(x[j][q]); hi += a->in[I_LCW][((size_t)jl * 4 + j) * D + c0 + 2 * q + 1] * bfhi(x[j][q]); }
            o[q] = pk2(lo, hi); }
        *(u32x4*)(XC + (size_t)(blk * 64 + i) * D + c0) = o;
    }
}
constexpr int SEGL = 128, NSEG = SEQ / SEGL;
DI void ph_scan(int wv) {
    const CArgs* a = kargs(); const Frame F = make_frame(wv);
    const bf16_t* LA = (const bf16_t*)(a->ws + WS_R + R_LA); const bf16_t* U = (const bf16_t*)(a->ws + WS_R + R_U);
    const bf16_t* GB = (const bf16_t*)(a->ws + WS_R + R_GB); bf16_t* Y = (bf16_t*)(a->ws + WS_R + R_XR);
    const f32x4* CAR = (const f32x4*)(a->ws + WS_MODP);
    for (int gid = F.vcu * NTHR + F.tid; gid < BATCH * NSEG * 256; gid += F.G * NTHR) {
        const int c4 = gid & 255, seg = (gid >> 8) & (NSEG - 1), b = gid >> 13;
        const size_t base = ((size_t)b * SEQ + seg * SEGL) * D + 4 * c4;
        f32x4 h = (f32x4){0.f, 0.f, 0.f, 0.f};
#pragma unroll 4
        for (int blk = 0; blk < 2 * seg; ++blk) { const f32x4 p = CAR[((size_t)(b * 64 + blk) * 256 + c4) * 2], q = CAR[((size_t)(b * 64 + blk) * 256 + c4) * 2 + 1];
            h[0] = p[0] * h[0] + p[1]; h[1] = p[2] * h[1] + p[3]; h[2] = q[0] * h[2] + q[1]; h[3] = q[2] * h[3] + q[3]; }
#pragma unroll 8
        for (int r = 0; r < SEGL; ++r) { const u32x2 la = *(const u32x2*)(LA + base + (size_t)r * D), uu = *(const u32x2*)(U + base + (size_t)r * D);
            h[0] = __expf(bflo(la.x)) * h[0] + bflo(uu.x); h[1] = __expf(bfhi(la.x)) * h[1] + bfhi(uu.x); h[2] = __expf(bflo(la.y)) * h[2] + bflo(uu.y); h[3] = __expf(bfhi(la.y)) * h[3] + bfhi(uu.y);
            const u32x2 g = *(const u32x2*)(GB + base + (size_t)r * D); u32x2 o; o.x = pk2(h[0] * bflo(g.x), h[1] * bfhi(g.x)); o.y = pk2(h[2] * bflo(g.y), h[3] * bfhi(g.y));
            *(u32x2*)(Y + base + (size_t)r * D) = o; }
    }
}

#define PH_COMMON(jl) const CArgs* a = kargs(); const Frame F = make_frame(wv); asm volatile("" : "+s"(jl)); unsigned char* ws = a->ws; unsigned char* R = ws + WS_R; \
    const bf16_t* Wj = (const bf16_t*)(ws + WS_W) + (size_t)jl * W_PER_J; const bf16_t* HN = (const bf16_t*)(ws + WS_HN); float* XS = a->out; const float* MOD = (const float*)(ws + WS_MOD); \
    int bx = blockIdx.x; asm volatile("" : "+s"(bx)); (void)R; (void)Wj; (void)HN; (void)XS; (void)MOD
DI void ph_mlstm_gates(int wv, int jl) {
    const CArgs* a = kargs(); const Frame F = make_frame(wv); asm volatile("" : "+s"(jl));
    const bf16_t* HN = (const bf16_t*)(a->ws + WS_HN); float* G = (float*)(a->ws + WS_GATES);
    const bf16_t* Wg = (const bf16_t*)(a->ws + WS_W) + (size_t)jl * W_PER_J + W_WIN + (size_t)3072 * D;
    const int lane = F.lane, fr = lane & 15, fq = lane >> 4;
    { const int row = F.tid >> 5, ch = F.tid & 31;
#pragma unroll
      for (int q = 0; q < 4; ++q) *(LAS u32x4*)(F.lds + row * 2064 + ch * 64 + q * 16) = *(const u32x4*)(Wg + (size_t)row * D + ch * 32 + q * 8); }
    __syncthreads();
    const float bias = a->in[I_MLGB][jl * 16 + fr];
    float ln2s = 0.69314718f; asm volatile("" : "+s"(ln2s));
    const LAS unsigned char* bp = F.lds + fr * 2064 + fq * 16;
    for (int tile = F.vcu; tile < T / 256; tile += F.G) {
        const int R0 = tile * 256 + F.wave * 32;
        const bf16_t* a0 = HN + (size_t)(R0 + fr) * D + fq * 8; const bf16_t* a1 = a0 + (size_t)16 * D;
        f32x4 acc0 = (f32x4){0.f, 0.f, 0.f, 0.f}, acc1 = (f32x4){0.f, 0.f, 0.f, 0.f};
#pragma unroll 8
        for (int s = 0; s < 32; ++s) {
            const bf16x8 af0 = *(const bf16x8*)(a0 + s * 32), af1 = *(const bf16x8*)(a1 + s * 32);
            const bf16x8 bf = *(const LAS bf16x8*)(bp + s * 64);
            acc0 = __builtin_amdgcn_mfma_f32_16x16x32_bf16(af0, bf, acc0, 0, 0, 0); acc1 = __builtin_amdgcn_mfma_f32_16x16x32_bf16(af1, bf, acc1, 0, 0, 0);
        }
#pragma unroll
        for (int r = 0; r < 4; ++r) { float x0 = acc0[r] + bias, x1 = acc1[r] + bias;
            if (fr >= 8) { x0 = fminf(x0, 0.f) - ln2s * __builtin_amdgcn_logf(1.f + __expf(-fabsf(x0))); x1 = fminf(x1, 0.f) - ln2s * __builtin_amdgcn_logf(1.f + __expf(-fabsf(x1))); }
            G[(size_t)(R0 + 4 * fq + r) * 16 + fr] = x0; G[(size_t)(R0 + 16 + 4 * fq + r) * 16 + fr] = x1; }
    }
    __syncthreads();
}
DI void ph_gemm_mlstm_in(int wv, int jl) { PH_COMMON(jl);
    pg8::Gemm g{HN, Wj + W_WIN, D, D, nullptr, 0, 0}; pg8::SchedPlain S; S.init(T / 256, 3072 / 256, F.G, bx);
    pg8::EpiMlstmIn E{(bf16_t*)(R + R_Q), (bf16_t*)(R + R_K), (bf16_t*)(R + R_V), (bf16_t*)(R + R_O), (float*)(ws + WS_GATES), a->in[I_MLGB] + jl * 16};
    pg8::gemm_phase<pg8::EpiMlstmIn, pg8::SchedPlain, false>(F.lds, F.tid, g, S, E); }
DI void ph_gemm_resid(int wv, int jl, int which) { PH_COMMON(jl); asm volatile("" : "+s"(which));
    const int layer = 2 * jl + (which == 2 ? 1 : 0);
    pg8::SchedPlain S; S.init(T / 256, D / 256, F.G, bx);
    if (which != 1) {
        pg8::Gemm g{which == 0 ? (const bf16_t*)(R + R_HS) : (const bf16_t*)(R + R_XR), Wj + (which == 0 ? W_WOUT : W_LOUT), D, D, nullptr, 0, 0};
        pg8::EpiMix E{(bf16_t*)(R + R_M1), MOD + (size_t)layer * 16 * 6144 + 2048};
        pg8::gemm_phase<pg8::EpiMix, pg8::SchedPlain, false>(F.lds, F.tid, g, S, E);
    } else {
#define RESID_ARGS a->in[I_X], (bf16_t*)(R + R_XSB), MOD + (size_t)layer * 16 * 6144 + 5120, (const bf16_t*)(R + R_M1), (const float*)(ws + WS_CA1) + (size_t)jl * 16 * D, (bf16_t*)(ws + WS_HN), (float*)(ws + WS_GATES), F.lds
        if (DENSE_FP8_AT(jl)) { pg8::Gemm g{(const bf16_t*)(R + R_ACT), Wj + W_W2, DFF / 2, DFF / 2, nullptr, pg8::E8_W2, pg8::E8_ACT};
            if (jl == 0) { pg8::EpiResidT<false> E{RESID_ARGS}; pg8::gemm_phase<pg8::EpiResidT<false>, pg8::SchedPlain, false, true>(F.lds, F.tid, g, S, E); }
            else { pg8::EpiResidT<true> E{RESID_ARGS}; pg8::gemm_phase<pg8::EpiResidT<true>, pg8::SchedPlain, false, true>(F.lds, F.tid, g, S, E); } }
        else { pg8::Gemm g{(const bf16_t*)(R + R_ACT), Wj + W_W2, DFF, DFF, nullptr, 0, 0};
            if (jl == 0) { pg8::EpiResidT<false> E{RESID_ARGS}; pg8::gemm_phase<pg8::EpiResidT<false>, pg8::SchedPlain, false>(F.lds, F.tid, g, S, E); }
            else { pg8::EpiResidT<true> E{RESID_ARGS}; pg8::gemm_phase<pg8::EpiResidT<true>, pg8::SchedPlain, false>(F.lds, F.tid, g, S, E); } }
#undef RESID_ARGS
    }
}
DI void ph_gemm_ffn_up(int wv, int jl) { PH_COMMON(jl);
    pg8::SchedPlain S; S.init(T / 256, 2 * DFF / 256, F.G, bx);
    if (DENSE_UP_FP8_AT(jl)) {
        pg8::Gemm g{HN, Wj + W_W13, D / 2, D / 2, nullptr, pg8::E8_W13, pg8::E8_HN};
        if (DENSE_FP8_AT(jl)) { pg8::EpiSwigluT<true> E{(unsigned char*)(R + R_ACT)}; pg8::gemm_phase<pg8::EpiSwigluT<true>, pg8::SchedPlain, false, true>(F.lds, F.tid, g, S, E); }
        else { pg8::EpiSwigluT<false> E{(unsigned char*)(R + R_ACT)}; pg8::gemm_phase<pg8::EpiSwigluT<false>, pg8::SchedPlain, false, true>(F.lds, F.tid, g, S, E); }
    } else {
        pg8::Gemm g{HN, Wj + W_W13, D, D, nullptr, 0, 0};
        if (DENSE_FP8_AT(jl)) { pg8::EpiSwigluT<true> E{(unsigned char*)(R + R_ACT)}; pg8::gemm_phase<pg8::EpiSwigluT<true>, pg8::SchedPlain, false, false>(F.lds, F.tid, g, S, E); }
        else { pg8::EpiSwigluT<false> E{(unsigned char*)(R + R_ACT)}; pg8::gemm_phase<pg8::EpiSwigluT<false>, pg8::SchedPlain, false, false>(F.lds, F.tid, g, S, E); }
    } }
DI void ph_gemm_lru_in(int wv, int jl) { PH_COMMON(jl);
    pg8::Gemm g{HN, Wj + W_LIN, D, D, nullptr, 0, 0}; pg8::SchedPlain S; S.init(T / 256, 2 * D / 256, F.G, bx);
    pg8::EpiLruIn E{(bf16_t*)(R + R_GB), (bf16_t*)(R + R_XC), (bf16_t*)(R + R_XR), a->in[I_LCW] + (size_t)jl * 4 * D, a->in[I_LCB] + (size_t)jl * D, F.lds,
                     (const float*)(ws + WS_GATES), (const float*)(ws + WS_BIASP) + (size_t)jl * 8 * 16 * 2048};
    pg8::gemm_phase<pg8::EpiLruIn, pg8::SchedPlain, false>(F.lds, F.tid, g, S, E); }
DI void ph_gemm_lru_gate(int wv, int jl) { PH_COMMON(jl);
    pg8::Gemm g{(const bf16_t*)(R + R_XC), Wj + W_GW, D, 256, nullptr, 0, 0}; pg8::SchedLruGate S; S.init(T / 256, 8, F.G, bx);
    pg8::EpiLruGate E{(const bf16_t*)(R + R_XC), (bf16_t*)(R + R_LA), (bf16_t*)(R + R_U), a->in[I_LGB] + (size_t)jl * 4 * 512, (const float*)(ws + WS_SP) + jl * D, (float*)(ws + WS_MODP)};
    pg8::gemm_phase<pg8::EpiLruGate, pg8::SchedLruGate, false>(F.lds, F.tid, g, S, E); }
DI void moe_sched(pg8::SchedMoe& S, unsigned char* ws, int& nti) { unsigned* META = (unsigned*)(ws + WS_CTL) + CW_META;
    nti = (int)__hip_atomic_load(META + 0, __ATOMIC_RELAXED, __HIP_MEMORY_SCOPE_AGENT);
    S.ts1 = (int)__hip_atomic_load(META + 2, __ATOMIC_RELAXED, __HIP_MEMORY_SCOPE_AGENT); S.ts2 = (int)__hip_atomic_load(META + 3, __ATOMIC_RELAXED, __HIP_MEMORY_SCOPE_AGENT);
    S.ts3 = (int)__hip_atomic_load(META + 4, __ATOMIC_RELAXED, __HIP_MEMORY_SCOPE_AGENT); S.ts4 = (int)__hip_atomic_load(META + 5, __ATOMIC_RELAXED, __HIP_MEMORY_SCOPE_AGENT);
    S.ts5 = (int)__hip_atomic_load(META + 6, __ATOMIC_RELAXED, __HIP_MEMORY_SCOPE_AGENT); S.ts6 = (int)__hip_atomic_load(META + 7, __ATOMIC_RELAXED, __HIP_MEMORY_SCOPE_AGENT);
    S.ts7 = (int)__hip_atomic_load(META + 8, __ATOMIC_RELAXED, __HIP_MEMORY_SCOPE_AGENT);
    nti = __builtin_amdgcn_readfirstlane(nti); S.ts1 = __builtin_amdgcn_readfirstlane(S.ts1); S.ts2 = __builtin_amdgcn_readfirstlane(S.ts2); S.ts3 = __builtin_amdgcn_readfirstlane(S.ts3);
    S.ts4 = __builtin_amdgcn_readfirstlane(S.ts4); S.ts5 = __builtin_amdgcn_readfirstlane(S.ts5); S.ts6 = __builtin_amdgcn_readfirstlane(S.ts6); S.ts7 = __builtin_amdgcn_readfirstlane(S.ts7); }
DI void ph_gemm_moe_up(int wv, int jl) { PH_COMMON(jl);
    pg8::SchedMoe S; int nti; moe_sched(S, ws, nti);
    pg8::Gemm g{HN, Wj + W_MW13, D / 2, D / 2, (const int*)(ws + WS_SLOTTOK), pg8::E8_W13, pg8::E8_HN}; S.init(nti, 2 * DFF / 256, F.G, bx); S.estride = (size_t)DFF * D;
    pg8::EpiSwiglu E{(unsigned char*)(R + R_ACT)};
    pg8::gemm_phase<pg8::EpiSwiglu, pg8::SchedMoe, true, true>(F.lds, F.tid, g, S, E); }
DI void ph_gemm_moe_down(int wv, int jl) { PH_COMMON(jl);
    pg8::SchedMoe S; int nti; moe_sched(S, ws, nti);
    pg8::Gemm g{(const bf16_t*)(R + R_ACT), Wj + W_MW2, DFF / 2, DFF / 2, nullptr, pg8::E8_W2, pg8::E8_ACT}; S.init(nti, D / 256, F.G, bx); S.estride = (size_t)D * DFF / 2;
    pg8::EpiBf16 E{(bf16_t*)(R + R_YS), D};
    pg8::gemm_phase<pg8::EpiBf16, pg8::SchedMoe, false, true>(F.lds, F.tid, g, S, E); }

constexpr int N_PHASES = 3 + 2 * 18;
#ifndef ONLY
#define ONLY -1
#endif
#define EN(k) (ONLY < 0 || ONLY == (k))
#ifndef DUP_MASK
#define DUP_MASK 0ull
#endif
#define DUP(k) (((DUP_MASK) >> (k)) & 1ull)
DI void seam() { XcdBarrier b; b.bar = (unsigned*)(kargs()->ws + WS_CTL) + CW_BAR; b.x = xb_xcc_id(); b.st = (volatile LAS unsigned*)((LAS unsigned char*)lds_raw + MISC_OFF) + 8; xcd_barrier(b); }
__global__ void __launch_bounds__(NTHR, 2) fwd(Args args) {
    { volatile LAS unsigned* MISC = (volatile LAS unsigned*)((LAS unsigned char*)lds_raw + MISC_OFF);
      if (threadIdx.x < 64) MISC[threadIdx.x] = 0u;
      __syncthreads();
      if (!MK_PER_PHASE) (void)xcd_barrier_post((unsigned*)(args.ws + WS_CTL) + CW_BAR, MISC + 8); }
    const int wv = __builtin_amdgcn_readfirstlane((int)threadIdx.x >> 6);
    const int lo = args.ph_lo, hi = args.ph_hi;
#define IN(k) (lo <= (k) && (k) < hi)
#define SEAM(k) do { if (IN(k) && IN((k) + 1)) seam(); } while (0)
    if (EN(100) && IN(0)) { ph_prologue_a(wv); if (DUP(20)) { __syncthreads(); ph_prologue_a(wv); } }
    SEAM(0);
    if (EN(102) && IN(2)) { row_pass<0, false>(wv, 0, 0, 0, 0, 0, 0); if (DUP(22)) row_pass<0, false>(wv, 0, 0, 0, 0, 0, 0); }
    SEAM(2);
#pragma nounroll
    for (int jl = 0; jl < 2; ++jl) {
        const int P = 3 + 18 * jl, LA_ = 2 * jl, LB_ = 2 * jl + 1;
        if (EN(0) && IN(P + 0)) { ph_mlstm_gates(wv, jl); ph_gemm_mlstm_in(wv, jl); if (DUP(0)) ph_gemm_mlstm_in(wv, jl); }
        SEAM(P + 0);
        if (EN(1) && IN(P + 1)) { if (blockIdx.x >= BATCH * ML_H) { ph_moe_convert(wv, jl); if (DUP(2)) ph_moe_convert(wv, jl); } else { ph_mlstm(wv, jl); if (DUP(1)) { __syncthreads(); ph_mlstm(wv, jl); } } }
        SEAM(P + 1);
        if (EN(2) && IN(P + 2)) ph_gemm_resid(wv, jl, 0);
        SEAM(P + 2);
        if (EN(3) && IN(P + 3)) { ph_lru_tables(wv, jl); if (jl == 0) row_pass<0, false>(wv, 0, LA_ * 2 + 1, LA_, 1, jl, 1); else row_pass<0, true>(wv, 1, LA_ * 2 + 1, LA_, 1, jl, 1); }
        SEAM(P + 3);
        if (EN(4) && IN(P + 4)) { ph_gemm_ffn_up(wv, jl); if (DUP(4)) ph_gemm_ffn_up(wv, jl); }
        SEAM(P + 4);
        if (EN(2) && IN(P + 5)) ph_gemm_resid(wv, jl, 1);
        SEAM(P + 5);
        if (EN(7) && IN(P + 7)) { ph_gemm_lru_in(wv, jl); if (DUP(7)) ph_gemm_lru_in(wv, jl); }
        SEAM(P + 7);
        if (EN(8) && IN(P + 8)) { ph_conv(wv, jl); if (DUP(8)) ph_conv(wv, jl); }
        SEAM(P + 8);
        if (EN(9) && IN(P + 9)) { ph_gemm_lru_gate(wv, jl); if (DUP(9)) ph_gemm_lru_gate(wv, jl); }
        SEAM(P + 9);
        if (EN(11) && IN(P + 11)) { ph_scan(wv); if (DUP(11)) ph_scan(wv); }
        SEAM(P + 11);
        if (EN(2) && IN(P + 12)) ph_gemm_resid(wv, jl, 2);
        SEAM(P + 12);
        if (EN(13) && IN(P + 13)) { row_pass<1, true>(wv, 1, LB_ * 2 + 1, LB_, 1, jl, 1); if (DUP(13)) { __syncthreads(); row_pass<1, true>(wv, 1, LB_ * 2 + 1, LB_, 1, jl, 1); } }
        SEAM(P + 13);
        if (EN(14) && IN(P + 14)) { ph_slots(wv); if (DUP(14)) { __syncthreads(); ph_slots(wv); } }
        SEAM(P + 14);
        if (EN(15) && IN(P + 15)) { ph_gemm_moe_up(wv, jl); if (DUP(15)) ph_gemm_moe_up(wv, jl); }
        SEAM(P + 15);
        if (EN(16) && IN(P + 16)) { ph_gemm_moe_down(wv, jl); if (DUP(16)) ph_gemm_moe_down(wv, jl); }
        SEAM(P + 16);
        if (EN(17) && IN(P + 17)) { if (jl == 0) row_pass<2, true>(wv, 1, (LB_ + 1) * 2 + 0, LB_ + 1, 0, jl, 1); else row_pass<3, true>(wv, 1, -1, LB_, 0, jl, 1); }
        SEAM(P + 17);
    }
#undef IN
#undef SEAM
}

extern "C" void kernel_launch(void* const* d_in, const int* in_sizes, int n_in, void* d_out, int out_size, void* d_ws, size_t ws_size, hipStream_t stream) {
    static int grid = 0;
    if (grid == 0) {
        if (n_in != N_IN || out_size != T * D || ws_size < WS_END) { fprintf(stderr, "kernel_launch: unexpected problem (n_in %d out %d ws %zu, need %zu)\n", n_in, out_size, ws_size, (size_t)WS_END); grid = -1; return; }
        int dev = 0, cus = 0, per_cu = 0;
        if (hipGetDevice(&dev) != hipSuccess || hipDeviceGetAttribute(&cus, hipDeviceAttributeMultiprocessorCount, dev) != hipSuccess) { grid = -1; return; }
        if (hipFuncSetAttribute((const void*)fwd, hipFuncAttributeMaxDynamicSharedMemorySize, LDS_BYTES) != hipSuccess) { fprintf(stderr, "kernel_launch: hipFuncSetAttribute failed\n"); grid = -1; return; }
        if (hipOccupancyMaxActiveBlocksPerMultiprocessor(&per_cu, (const void*)fwd, NTHR, LDS_BYTES) != hipSuccess || per_cu < 1) fprintf(stderr, "kernel_launch: occupancy query says %d\n", per_cu);
        (void)hipGetLastError();
        grid = cus;
    }
    if (grid < 0) return;
    (void)hipMemsetAsync((char*)d_ws + WS_CTL, 0, CTL_ZERO_BYTES, stream);
    Args a{};
    for (int i = 0; i < N_IN; ++i) a.in[i] = (const float*)d_in[i];
    a.out = (float*)d_out; a.ws = (unsigned char*)d_ws;
#if MK_PER_PHASE
    for (int p = 0; p < N_PHASES; ++p) { a.ph_lo = p; a.ph_hi = p + 1; hipLaunchKernelGGL(fwd, dim3(grid), dim3(NTHR), LDS_BYTES, stream, a); }
#else
    a.ph_lo = 0; a.ph_hi = N_PHASES; hipLaunchKernelGGL(fwd, dim3(grid), dim3(NTHR), LDS_BYTES, stream, a);
#endif
}
```

```cpp
#include <hip/hip_runtime.h>
#include <cstdio>
#include <cstdint>

#ifndef DENSE_FP8_MASK
#define DENSE_FP8_MASK 3
#endif
#define DENSE_FP8_AT(jl) (((DENSE_FP8_MASK) >> (jl)) & 1)
#ifndef MK_PER_PHASE
#define MK_PER_PHASE 0
#endif

#define DI __device__ __forceinline__
#define GAS __attribute__((address_space(1)))
#define LAS __attribute__((address_space(3)))
typedef unsigned short bf16_t;
typedef short bf16x8 __attribute__((ext_vector_type(8)));
typedef float f32x4 __attribute__((ext_vector_type(4)));
typedef float f32x2 __attribute__((ext_vector_type(2)));
typedef unsigned u32x4 __attribute__((ext_vector_type(4)));
typedef unsigned u32x2 __attribute__((ext_vector_type(2)));
typedef int i32x2 __attribute__((ext_vector_type(2)));

constexpr int D = 1024, BATCH = 16, SEQ = 4096, T = BATCH * SEQ;
constexpr int ML_H = 8, DV = 128, DQK = 64, CHK = 64, MLP = 3088, MLPP = 3328;
constexpr int DFF = 3584, NE = 8;
constexpr int MAXSLOT = 2 * T + 8 * 256;
constexpr float RMS_EPS = 1e-6f;
constexpr int NWAVES = 8, NTHR = 512;

enum { I_X = 0, I_C, I_ADAW, I_ADAB, I_NORMG, I_MLWIN, I_MLGB, I_MLHG, I_MLWOUT, I_FW13, I_FW2, I_LWIN, I_LCW, I_LCB, I_LGW, I_LGB, I_LAP, I_LWOUT, I_RW, I_RB, I_MW13, I_MW2, I_FNG, N_IN };

constexpr size_t MiB = 1u << 20;
constexpr size_t WS_CTL = 0, CTL_ZERO_BYTES = 1 * MiB;
constexpr size_t WS_MOD = 1 * MiB;
constexpr size_t WS_MODP = 3 * MiB;
constexpr size_t WS_SP = 15 * MiB;
constexpr size_t WS_CA1 = 15 * MiB + 64 * 1024;
constexpr size_t WS_GATES = 16 * MiB;
constexpr size_t WS_BIASP = 20 * MiB;
constexpr size_t WS_TOPE = 22 * MiB;
constexpr size_t WS_TOPW = 22 * MiB + 512 * 1024;
constexpr size_t WS_HIST = 23 * MiB;
constexpr size_t WS_SLOTTOK = 23 * MiB + 256 * 1024;
constexpr size_t WS_TOKSLOT = 24 * MiB;
constexpr size_t WS_W = 32 * MiB;
constexpr size_t WS_HN = 448 * MiB;
constexpr size_t WS_R = 576 * MiB;
constexpr size_t WS_END = WS_R + 1170 * MiB;
constexpr size_t W_WIN = 0, W_WOUT = W_WIN + (size_t)MLPP * D, W_W13 = W_WOUT + (size_t)D * D, W_W2 = W_W13 + (size_t)2 * DFF * D, W_LIN = W_W2 + (size_t)D * DFF,
                 W_GW = W_LIN + (size_t)2 * D * D, W_LOUT = W_GW + (size_t)4 * 512 * 256, W_MW13 = W_LOUT + (size_t)D * D, W_MW2 = W_MW13 + (size_t)NE * 2 * DFF * D, W_PER_J = W_MW2 + (size_t)NE * D * DFF;
static_assert(WS_W + 2 * W_PER_J * 2 <= WS_HN, "weights fit");
constexpr size_t R_Q = 0, R_K = 64 * MiB, R_V = 128 * MiB, R_O = 256 * MiB, R_HS = 384 * MiB;
constexpr size_t R_ACT = 0;
constexpr size_t R_GB = 0, R_XR = 128 * MiB, R_XC = 256 * MiB, R_LA = 384 * MiB, R_U = 512 * MiB;
constexpr size_t R_M1 = 512 * MiB;
constexpr size_t R_XSB = 640 * MiB;
constexpr size_t R_YS = 910 * MiB;
static_assert((size_t)MAXSLOT * DFF * 2 == 910 * MiB, "moe act size");
constexpr int CW_BAR = 4096, CW_META = 8192;

constexpr int LDS_BYTES = 147456, MISC_OFF = 147200;

DI float bf2f(unsigned short b) { return __uint_as_float(((unsigned)b) << 16); }
DI float bflo(unsigned u) { return __uint_as_float(u << 16); }
DI float bfhi(unsigned u) { return __uint_as_float(u & 0xffff0000u); }
DI unsigned f2bf(float f) { unsigned u = __float_as_uint(f); return (u + 0x7fffu + ((u >> 16) & 1u)) >> 16; }
DI unsigned pk2(float lo, float hi) { return f2bf(lo) | (f2bf(hi) << 16); }
DI float sigmoid_f(float x) { return __builtin_amdgcn_rcpf(1.f + __expf(-x)); }
DI float log1p_exp_neg(float x) {
    float ln2 = 0.69314718f; asm volatile("" : "+s"(ln2));
    const float e = __expf(-x), u = 1.f + e, d = u - 1.f;
    return d == 0.f ? e : ln2 * __builtin_amdgcn_logf(u) * (e / d);
}
DI float wave_sum(float v) {
    { const int x = __builtin_bit_cast(int, v); v += __builtin_bit_cast(float, __builtin_amdgcn_update_dpp(x, x, 0xB1, 0xf, 0xf, true)); }
    { const int x = __builtin_bit_cast(int, v); v += __builtin_bit_cast(float, __builtin_amdgcn_update_dpp(x, x, 0x4E, 0xf, 0xf, true)); }
    { const int x = __builtin_bit_cast(int, v); v += __builtin_bit_cast(float, __builtin_amdgcn_update_dpp(x, x, 0x141, 0xf, 0xf, true)); }
    { const int x = __builtin_bit_cast(int, v); v += __builtin_bit_cast(float, __builtin_amdgcn_update_dpp(x, x, 0x140, 0xf, 0xf, true)); }
    const int y = __builtin_bit_cast(int, v);
    const float r0 = __builtin_bit_cast(float, __builtin_amdgcn_readlane(y, 0)), r1 = __builtin_bit_cast(float, __builtin_amdgcn_readlane(y, 16));
    const float r2 = __builtin_bit_cast(float, __builtin_amdgcn_readlane(y, 32)), r3 = __builtin_bit_cast(float, __builtin_amdgcn_readlane(y, 48));
    return (r0 + r1) + (r2 + r3);
}
DI int wave_sum_i(int v) {
#pragma unroll
    for (int o = 1; o < 64; o <<= 1) v += __shfl_xor(v, o);
    return v;
}
#define LDS_WAIT() asm volatile("s_waitcnt lgkmcnt(0)" ::: "memory")

#define XB_TMO      128
#define XB_XCNT(j)  (256  + 64 * (j))
#define XB_XSUB(j)  (1280 + 64 * (j))
#define XB_XGEN(j)  (2304 + 64 * (j))
#define XB_TOP      3328
#define XB_TOPGEN   3392
#define XCD_BAR_WORDS 3456
#define XB_SPIN_CAP (1u << 19)
DI unsigned xb_ld(unsigned* p)              { return __hip_atomic_load(p, __ATOMIC_RELAXED, __HIP_MEMORY_SCOPE_AGENT); }
DI unsigned xb_add(unsigned* p, unsigned v) { return __hip_atomic_fetch_add(p, v, __ATOMIC_RELAXED, __HIP_MEMORY_SCOPE_AGENT); }
DI unsigned xb_xcc_id() { return (unsigned)__builtin_amdgcn_s_getreg((3 << 11) | 20) & 0xFu; }
#define XB_SPIN(cond, bar) do { unsigned _sp = 0; while (cond) { __builtin_amdgcn_s_sleep(1); \
    if ((++_sp & 255u) == 0u) { if (xb_ld(&(bar)[XB_TMO])) break; if (_sp > XB_SPIN_CAP) { atomicAdd(&(bar)[XB_TMO], 1u); break; } } } } while (0)
struct XcdBarrier { unsigned* bar; unsigned x; volatile LAS unsigned* st; };
DI XcdBarrier xcd_barrier_post(unsigned* bar, volatile LAS unsigned* st) {
    XcdBarrier b; b.bar = bar; b.x = xb_xcc_id(); b.st = st;
    if (threadIdx.x == 0) (void)xb_add(&bar[XB_XCNT(b.x)], 1u);
    return b;
}
DI void xcd_barrier_complete(unsigned* bar, unsigned x, unsigned& nloc, unsigned& nx) {
    const unsigned G = gridDim.x * gridDim.y * gridDim.z;
    unsigned sum, cnt, mine, sp = 0u;
    for (;;) {
        sum = 0u; cnt = 0u; mine = 0u;
#pragma unroll
        for (unsigned j = 0; j < 16; ++j) { const unsigned c = xb_ld(&bar[XB_XCNT(j)]); sum += c; cnt += (c > 0u) ? 1u : 0u; mine = (j == x) ? c : mine; }
        if (sum == G) break;
        __builtin_amdgcn_s_sleep(1);
        if ((++sp & 255u) == 0u) { if (xb_ld(&bar[XB_TMO])) break; if (sp > XB_SPIN_CAP) { atomicAdd(&bar[XB_TMO], 1u); break; } }
    }
    nloc = mine > 0u ? mine : 1u; nx = cnt > 0u ? cnt : 1u;
}
DI void xcd_barrier(const XcdBarrier& b) {
    asm volatile("s_waitcnt vmcnt(0)" ::: "memory");
    __syncthreads();
    if (threadIdx.x == 0) {
        unsigned* bar = b.bar;
        __builtin_amdgcn_s_waitcnt(0);
        unsigned nloc = b.st[0], nx = b.st[1];
        if (nloc == 0u) { xcd_barrier_complete(bar, b.x, nloc, nx); b.st[0] = nloc; b.st[1] = nx; }
        const unsigned old = xb_add(&bar[XB_XSUB(b.x)], 1u);
        const unsigned gen = old / nloc;
        if (old + 1u == (gen + 1u) * nloc) {
            __builtin_amdgcn_fence(__ATOMIC_RELEASE, "agent");
            asm volatile("s_waitcnt vmcnt(0)" ::: "memory");
            const unsigned og = xb_add(&bar[XB_TOP], 1u);
            const unsigned tg = og / nx;
            if (og + 1u == (tg + 1u) * nx) xb_add(&bar[XB_TOPGEN], 1u);
            else XB_SPIN(xb_ld(&bar[XB_TOPGEN]) == tg, bar);
            __builtin_amdgcn_fence(__ATOMIC_ACQUIRE, "agent");
            xb_add(&bar[XB_XGEN(b.x)], 1u);
            asm volatile("s_waitcnt vmcnt(0)" ::: "memory");
        } else {
            XB_SPIN(xb_ld(&bar[XB_XGEN(b.x)]) == gen, bar);
            __builtin_amdgcn_fence(__ATOMIC_ACQUIRE, "agent");
            asm volatile("s_waitcnt vmcnt(0)" ::: "memory");
        }
    }
    __syncthreads();
}

namespace pg8 {
constexpr int BM = 256, BK = 64, HALF = 128, HTB = HALF * BK * 2, STAGE_BYTES = 8 * HTB, NXCD = 8, WGM = 8;
__host__ __device__ __forceinline__ int lds_byte(int r, int c) { const int st = (r >> 4) * 2 + (c >> 5), rr = r & 15, cc = c & 31, ob = rr * 64 + cc * 2; return st * 1024 + (ob ^ (((ob >> 9) & 1) << 5)); }
__host__ __device__ __forceinline__ void stage_rc(int b, int& R, int& C) { const int st = b / 1024, sb = b % 1024, swz = sb ^ (((sb >> 9) & 1) << 5); R = (st >> 1) * 16 + swz / 64; C = (st & 1) * 32 + (swz % 64) / 2; }
__host__ __device__ __forceinline__ int perm32(int rho) { const int n = rho >> 4, i = rho & 15; return 8 * (i >> 2) + 4 * n + (i & 3); }
struct Unit { int pm, pn; };
struct Gemm { const bf16_t* A; const bf16_t* Bt; int lda, K; const int* gidx; int sc_w, sc_a; };

struct Order {
    int nM, nN, nwg, G, c;
    DI void init(int nM_, int nN_, int G_, int c_) { nM = nM_; nN = nN_; nwg = nM * nN; G = G_; c = c_; }
    DI bool next(int i, Unit& u) const {
        const long L = (long)i * G + c; if (L >= nwg) return false;
        int wgid = (int)L; { const int q = nwg / NXCD, r = nwg % NXCD, xcd = wgid % NXCD, off = wgid / NXCD; wgid = (xcd < r ? xcd * (q + 1) : r * (q + 1) + (xcd - r) * q) + off; }
        const int nig = WGM * nN, gid = wgid / nig, fm = gid * WGM, gsz = (nM - fm) < WGM ? (nM - fm) : WGM;
        u.pm = fm + ((wgid % nig) % gsz); u.pn = (wgid % nig) / gsz; return true;
    }
};
struct SchedPlain : Order { DI size_t a_off(const Unit&) const { return 0; } DI size_t b_off(const Unit&) const { return 0; } };
struct SchedLruGate : Order { DI size_t a_off(const Unit& u) const { return (size_t)(u.pn >> 1) * 256; } DI size_t b_off(const Unit&) const { return 0; } };
struct SchedMoe : Order { int ts1, ts2, ts3, ts4, ts5, ts6, ts7; size_t estride;
    DI size_t a_off(const Unit&) const { return 0; }
    DI size_t b_off(const Unit& u) const { const int e = (u.pm >= ts1) + (u.pm >= ts2) + (u.pm >= ts3) + (u.pm >= ts4) + (u.pm >= ts5) + (u.pm >= ts6) + (u.pm >= ts7); return (size_t)e * estride; } };

DI unsigned cvt_pk_bf16(float lo, float hi) { unsigned r; asm volatile("v_cvt_pk_bf16_f32 %0, %1, %2" : "=v"(r) : "v"(lo), "v"(hi)); return r; }
DI u32x4 pack8(const f32x4& v0, const f32x4& v1) { u32x4 w; w.x = cvt_pk_bf16(v0[0], v0[1]); w.y = cvt_pk_bf16(v0[2], v0[3]); w.z = cvt_pk_bf16(v1[0], v1[1]); w.w = cvt_pk_bf16(v1[2], v1[3]); return w; }

typedef f32x4 Acc[2][2][4][2];

struct EpiMlstmIn { static constexpr bool PERM = true;
    bf16_t *Q, *K, *V, *O; float* gates; const float* gate_b;
    DI void operator()(const Acc& acc, const Unit& u, int wr, int wc, int fr, int fq) const {
        const int row0 = u.pm * BM + wr * 64 + fr;
        if (u.pn < 12) {
            bf16_t* base; int ldc, colt; float sc = 1.f; bool act = false;
            if (u.pn < 2) { base = Q; ldc = 512; colt = u.pn * 256; sc = 0.125f; }
            else if (u.pn < 4) { base = K; ldc = 512; colt = (u.pn - 2) * 256; }
            else if (u.pn < 8) { base = V; ldc = 1024; colt = (u.pn - 4) * 256; }
            else { base = O; ldc = 1024; colt = (u.pn - 8) * 256; act = true; }
            const int col0 = colt + wc * 32 + 8 * fq;
#pragma unroll
            for (int ai = 0; ai < 2; ++ai)
#pragma unroll
                for (int m = 0; m < 4; ++m) { bf16_t* rowp = base + (size_t)(row0 + ai * HALF + m * 16) * ldc + col0;
#pragma unroll
                    for (int bj = 0; bj < 2; ++bj) { f32x4 v0 = acc[ai][bj][m][0], v1 = acc[ai][bj][m][1];
                        if (act) {
#pragma unroll
                            for (int j = 0; j < 4; ++j) { v0[j] = sigmoid_f(v0[j]); v1[j] = sigmoid_f(v1[j]); } }
                        v0 = v0 * sc; v1 = v1 * sc;
                        *(u32x4*)(rowp + bj * HALF) = pack8(v0, v1); } }
        }
    }
};
template <bool SB> struct EpiResidT { static constexpr bool PERM = true;
    const float* src; bf16_t* xs; const float* gmod; const bf16_t* m1;
    const float* ca; bf16_t* xa; float* ssq; LAS unsigned char* lds;
    DI void operator()(const Acc& acc, const Unit& u, int wr, int wc, int fr_, int fq_) const {
        unsigned ones = ~0u; asm volatile("" : "+s"(ones)); const int ln = (int)__builtin_amdgcn_mbcnt_hi(ones, __builtin_amdgcn_mbcnt_lo(ones, 0u)); const int fr = ln & 15, fq = ln >> 4; (void)fr_; (void)fq_;
        const int row0 = u.pm * BM + wr * 64 + fr, col0 = u.pn * BM + wc * 32 + 8 * fq;
        const int tid = (wr * 4 + wc) * 64 + ln;
        if (tid < 256) *(LAS float*)(lds + STAGE_BYTES + 6144 + tid * 4) = gmod[(size_t)(u.pm >> 4) * 6144 + u.pn * BM + tid];
        else *(LAS float*)(lds + STAGE_BYTES + 7168 + (tid - 256) * 4) = ca[(size_t)(u.pm >> 4) * D + u.pn * BM + (tid - 256)];
        asm volatile("s_waitcnt vmcnt(0) lgkmcnt(0)" ::: "memory"); __builtin_amdgcn_s_barrier(); asm volatile("" ::: "memory");
        const LAS float* GS = (const LAS float*)(lds + STAGE_BYTES + 6144) + wc * 32 + 8 * fq; const LAS float* CS = (const LAS float*)(lds + STAGE_BYTES + 7168) + wc * 32 + 8 * fq;
#pragma unroll
        for (int am = 0; am < 8; ++am) { const int ai = am >> 2, m = am & 3;
            const int row = row0 + ai * HALF + m * 16; const size_t off = (size_t)row * D + col0; float ss = 0.f;
            f32x4 sv[2][2]; u32x4 sw[2], mw[2];
#pragma unroll
            for (int bj = 0; bj < 2; ++bj) {
                if constexpr (SB) sw[bj] = *(const u32x4*)(xs + off + bj * HALF);
                else { sv[bj][0] = *(const f32x4*)(src + off + bj * HALF); sv[bj][1] = *(const f32x4*)(src + off + bj * HALF + 4); }
                mw[bj] = *(const u32x4*)(m1 + off + bj * HALF); }
#pragma unroll
            for (int bj = 0; bj < 2; ++bj) { f32x4 y[2], xo[2];
#pragma unroll
                for (int n = 0; n < 2; ++n) { const unsigned w0 = mw[bj][2 * n], w1 = mw[bj][2 * n + 1]; const f32x4 mv = (f32x4){bflo(w0), bfhi(w0), bflo(w1), bfhi(w1)};
                    f32x4 s; if constexpr (SB) { const unsigned a0 = sw[bj][2 * n], a1 = sw[bj][2 * n + 1]; s = (f32x4){bflo(a0), bfhi(a0), bflo(a1), bfhi(a1)}; } else s = sv[bj][n];
                    const f32x4 x = (s + mv) + *(const LAS f32x4*)(GS + bj * HALF + n * 4) * acc[ai][bj][m][n];
                    xo[n] = x; ss += (x[0] * x[0] + x[1] * x[1]) + (x[2] * x[2] + x[3] * x[3]); y[n] = x * *(const LAS f32x4*)(CS + bj * HALF + n * 4); }
                *(u32x4*)(xs + off + bj * HALF) = pack8(xo[0], xo[1]);
                *(u32x4*)(xa + off + bj * HALF) = pack8(y[0], y[1]); }
            ss += __shfl_xor(ss, 16); ss += __shfl_xor(ss, 32);
            if (fq == 0) *(LAS float*)(lds + STAGE_BYTES + 2048 + ((wr * 64 + ai * HALF + m * 16 + fr) * 4 + wc) * 4) = ss;
        }
        asm volatile("s_waitcnt lgkmcnt(0)" ::: "memory"); __builtin_amdgcn_s_barrier(); asm volatile("" ::: "memory");
        if (tid < 256) { const f32x4 t = *(const LAS f32x4*)(lds + STAGE_BYTES + 2048 + tid * 16); ssq[(size_t)(u.pm * BM + tid) * 4 + u.pn] = (t[0] + t[1]) + (t[2] + t[3]); }
    }
};
struct EpiMix { static constexpr bool PERM = true;
    bf16_t* M; const float* gmod;
    DI void operator()(const Acc& acc, const Unit& u, int wr, int wc, int fr, int fq) const {
        const int row0 = u.pm * BM + wr * 64 + fr, col0 = u.pn * BM + wc * 32 + 8 * fq;
        const float* gv = gmod + (size_t)(u.pm >> 4) * 6144 + col0;
        f32x4 g4[2][2];
#pragma unroll
        for (int bj = 0; bj < 2; ++bj)
#pragma unroll
            for (int n = 0; n < 2; ++n) g4[bj][n] = *(const f32x4*)(gv + bj * HALF + n * 4);
#pragma unroll
        for (int ai = 0; ai < 2; ++ai)
#pragma unroll
            for (int m = 0; m < 4; ++m) { bf16_t* rowp = M + (size_t)(row0 + ai * HALF + m * 16) * D + col0;
#pragma unroll
                for (int bj = 0; bj < 2; ++bj) *(u32x4*)(rowp + bj * HALF) = pack8(acc[ai][bj][m][0] * g4[bj][0], acc[ai][bj][m][1] * g4[bj][1]); }
    }
};
constexpr float ACT_SCALE = 4.f, HN_SCALE = 4.f, W13_SCALE = 32.f, W2_SCALE = 64.f;
constexpr int E8_ACT = 0x7d7d7d7d, E8_HN = 0x7d7d7d7d, E8_W13 = 0x7a7a7a7a, E8_W2 = 0x79797979;
DI unsigned pk4_fp8(float a, float b, float c, float d) {
    a = __builtin_amdgcn_fmed3f(a, -448.f, 448.f); b = __builtin_amdgcn_fmed3f(b, -448.f, 448.f); c = __builtin_amdgcn_fmed3f(c, -448.f, 448.f); d = __builtin_amdgcn_fmed3f(d, -448.f, 448.f);
    int w = 0; w = __builtin_amdgcn_cvt_pk_fp8_f32(a, b, w, false); w = __builtin_amdgcn_cvt_pk_fp8_f32(c, d, w, true); return (unsigned)w; }
template <bool F8> struct EpiSwigluT { static constexpr bool PERM = true;
    unsigned char* O;
    DI void operator()(const Acc& acc, const Unit& u, int wr, int wc, int fr, int fq) const {
        const int row0 = u.pm * BM + wr * 64 + fr, col0 = u.pn * HALF + wc * 32 + 8 * fq;
#pragma unroll
        for (int ai = 0; ai < 2; ++ai)
#pragma unroll
            for (int m = 0; m < 4; ++m) { f32x4 v0, v1;
#pragma unroll
                for (int j = 0; j < 4; ++j) { const float a0 = acc[ai][0][m][0][j], a1 = acc[ai][0][m][1][j];
                    if constexpr (F8) {
                        v0[j] = a0 * __builtin_amdgcn_rcpf(__builtin_fmaf(__builtin_amdgcn_exp2f(-a0), 1.f / ACT_SCALE, 1.f / ACT_SCALE)) * acc[ai][1][m][0][j];
                        v1[j] = a1 * __builtin_amdgcn_rcpf(__builtin_fmaf(__builtin_amdgcn_exp2f(-a1), 1.f / ACT_SCALE, 1.f / ACT_SCALE)) * acc[ai][1][m][1][j]; }
                    else { v0[j] = a0 * sigmoid_f(a0) * acc[ai][1][m][0][j]; v1[j] = a1 * sigmoid_f(a1) * acc[ai][1][m][1][j]; } }
                if constexpr (F8) { u32x2 w; w.x = pk4_fp8(v0[0], v0[1], v0[2], v0[3]); w.y = pk4_fp8(v1[0], v1[1], v1[2], v1[3]);
                    *(u32x2*)(O + (size_t)(row0 + ai * HALF + m * 16) * DFF + col0) = w; }
                else *(u32x4*)((bf16_t*)O + (size_t)(row0 + ai * HALF + m * 16) * DFF + col0) = pack8(v0, v1); }
    }
};
typedef EpiSwigluT<true> EpiSwiglu;
template <int K> DI float dpp_ror(float v) { const int x = __builtin_bit_cast(int, v); return __builtin_bit_cast(float, __builtin_amdgcn_update_dpp(x, x, 0x120 + K, 0xf, 0xf, true)); }
struct EpiLruIn { static constexpr bool PERM = true;
    bf16_t *GB, *XC, *XRH; const float* cw; const float* cb; LAS unsigned char* lds;
    const float* ssq; const float* biasp;
    DI void operator()(const Acc& acc, const Unit& u, int wr, int wc, int fr_, int fq_) const {
        unsigned ones = ~0u; asm volatile("" : "+s"(ones)); const int ln = (int)__builtin_amdgcn_mbcnt_hi(ones, __builtin_amdgcn_mbcnt_lo(ones, 0u)); const int fr = ln & 15, fq = ln >> 4; (void)fr_; (void)fq_;
        const int row0 = u.pm * BM + wr * 64 + fr; const bool isg = u.pn < 4; const int tid = (wr * 4 + wc) * 64 + ln;
        LAS float* RS = (LAS float*)(lds + STAGE_BYTES + 6144); LAS float* BS = (LAS float*)(lds + STAGE_BYTES + 7168); LAS float* TB = (LAS float*)(lds + STAGE_BYTES + 8192);
        if (tid < 256) { const f32x4 t = *(const f32x4*)(ssq + (size_t)(u.pm * BM + tid) * 4); RS[tid] = __builtin_amdgcn_rsqf(((t[0] + t[1]) + (t[2] + t[3])) * (1.f / D) + RMS_EPS); }
        else { const float* bp = biasp + (size_t)(u.pm >> 4) * 2048 + u.pn * BM + (tid - 256); float s = 0.f;
#pragma unroll
            for (int ks = 0; ks < 8; ++ks) s += bp[(size_t)ks * 16 * 2048];
            BS[tid - 256] = s; }
        const int c0 = (u.pn - 4) * 256;
        if (!isg) for (int idx = tid; idx < 5 * 256; idx += 512) TB[idx] = (idx < 1024) ? cw[(size_t)(idx >> 8) * D + c0 + (idx & 255)] : cb[c0 + idx - 1024];
        asm volatile("s_waitcnt vmcnt(0) lgkmcnt(0)" ::: "memory"); __builtin_amdgcn_s_barrier(); asm volatile("" ::: "memory");
        const int cl = wc * 32 + 8 * fq;
        if (isg) {
            const int col0 = u.pn * 256 + cl;
#pragma unroll
            for (int ai = 0; ai < 2; ++ai)
#pragma unroll
                for (int m = 0; m < 4; ++m) { bf16_t* rowp = GB + (size_t)(row0 + ai * HALF + m * 16) * D + col0; const float r = RS[wr * 64 + fr + ai * HALF + m * 16];
#pragma unroll
                    for (int bj = 0; bj < 2; ++bj) { f32x4 v0 = acc[ai][bj][m][0] * r + *(const LAS f32x4*)(BS + cl + bj * HALF), v1 = acc[ai][bj][m][1] * r + *(const LAS f32x4*)(BS + cl + bj * HALF + 4);
#pragma unroll
                        for (int j = 0; j < 4; ++j) { float x = v0[j]; float z = 1.5957691216f * (x + 0.044715f * x * x * x); v0[j] = x * sigmoid_f(z);
                            x = v1[j]; z = 1.5957691216f * (x + 0.044715f * x * x * x); v1[j] = x * sigmoid_f(z); }
                        *(u32x4*)(rowp + bj * HALF) = pack8(v0, v1); }
                    asm volatile("" ::: "memory"); }
        } else {
            const int col0 = c0 + cl;
#pragma unroll
            for (int ai = 0; ai < 2; ++ai)
#pragma unroll
                for (int m = 0; m < 4; ++m) { const int row = row0 + ai * HALF + m * 16; const float r = RS[wr * 64 + fr + ai * HALF + m * 16], rp = (m > 0) ? RS[wr * 64 + fr + ai * HALF + (m > 0 ? m - 1 : 0) * 16] : 0.f;
#pragma unroll
                    for (int bj = 0; bj < 2; ++bj) { f32x4 o[2], xs[2];
#pragma unroll
                        for (int n = 0; n < 2; ++n) { const LAS float* tp = TB + cl + bj * HALF + 4 * n; const f32x4 bq = *(const LAS f32x4*)(BS + cl + bj * HALF + 4 * n);
                            const f32x4 w0 = *(const LAS f32x4*)(tp), w1 = *(const LAS f32x4*)(tp + 256), w2 = *(const LAS f32x4*)(tp + 512), w3 = *(const LAS f32x4*)(tp + 768), b4 = *(const LAS f32x4*)(tp + 1024);
#pragma unroll
                            for (int j = 0; j < 4; ++j) { const float x0 = acc[ai][bj][m][n][j] * r + bq[j]; const float xp = (m > 0) ? acc[ai][bj][m > 0 ? m - 1 : 0][n][j] * rp + bq[j] : 0.f;
                                const float c1 = dpp_ror<1>(x0), c2 = dpp_ror<2>(x0), c3 = dpp_ror<3>(x0), p1 = dpp_ror<1>(xp), p2 = dpp_ror<2>(xp), p3 = dpp_ror<3>(xp);
                                const float x1 = (fr >= 1) ? c1 : p1, x2 = (fr >= 2) ? c2 : p2, x3 = (fr >= 3) ? c3 : p3;
                                xs[n][j] = x0; o[n][j] = b4[j] + w0[j] * x3 + w1[j] * x2 + w2[j] * x1 + w3[j] * x0; }
                            asm volatile("" ::: "memory"); }
                        *(u32x4*)(XC + (size_t)row * D + col0 + bj * HALF) = pack8(o[0], o[1]);
                        if (m == 0 && fr < 3) *(u32x4*)(XRH + ((size_t)(row >> 6) * 6 + fr) * D + col0 + bj * HALF) = pack8(xs[0], xs[1]);
                        if (m == 3 && fr >= 13) *(u32x4*)(XRH + ((size_t)(row >> 6) * 6 + 3 + (fr - 13)) * D + col0 + bj * HALF) = pack8(xs[0], xs[1]);
                        __builtin_amdgcn_sched_barrier(0); }
                    asm volatile("" ::: "memory"); }
        }
    }
};
template <int K> DI float dpp_shr(float v) { const int x = __builtin_bit_cast(int, v); return __builtin_bit_cast(float, __builtin_amdgcn_update_dpp(x, x, 0x110 + K, 0xf, 0xf, true)); }
struct EpiLruGate { static constexpr bool PERM = true;
    const bf16_t* XC; bf16_t *LA, *U; const float* gate_b; const float* sp; float* car64;
    DI void operator()(const Acc& acc, const Unit& u, int wr, int wc, int fr, int fq) const {
        const int row0 = u.pm * BM + wr * 64 + fr, ch0 = u.pn * HALF + wc * 32 + 8 * fq;
        const int hd = u.pn >> 1, o0 = (u.pn & 1) * HALF + wc * 32 + 8 * fq;
        u32x4 xw[2][4];
#pragma unroll
        for (int ai = 0; ai < 2; ++ai)
#pragma unroll
            for (int m = 0; m < 4; ++m) xw[ai][m] = *(const u32x4*)(XC + (size_t)(row0 + ai * HALF + m * 16) * D + ch0);
#pragma unroll
        for (int n = 0; n < 2; ++n) {
            const f32x4 bx = *(const f32x4*)(gate_b + hd * 512 + o0 + 4 * n), ba = *(const f32x4*)(gate_b + hd * 512 + 256 + o0 + 4 * n), s4 = *(const f32x4*)(sp + ch0 + 4 * n);
#pragma unroll
            for (int ai = 0; ai < 2; ++ai) {
                float Ab[4] = {1.f, 1.f, 1.f, 1.f}, Hb[4] = {0.f, 0.f, 0.f, 0.f};
#pragma unroll
                for (int m = 0; m < 4; ++m) { const size_t off = (size_t)(row0 + ai * HALF + m * 16) * D + ch0 + 4 * n;
                    float la[4], uu[4];
#pragma unroll
                    for (int j = 0; j < 4; ++j) { const unsigned w = xw[ai][m][2 * n + (j >> 1)]; const float xc = (j & 1) ? bfhi(w) : bflo(w);
                        const float ig = sigmoid_f(acc[ai][0][m][n][j] + bx[j]), rg = sigmoid_f(acc[ai][1][m][n][j] + ba[j]);
                        const float l = -8.f * rg * s4[j]; const float av = __expf(l);
                        la[j] = l; uu[j] = xc * ig * __builtin_amdgcn_sqrtf(1.f - av * av); }
                    u32x2 lw, uw; lw.x = cvt_pk_bf16(la[0], la[1]); lw.y = cvt_pk_bf16(la[2], la[3]); uw.x = cvt_pk_bf16(uu[0], uu[1]); uw.y = cvt_pk_bf16(uu[2], uu[3]);
                    *(u32x2*)(LA + off) = lw; *(u32x2*)(U + off) = uw;
#pragma unroll
                    for (int j = 0; j < 4; ++j) { const unsigned lq = (j < 2) ? lw.x : lw.y, uq = (j < 2) ? uw.x : uw.y;
                        float A = __expf((j & 1) ? bfhi(lq) : bflo(lq)), H = (j & 1) ? bfhi(uq) : bflo(uq);
                        { const float Al = dpp_shr<1>(A), Hl = dpp_shr<1>(H); H = A * Hl + H; A = Al * A; }
                        { const float Al = dpp_shr<2>(A), Hl = dpp_shr<2>(H); H = A * Hl + H; A = Al * A; }
                        { const float Al = dpp_shr<4>(A), Hl = dpp_shr<4>(H); H = A * Hl + H; A = Al * A; }
                        { const float Al = dpp_shr<8>(A), Hl = dpp_shr<8>(H); H = A * Hl + H; A = Al * A; }
                        Hb[j] = A * Hb[j] + H; Ab[j] = Ab[j] * A; } }
                if (fr == 15) { float* cp = car64 + ((size_t)(u.pm * 4 + 2 * ai + wr) * D + ch0 + 4 * n) * 2;
                    *(f32x4*)(cp) = (f32x4){Ab[0], Hb[0], Ab[1], Hb[1]}; *(f32x4*)(cp + 4) = (f32x4){Ab[2], Hb[2], Ab[3], Hb[3]}; }
            }
        }
    }
};
struct EpiBf16 { static constexpr bool PERM = true;
    bf16_t* O; int ldc;
    DI void operator()(const Acc& acc, const Unit& u, int wr, int wc, int fr, int fq) const {
        const int row0 = u.pm * BM + wr * 64 + fr, col0 = u.pn * BM + wc * 32 + 8 * fq;
#pragma unroll
        for (int ai = 0; ai < 2; ++ai)
#pragma unroll
            for (int m = 0; m < 4; ++m) { bf16_t* rowp = O + (size_t)(row0 + ai * HALF + m * 16) * ldc + col0;
#pragma unroll
                for (int bj = 0; bj < 2; ++bj) *(u32x4*)(rowp + bj * HALF) = pack8(acc[ai][bj][m][0], acc[ai][bj][m][1]); }
    }
};

typedef int i32x4 __attribute__((ext_vector_type(4)));
typedef int i32x8 __attribute__((ext_vector_type(8)));
template <class Epi, class Sched, bool GATHER, bool FP8 = false>
DI void gemm_phase(LAS unsigned char* lds, const int tid, const Gemm g, const Sched& S, const Epi& E) {
    const int wid = __builtin_amdgcn_readfirstlane(tid >> 6), lane = tid & 63, wr = wid >> 2, wc = wid & 3, fr = lane & 15, fq = lane >> 4;
    const int K = g.K, lda = g.lda, nt = K / BK;
    unsigned voffA[2], voffB[2]; int RA[2]; unsigned CA2[2];
#pragma unroll
    for (int i = 0; i < 2; ++i) { int R, C; stage_rc(tid * 16 + i * 8192, R, C); const int Rb = Epi::PERM ? ((R & ~31) + perm32(R & 31)) : R;
        voffA[i] = (unsigned)(R * lda + C) * 2u; voffB[i] = (unsigned)(Rb * K + C) * 2u; RA[i] = R; CA2[i] = (unsigned)C * 2u; }
    const size_t kstep = (size_t)(BK * 2);
    const size_t hstepA = GATHER ? 0 : (size_t)HALF * lda * 2, hstepB = (size_t)HALF * K * 2;
    const size_t tstepA = GATHER ? 0 : 2 * hstepA, tstepB = 2 * hstepB;
    const unsigned ldsw = (unsigned)wid * 1024u;
    const int aoff = lds_byte(wr * 64 + fr, fq * 8), boff = lds_byte(wc * 32 + fr, fq * 8);
    unsigned vc[2][2];
#define PG8_SA(b, h) (((b) * 2 + (h)) * HTB)
#define PG8_SB(b, h) ((4 + (b) * 2 + (h)) * HTB)
#define PG8_STAGE(bufoff, gbase, voff) do { _Pragma("unroll") for (int _i = 0; _i < 2; ++_i) \
        __builtin_amdgcn_global_load_lds((const unsigned*)((const char*)(gbase) + (voff)[_i]), (LAS unsigned*)(lds + (bufoff) + ldsw + _i * 8192), 16, 0, 0); } while (0)
#define PG8_STAGE_A(bufoff, kptr, h, VV) do { if constexpr (GATHER) { PG8_STAGE(bufoff, kptr, (VV)[h]); } else { PG8_STAGE(bufoff, (kptr) + (h) * hstepA, voffA); } } while (0)
#define PG8_LDA(dst, b, h) do { _Pragma("unroll") for (int m = 0; m < 4; ++m) _Pragma("unroll") for (int k = 0; k < 2; ++k) dst[m][k] = *(const LAS bf16x8*)(lds + PG8_SA(b, h) + aoff + m * 2048 + k * 1024); } while (0)
#define PG8_LDB(dst, b, h) do { _Pragma("unroll") for (int n = 0; n < 2; ++n) _Pragma("unroll") for (int k = 0; k < 2; ++k) dst[n][k] = *(const LAS bf16x8*)(lds + PG8_SB(b, h) + boff + n * 2048 + k * 1024); } while (0)
#define PG8_CAT(f) __builtin_shufflevector(__builtin_bit_cast(i32x4, (f)[0]), __builtin_bit_cast(i32x4, (f)[1]), 0, 1, 2, 3, 4, 5, 6, 7)
#define PG8_MMA(ai, bj, At, Bt) do { __builtin_amdgcn_s_setprio(1); _Pragma("unroll") for (int m = 0; m < 4; ++m) _Pragma("unroll") for (int n = 0; n < 2; ++n) { \
        if constexpr (FP8) { const i32x8 _b = PG8_CAT(Bt[n]), _a = PG8_CAT(At[m]); asm volatile("v_mfma_scale_f32_16x16x128_f8f6f4 %0, %1, %2, %0, %3, %4 op_sel_hi:[0,0,0]" : "+v"(acc[ai][bj][m][n]) : "v"(_b), "v"(_a), "v"(scw), "v"(sca)); } \
        else { _Pragma("unroll") for (int k = 0; k < 2; ++k) acc[ai][bj][m][n] = __builtin_amdgcn_mfma_f32_16x16x32_bf16(Bt[n][k], At[m][k], acc[ai][bj][m][n], 0, 0, 0); } } __builtin_amdgcn_s_setprio(0); } while (0)
#define PG8_WAIT_V(n) asm volatile("s_waitcnt vmcnt(" #n ")" ::: "memory")
#define PG8_WAIT_L(n) asm volatile("s_waitcnt lgkmcnt(" #n ")" ::: "memory")
#define PG8_BAR __builtin_amdgcn_s_barrier()
#define PG8_SCHED __builtin_amdgcn_sched_barrier(0)
#define PG8_GIDX(VV, U) do { if constexpr (GATHER) { _Pragma("unroll") for (int _h = 0; _h < 2; ++_h) _Pragma("unroll") for (int _i = 0; _i < 2; ++_i) { \
        const int _tok = g.gidx[(U).pm * BM + _h * HALF + RA[_i]]; (VV)[_h][_i] = (unsigned)_tok * (unsigned)(lda * 2) + CA2[_i]; } } } while (0)
#define PG8_GIDX_LDS(VV, BUF) do { if constexpr (GATHER) { _Pragma("unroll") for (int _h = 0; _h < 2; ++_h) _Pragma("unroll") for (int _i = 0; _i < 2; ++_i) { \
        const int _tok = *(const LAS int*)(lds + STAGE_BYTES + (BUF) * 1024 + (_h * HALF + RA[_i]) * 4); (VV)[_h][_i] = (unsigned)_tok * (unsigned)(lda * 2) + CA2[_i]; } } } while (0)
    Unit cur, nxt; int ui = 0;
    if (!S.next(0, cur)) return;
    int scw = 0, sca = 0; if constexpr (FP8) { scw = g.sc_w; sca = g.sc_a; asm volatile("" : "+v"(scw), "+v"(sca)); }
    Acc acc;
#pragma unroll
    for (int a = 0; a < 2; ++a)
#pragma unroll
        for (int b = 0; b < 2; ++b)
#pragma unroll
            for (int m = 0; m < 4; ++m)
#pragma unroll
                for (int n = 0; n < 2; ++n) acc[a][b][m][n] = (f32x4){0.f, 0.f, 0.f, 0.f};
    bf16x8 At[4][2], B0[2][2], B1[2][2];
    const char* cA = (const char*)(g.A + S.a_off(cur)) + (size_t)cur.pm * tstepA; const char* cB = (const char*)(g.Bt + S.b_off(cur)) + (size_t)cur.pn * tstepB;
    vc[0][0] = vc[0][1] = vc[1][0] = vc[1][1] = 0u;
    PG8_GIDX(vc, cur);
    PG8_STAGE(PG8_SB(0, 0), cB, voffB); PG8_STAGE(PG8_SB(0, 1), cB + hstepB, voffB); PG8_STAGE_A(PG8_SA(0, 0), cA, 0, vc); PG8_STAGE_A(PG8_SA(0, 1), cA, 1, vc);
    if (wr == 1) PG8_BAR;
    PG8_WAIT_V(2); PG8_BAR;
    PG8_STAGE(PG8_SB(1, 0), cB + kstep, voffB); PG8_STAGE_A(PG8_SA(1, 0), cA + kstep, 0, vc); PG8_STAGE(PG8_SB(1, 1), cB + hstepB + kstep, voffB);
    PG8_WAIT_V(6); PG8_BAR;
    for (;;) {
        const bool has_next = S.next(ui + 1, nxt);
        const char* nA = has_next ? (const char*)(g.A + S.a_off(nxt)) + (size_t)nxt.pm * tstepA : cA; const char* nB = has_next ? (const char*)(g.Bt + S.b_off(nxt)) + (size_t)nxt.pn * tstepB : cB;
        if constexpr (GATHER) { if (has_next && wid == 0)
            __builtin_amdgcn_global_load_lds((const unsigned*)(g.gidx + (size_t)nxt.pm * BM + lane * 4), (LAS unsigned*)(lds + STAGE_BYTES + (ui & 1) * 1024), 16, 0, 0); }
#pragma nounroll
        for (int t = 0; t < nt; t += 2) {
            const bool last = (t == nt - 2);
            const char* a1 = cA + (size_t)(t + 1) * kstep;
            const char* a2 = last ? nA : cA + (size_t)(t + 2) * kstep; const char* b2 = last ? nB : cB + (size_t)(t + 2) * kstep;
            const char* a3 = a2 + kstep; const char* b3 = b2 + kstep;
            unsigned v2[2][2];
#pragma unroll
            for (int h = 0; h < 2; ++h)
#pragma unroll
                for (int i = 0; i < 2; ++i) v2[h][i] = vc[h][i];
            if (last && has_next) { PG8_GIDX_LDS(v2, ui & 1); }
            PG8_LDB(B0, 0, 0); PG8_LDB(B1, 0, 1); PG8_SCHED; PG8_LDA(At, 0, 0); PG8_STAGE_A(PG8_SA(1, 1), a1, 1, vc);
            PG8_WAIT_V(8); PG8_WAIT_L(0); PG8_BAR; PG8_MMA(0, 0, At, B0); PG8_MMA(0, 1, At, B1); PG8_BAR; PG8_SCHED;
            PG8_LDA(At, 0, 1); PG8_STAGE(PG8_SB(0, 0), b2, voffB); PG8_STAGE(PG8_SB(0, 1), b2 + hstepB, voffB); PG8_STAGE_A(PG8_SA(0, 0), a2, 0, v2);
            PG8_WAIT_V(8); PG8_WAIT_L(0); PG8_BAR; PG8_MMA(1, 0, At, B0); PG8_MMA(1, 1, At, B1); PG8_BAR; PG8_SCHED;
            PG8_LDB(B0, 1, 0); PG8_LDB(B1, 1, 1); PG8_SCHED; PG8_LDA(At, 1, 0); PG8_STAGE_A(PG8_SA(0, 1), a2, 1, v2);
            PG8_WAIT_V(8); PG8_WAIT_L(0); PG8_BAR; PG8_MMA(0, 0, At, B0); PG8_MMA(0, 1, At, B1); PG8_BAR; PG8_SCHED;
            PG8_LDA(At, 1, 1); PG8_STAGE(PG8_SB(1, 0), b3, voffB); PG8_STAGE(PG8_SB(1, 1), b3 + hstepB, voffB); PG8_STAGE_A(PG8_SA(1, 0), a3, 0, v2);
            PG8_WAIT_V(8); PG8_WAIT_L(0); PG8_BAR; PG8_MMA(1, 0, At, B0); PG8_MMA(1, 1, At, B1); PG8_BAR; PG8_SCHED;
            if constexpr (GATHER) { if (last) {
#pragma unroll
                for (int h = 0; h < 2; ++h)
#pragma unroll
                    for (int i = 0; i < 2; ++i) vc[h][i] = v2[h][i]; } }
        }
        if (wr == 0) PG8_BAR;
        if constexpr (FP8) asm volatile("s_nop 15\n\ts_nop 15\n\ts_nop 15\n\ts_nop 15\n\ts_nop 15" ::: "memory");
        E(acc, cur, wr, wc, fr, fq);
        if (!has_next) break;
#pragma unroll
        for (int a = 0; a < 2; ++a)
#pragma unroll
            for (int b = 0; b < 2; ++b)
#pragma unroll
                for (int m = 0; m < 4; ++m)
#pragma unroll
                    for (int n = 0; n < 2; ++n) acc[a][b][m][n] = (f32x4){0.f, 0.f, 0.f, 0.f};
        cur = nxt; cA = nA; cB = nB; ++ui;
        if (wr == 1) PG8_BAR;
    }
    PG8_WAIT_V(0);
    PG8_BAR;
#undef PG8_SA
#undef PG8_SB
#undef PG8_STAGE
#undef PG8_STAGE_A
#undef PG8_LDA
#undef PG8_LDB
#undef PG8_MMA
#undef PG8_CAT
#undef PG8_WAIT_V
#undef PG8_WAIT_L
#undef PG8_BAR
#undef PG8_SCHED
#undef PG8_GIDX
#undef PG8_GIDX_LDS
}
}

struct Args { const float* in[N_IN]; float* out; unsigned char* ws; int ph_lo, ph_hi; };
static_assert(sizeof(Args) == (N_IN + 2) * 8 + 8, "Args has no padding");

typedef const Args __attribute__((address_space(4))) CArgs;
DI const CArgs* kargs() { const CArgs* p = (const CArgs*)__builtin_amdgcn_kernarg_segment_ptr(); asm volatile("" : "+s"(p)); return p; }
struct Frame { LAS unsigned char* lds; int tid, lane, wave, vcu, G; };
extern __shared__ __attribute__((aligned(16))) unsigned char lds_raw[];
DI Frame make_frame(int wv) { Frame F; F.lds = (LAS unsigned char*)lds_raw; unsigned ones = ~0u; asm volatile("" : "+s"(ones)); int t = wv * 64 + (int)__builtin_amdgcn_mbcnt_hi(ones, __builtin_amdgcn_mbcnt_lo(ones, 0u)); asm volatile("" : "+v"(t)); F.tid = t; F.lane = t & 63; F.wave = __builtin_amdgcn_readfirstlane(t >> 6);
    F.G = gridDim.x; { int bx = blockIdx.x; asm volatile("" : "+s"(bx)); F.vcu = (F.G % 8 == 0) ? (bx % 8) * (F.G / 8) + bx / 8 : bx; } return F; }

struct TrItem { const float* W; bf16_t* WT; int K, N, half, item; float f8scale; };
DI void tr_load(const TrItem& q, int lane, float (&v)[32]) {
    const int nblk = (q.N + 31) >> 5, kb = q.item / nblk, nb = q.item - kb * nblk, k0 = 64 * kb, n0 = 32 * nb;
    const int n = n0 + (lane & 31); const bool ok = n < q.N; const int nc = ok ? n : q.N - 1;
    const float* p = q.W + (size_t)(k0 + (lane >> 5)) * q.N + nc; const size_t rs = (size_t)2 * q.N;
#pragma unroll
    for (int i = 0; i < 32; ++i) v[i] = __builtin_nontemporal_load(p + (size_t)i * rs);
    if (!ok) {
#pragma unroll
        for (int i = 0; i < 32; ++i) v[i] = 0.f; }
}
DI void tr_store(const TrItem& q, int lane, const float (&v)[32], LAS float* scr) {
    const int nblk = (q.N + 31) >> 5, kb = q.item / nblk, nb = q.item - kb * nblk, k0 = 64 * kb, n0 = 32 * nb;
#pragma unroll
    for (int i = 0; i < 32; ++i) { const int kk = 2 * i + (lane >> 5); scr[kk * 33 + (lane & 31)] = v[i]; }
    LDS_WAIT(); asm volatile("" ::: "memory");
    const int c = lane & 7;
#pragma unroll
    for (int j = 0; j < 4; ++j) { const int nl = (lane >> 3) + 8 * j; const LAS float* s = scr + (8 * c) * 33 + nl;
        u32x4 o; o.x = pk2(s[0 * 33], s[1 * 33]); o.y = pk2(s[2 * 33], s[3 * 33]); o.z = pk2(s[4 * 33], s[5 * 33]); o.w = pk2(s[6 * 33], s[7 * 33]);
        const int n = n0 + nl; int rho = n;
        if (q.half) { const int nn = (n < q.half) ? n : n - q.half; rho = ((nn >> 7) << 8) + (nn & 127) + ((n < q.half) ? 0 : 128); }
        if (q.f8scale != 0.f) { const float f = q.f8scale * (q.half ? ((n < q.half) ? 1.44269504f : 0.693147181f) : 1.f); u32x2 o8;     o8.x = pg8::pk4_fp8(s[0 * 33] * f, s[1 * 33] * f, s[2 * 33] * f, s[3 * 33] * f); o8.y = pg8::pk4_fp8(s[4 * 33] * f, s[5 * 33] * f, s[6 * 33] * f, s[7 * 33] * f);
            *(u32x2*)((unsigned char*)q.WT + (size_t)rho * q.K + k0 + 8 * c) = o8; }
        else *(u32x4*)(q.WT + (size_t)rho * q.K + k0 + 8 * c) = o; }
    LDS_WAIT(); asm volatile("" ::: "memory");
}
constexpr int CI0 = 16 * 97, CI1 = 512, CI2 = 3584, CI3 = 1792, CI4 = 1024, CI5 = 256, CI6 = 512, CI7 = 8 * 3584, CI8 = 8 * 1792, CI_PER_J = CI0 + CI1 + CI2 + CI3 + CI4 + CI5 + CI6 + CI7 + CI8;
constexpr int N_MODIT = 4 * 24 * 8;
constexpr int CI_A_FWD = CI0 + CI1 + CI2 + CI3 + CI4 + CI5 + CI6;
DI TrItem conv_desc(const CArgs* a, int it) {
    const int j = it / CI_PER_J; int r = it - j * CI_PER_J;
    bf16_t* wb = (bf16_t*)(a->ws + WS_W) + (size_t)j * W_PER_J;
    if (r < CI0) return TrItem{a->in[I_MLWIN] + (size_t)j * D * MLP, wb + W_WIN, D, MLP, 0, r, 0.f}; r -= CI0;
    if (r < CI1) return TrItem{a->in[I_MLWOUT] + (size_t)j * D * D, wb + W_WOUT, D, D, 0, r, 0.f}; r -= CI1;
    if (r < CI2) return TrItem{a->in[I_FW13] + (size_t)j * D * 2 * DFF, wb + W_W13, D, 2 * DFF, DFF, r, DENSE_FP8_AT(j) ? pg8::W13_SCALE : 0.f}; r -= CI2;
    if (r < CI3) return TrItem{a->in[I_FW2] + (size_t)j * DFF * D, wb + W_W2, DFF, D, 0, r, DENSE_FP8_AT(j) ? pg8::W2_SCALE : 0.f}; r -= CI3;
    if (r < CI4) return TrItem{a->in[I_LWIN] + (size_t)j * D * 2 * D, wb + W_LIN, D, 2 * D, 0, r, 0.f}; r -= CI4;
    if (r < CI5) { const int hd = r >> 6; return TrItem{a->in[I_LGW] + (size_t)(j * 4 + hd) * 256 * 512, wb + W_GW + (size_t)hd * 512 * 256, 256, 512, 256, r & 63, 0.f}; } r -= CI5;
    if (r < CI6) return TrItem{a->in[I_LWOUT] + (size_t)j * D * D, wb + W_LOUT, D, D, 0, r, 0.f}; r -= CI6;
    if (r < CI7) { const int e = r / 3584; return TrItem{a->in[I_MW13] + (size_t)(j * NE + e) * D * 2 * DFF, wb + W_MW13 + (size_t)e * DFF * D, D, 2 * DFF, DFF, r - e * 3584, pg8::W13_SCALE}; } r -= CI7;
    { const int e = r / 1792; return TrItem{a->in[I_MW2] + (size_t)(j * NE + e) * DFF * D, wb + W_MW2 + (size_t)e * (D * DFF / 2), DFF, D, 0, r - e * 1792, pg8::W2_SCALE}; }
}
DI void conv_stream(const CArgs* a, int first, int step, int end, LAS float* scr, int lane) {
    if (first >= end) return;
    float va[32], vb[32];
    TrItem qa = conv_desc(a, first), qb = qa;
    tr_load(qa, lane, va);
    for (int it = first; it < end; it += 2 * step) {
        const bool hb = it + step < end;
        if (hb) { qb = conv_desc(a, it + step); tr_load(qb, lane, vb); }
        tr_store(qa, lane, va, scr);
        if (!hb) break;
        const bool ha = it + 2 * step < end;
        if (ha) { qa = conv_desc(a, it + 2 * step); tr_load(qa, lane, va); }
        tr_store(qb, lane, vb, scr);
        if (!ha) break;
    }
}
DI void mod_item(const CArgs* a, int it, const LAS float* cact, int lane) {
    const int i = it / 192, rem = it - i * 192, cg = rem >> 3, ks = rem & 7;
    const float* w = a->in[I_ADAW] + ((size_t)i * D + ks * 128) * 6144 + cg * 256 + lane * 4;
    f32x4 acc[16];
#pragma unroll
    for (int b = 0; b < 16; ++b) acc[b] = (f32x4){0.f, 0.f, 0.f, 0.f};
#pragma unroll 4
    for (int k = 0; k < 128; ++k) { const f32x4 w4 = *(const f32x4*)(w + (size_t)k * 6144);
#pragma unroll
        for (int b = 0; b < 16; ++b) acc[b] += w4 * cact[b * D + ks * 128 + k]; }
    float* o = (float*)(a->ws + WS_MODP) + ((size_t)(ks * 4 + i) * 16) * 6144 + cg * 256 + lane * 4;
#pragma unroll
    for (int b = 0; b < 16; ++b) *(f32x4*)(o + (size_t)b * 6144) = acc[b];
}
DI void mod_item_full(const CArgs* a, int it, const LAS float* cact, int lane) {
    const int i = it / 24, cg = it - i * 24;
    const float* w = a->in[I_ADAW] + (size_t)i * D * 6144 + cg * 256 + lane * 4;
    f32x4 acc[16];
#pragma unroll
    for (int b = 0; b < 16; ++b) acc[b] = (f32x4){0.f, 0.f, 0.f, 0.f};
    for (int k0 = 0; k0 < D; k0 += 16) { f32x4 w4[16];
#pragma unroll
        for (int kk = 0; kk < 16; ++kk) w4[kk] = __builtin_nontemporal_load((const f32x4*)(w + (size_t)(k0 + kk) * 6144));
#pragma unroll
        for (int kk = 0; kk < 16; ++kk)
#pragma unroll
            for (int b = 0; b < 16; ++b) acc[b] += w4[kk] * cact[b * D + k0 + kk]; }
    const f32x4 bias = *(const f32x4*)(a->in[I_ADAB] + (size_t)i * 6144 + cg * 256 + lane * 4);
    float* o = (float*)(a->ws + WS_MOD) + ((size_t)i * 16) * 6144 + cg * 256 + lane * 4;
#pragma unroll
    for (int b = 0; b < 16; ++b) *(f32x4*)(o + (size_t)b * 6144) = acc[b] + bias;
}
DI void ph_prologue_a(int wv) {
    const CArgs* a = kargs(); const Frame F = make_frame(wv);
    LAS float* cact = (LAS float*)(F.lds + 8 * 8448);
    LAS float* scr = (LAS float*)(F.lds + F.wave * 8448);
    for (int idx = F.tid; idx < 16 * D; idx += NTHR) { const float c = a->in[I_C][idx]; cact[idx] = c * sigmoid_f(c); }
    __syncthreads();
    const int gw = F.vcu * NWAVES + F.wave, NGW = F.G * NWAVES;
    for (int it = gw; it < 64; it += NGW) mod_item(a, it, cact, F.lane);
    {
        float va[32];
        for (int r = gw; r < CI0; r += NGW) { const TrItem q = conv_desc(a, r); tr_load(q, F.lane, va); tr_store(q, F.lane, va, scr); }
    }
    for (int idx = F.vcu * NTHR + F.tid; idx < 2 * 28672; idx += F.G * NTHR) { const int j = idx / 28672, o = idx - j * 28672;
        ((u32x4*)((bf16_t*)(a->ws + WS_W) + (size_t)j * W_PER_J + W_WIN + (size_t)3104 * D))[o] = (u32x4){0u, 0u, 0u, 0u}; }
}
DI void ph_prologue_b(int wv) {
    const CArgs* a = kargs(); const Frame F = make_frame(wv);
    const f32x4* P = (const f32x4*)(a->ws + WS_MODP); f32x4* M = (f32x4*)(a->ws + WS_MOD); const f32x4* B4 = (const f32x4*)a->in[I_ADAB];
    for (int idx = F.vcu * NTHR + F.tid; idx < 4 * 16 * 1536; idx += F.G * NTHR) { const int i = idx / (16 * 1536), n4 = idx % 1536;
        f32x4 s = B4[i * 1536 + n4];
#pragma unroll
        for (int ks = 0; ks < 8; ++ks) s += P[(size_t)ks * (4 * 16 * 1536) + idx];
        M[idx] = s; }
    for (int idx = F.vcu * NTHR + F.tid; idx < 2 * D; idx += F.G * NTHR) ((float*)(a->ws + WS_SP))[idx] = log1p_exp_neg(a->in[I_LAP][idx]);
}

template <bool SB> DI void ld_src(const float* src, const bf16_t* xsb, int r, int lane, u32x4 (&raw)[4]) {
    if constexpr (SB) { const u32x2* xr = (const u32x2*)(xsb + (size_t)r * D) + lane;
#pragma unroll
        for (int j = 0; j < 4; ++j) { const u32x2 t = __builtin_nontemporal_load(xr + 64 * j); raw[j].x = t.x; raw[j].y = t.y; } }
    else { const u32x4* xr = (const u32x4*)(src + (size_t)r * D) + lane;
#pragma unroll
        for (int j = 0; j < 4; ++j) raw[j] = __builtin_nontemporal_load(xr + 64 * j); }
}
template <int MODE, bool SB>
DI void row_pass(int wv, int srcsel, int ngsel, int layer, int sub, int jl, int addm) {
    const CArgs* a = kargs(); const Frame F = make_frame(wv); asm volatile("" : "+s"(layer), "+s"(jl));
    (void)srcsel; const float* src = a->in[I_X]; bf16_t* XSB = (bf16_t*)(a->ws + WS_R + R_XSB); const float* ngain = ngsel < 0 ? a->in[I_FNG] : a->in[I_NORMG] + (size_t)ngsel * D;
    float* XS = a->out; bf16_t* HN = (bf16_t*)(a->ws + WS_HN); const bf16_t* M1 = (const bf16_t*)(a->ws + WS_R + R_M1); asm volatile("" : "+s"(addm));
    const int gw = F.vcu * NWAVES + F.wave, lane = F.lane;
    LAS float* rw = (LAS float*)F.lds;
    if (MODE == 1) { const float* RW = a->in[I_RW] + (size_t)jl * D * NE; for (int idx = F.tid; idx < D * NE; idx += NTHR) { const int d = idx >> 3, e = idx & 7;
            rw[((((d >> 8) * 4 + (d & 3)) * 2 + (e >> 2)) * 64 + ((d & 255) >> 2)) * 4 + (e & 3)] = RW[idx]; }
        __syncthreads(); }
    int cnt0 = 0, cnt1 = 0, cnt2 = 0, cnt3 = 0, cnt4 = 0, cnt5 = 0, cnt6 = 0, cnt7 = 0;
    float rb[8];
    if (MODE == 1) {
#pragma unroll
        for (int e = 0; e < 8; ++e) rb[e] = a->in[I_RB][jl * NE + e]; }
    for (int blk = gw; blk < T / 32; blk += F.G * NWAVES) {
        const int r0 = blk * 32, b = r0 >> 12;
        const float* mod = (const float*)(a->ws + WS_MOD) + ((size_t)layer * 16 + b) * 6144;
        f32x4 CA[4], CB[4], G2[4];
#pragma unroll
        for (int j = 0; j < 4; ++j) { const int c = 256 * j + 4 * lane; const f32x4 g = *(const f32x4*)(ngain + c);
            if (MODE == 3) { CA[j] = g; CB[j] = (f32x4){0.f, 0.f, 0.f, 0.f}; }
            else if (MODE == 0 && layer == 0 && sub == 0) {
                f32x4 sh = *(const f32x4*)(a->in[I_ADAB] + c), sc = *(const f32x4*)(a->in[I_ADAB] + 1024 + c);
#pragma unroll
                for (int ks = 0; ks < 8; ++ks) { const float* pp = (const float*)(a->ws + WS_MODP) + ((size_t)(ks * 4) * 16 + b) * 6144; sh += *(const f32x4*)(pp + c); sc += *(const f32x4*)(pp + 1024 + c); }
                CA[j] = g * (sc + 1.f); CB[j] = sh; }
            else { const f32x4 sh = *(const f32x4*)(mod + sub * 3072 + c), sc = *(const f32x4*)(mod + sub * 3072 + 1024 + c); CA[j] = g * (sc + 1.f); CB[j] = sh; }
            if (MODE >= 2) G2[j] = *(const f32x4*)((const float*)(a->ws + WS_MOD) + ((size_t)(layer - (MODE == 2 ? 1 : 0)) * 16 + b) * 6144 + 5120 + c); }
        u32x4 vnx[4]; u32x2 mnx[4]; i32x2 slnx = (i32x2){0, 0}; f32x2 twnx = (f32x2){0.f, 0.f};
#pragma unroll
        for (int j = 0; j < 4; ++j) { mnx[j] = (u32x2){0u, 0u}; vnx[j] = (u32x4){0u, 0u, 0u, 0u}; }
        { ld_src<SB>(src, XSB, r0, lane, vnx);
          if (addm) { const u32x2* mr = (const u32x2*)(M1 + (size_t)r0 * D) + lane;
#pragma unroll
              for (int j = 0; j < 4; ++j) mnx[j] = __builtin_nontemporal_load(mr + 64 * j); }
          if (MODE >= 2) { slnx = ((const i32x2*)(a->ws + WS_TOKSLOT))[r0]; twnx = ((const f32x2*)(a->ws + WS_TOPW))[r0]; } }
        for (int rr = 0; rr < 32; ++rr) {
            const int row = r0 + rr;
            f32x4 v[4];
#pragma unroll
            for (int j = 0; j < 4; ++j) { const u32x4 rw_ = vnx[j]; if constexpr (SB) v[j] = (f32x4){bflo(rw_.x), bfhi(rw_.x), bflo(rw_.y), bfhi(rw_.y)}; else v[j] = __builtin_bit_cast(f32x4, rw_);
                const u32x2 mw = mnx[j]; v[j] += (f32x4){bflo(mw.x), bfhi(mw.x), bflo(mw.y), bfhi(mw.y)}; }
            const i32x2 sl = slnx; const f32x2 tw = twnx;
            { const int rnx = (rr + 1 < 32) ? row + 1 : row; ld_src<SB>(src, XSB, rnx, lane, vnx);
              if (addm) { const u32x2* mr = (const u32x2*)(M1 + (size_t)rnx * D) + lane;
#pragma unroll
                  for (int j = 0; j < 4; ++j) mnx[j] = __builtin_nontemporal_load(mr + 64 * j); }
              if (MODE >= 2) { slnx = ((const i32x2*)(a->ws + WS_TOKSLOT))[rnx]; twnx = ((const f32x2*)(a->ws + WS_TOPW))[rnx]; } }
            if (MODE >= 2) {
                const bf16_t* YS = (const bf16_t*)(a->ws + WS_R + R_YS);
                const u32x2* y0 = (const u32x2*)(YS + (size_t)sl.x * D) + lane; const u32x2* y1 = (const u32x2*)(YS + (size_t)sl.y * D) + lane;
#pragma unroll
                for (int j = 0; j < 4; ++j) { const u32x2 p = y0[64 * j], q = y1[64 * j];
                    f32x4 m; m[0] = tw.x * bflo(p.x) + tw.y * bflo(q.x); m[1] = tw.x * bfhi(p.x) + tw.y * bfhi(q.x); m[2] = tw.x * bflo(p.y) + tw.y * bflo(q.y); m[3] = tw.x * bfhi(p.y) + tw.y * bfhi(q.y);
                    v[j] += G2[j] * m; }
                if (MODE == 2) {
#pragma unroll
                    for (int j = 0; j < 4; ++j) { u32x2 w; w.x = pk2(v[j][0], v[j][1]); w.y = pk2(v[j][2], v[j][3]); ((u32x2*)(XSB + (size_t)row * D) + lane)[64 * j] = w; } }
            }
            float ss = 0.f;
#pragma unroll
            for (int j = 0; j < 4; ++j) ss += (v[j][0] * v[j][0] + v[j][1] * v[j][1]) + (v[j][2] * v[j][2] + v[j][3] * v[j][3]);
            const float rstd = 1.0f / sqrtf(wave_sum(ss) * (1.f / D) + RMS_EPS);
            f32x4 y[4];
#pragma unroll
            for (int j = 0; j < 4; ++j) y[j] = v[j] * rstd * CA[j] + CB[j];
            if (MODE == 3) {
#pragma unroll
                for (int j = 0; j < 4; ++j) ((f32x4*)(XS + (size_t)row * D) + lane)[64 * j] = y[j];
            } else if ((MODE == 0 && sub == 1 && DENSE_FP8_AT(jl)) || MODE == 1) {
                unsigned* o4 = (unsigned*)((unsigned char*)HN + (size_t)row * D) + lane;
#pragma unroll
                for (int j = 0; j < 4; ++j) o4[64 * j] = pg8::pk4_fp8(y[j][0] * pg8::HN_SCALE, y[j][1] * pg8::HN_SCALE, y[j][2] * pg8::HN_SCALE, y[j][3] * pg8::HN_SCALE);
            } else {
                u32x2* o8 = (u32x2*)(HN + (size_t)row * D) + lane;
#pragma unroll
                for (int j = 0; j < 4; ++j) { u32x2 w; w.x = pk2(y[j][0], y[j][1]); w.y = pk2(y[j][2], y[j][3]); o8[64 * j] = w; }
            }
            if (MODE == 1) {
                float lg[8];
#pragma unroll
                for (int e = 0; e < 8; ++e) lg[e] = 0.f;
#pragma unroll
                for (int j = 0; j < 4; ++j)
#pragma unroll
                    for (int q = 0; q < 4; ++q) { const LAS float* wp = rw + (((j * 4 + q) * 2) * 64 + lane) * 4; const f32x4 w0 = *(const LAS f32x4*)(wp), w1 = *(const LAS f32x4*)(wp + 256); const float yv = y[j][q];
                        lg[0] += yv * w0[0]; lg[1] += yv * w0[1]; lg[2] += yv * w0[2]; lg[3] += yv * w0[3]; lg[4] += yv * w1[0]; lg[5] += yv * w1[1]; lg[6] += yv * w1[2]; lg[7] += yv * w1[3];
                        if (q & 1) asm volatile("" ::: "memory"); }
#pragma unroll
                for (int e = 0; e < 8; ++e) lg[e] = wave_sum(lg[e]) + rb[e];
                int e0 = 0; float l0 = lg[0];
#pragma unroll
                for (int e = 1; e < 8; ++e) if (lg[e] > l0) { l0 = lg[e]; e0 = e; }
                int e1 = -1; float l1 = -3.0e38f;
#pragma unroll
                for (int e = 0; e < 8; ++e) if (e != e0 && lg[e] > l1) { l1 = lg[e]; e1 = e; }
                const float w0 = 1.f / (1.f + __expf(l1 - l0)), w1 = 1.f - w0;
                if (lane == 0) { ((int*)(a->ws + WS_TOPE))[row] = e0 | (e1 << 8); ((f32x2*)(a->ws + WS_TOPW))[row] = (f32x2){w0, w1}; }
                cnt0 += (e0 == 0) + (e1 == 0); cnt1 += (e0 == 1) + (e1 == 1); cnt2 += (e0 == 2) + (e1 == 2); cnt3 += (e0 == 3) + (e1 == 3);
                cnt4 += (e0 == 4) + (e1 == 4); cnt5 += (e0 == 5) + (e1 == 5); cnt6 += (e0 == 6) + (e1 == 6); cnt7 += (e0 == 7) + (e1 == 7);
            }
        }
        if (MODE == 1) {
            const int cv = lane == 0 ? cnt0 : lane == 1 ? cnt1 : lane == 2 ? cnt2 : lane == 3 ? cnt3 : lane == 4 ? cnt4 : lane == 5 ? cnt5 : lane == 6 ? cnt6 : cnt7;
            if (lane < 8) ((int*)(a->ws + WS_HIST))[blk * 8 + lane] = cv;
            cnt0 = cnt1 = cnt2 = cnt3 = cnt4 = cnt5 = cnt6 = cnt7 = 0;
        }
    }
}

DI void ph_lru_tables(int wv, int jl) {
    const CArgs* a = kargs(); const Frame F = make_frame(wv); asm volatile("" : "+s"(jl));
    const float* MODL = (const float*)(a->ws + WS_MOD) + (size_t)(2 * jl + 1) * 16 * 6144;
    for (int idx = F.vcu * NTHR + F.tid; idx < 16 * D; idx += F.G * NTHR) { const int col = idx & (D - 1), b = idx >> 10;
        ((float*)(a->ws + WS_CA1))[(size_t)jl * 16 * D + idx] = a->in[I_NORMG][(size_t)((2 * jl + 1) * 2) * D + col] * (1.f + MODL[(size_t)b * 6144 + 1024 + col]); }
    LAS float* shl = (LAS float*)(F.lds + F.wave * 8192);
    for (int it = F.vcu * NWAVES + F.wave; it < 64; it += F.G * NWAVES) { const int ks = it & 7, cg = it >> 3, lane = F.lane;
        const float* W = a->in[I_LWIN] + (size_t)jl * D * 2 * D + (size_t)(ks * 128) * (2 * D) + cg * 256 + lane * 4;
        for (int idx = lane; idx < 16 * 128; idx += 64) shl[idx] = MODL[(size_t)(idx >> 7) * 6144 + ks * 128 + (idx & 127)];
        LDS_WAIT(); asm volatile("" ::: "memory");
        f32x4 acc[16];
#pragma unroll
        for (int b = 0; b < 16; ++b) acc[b] = (f32x4){0.f, 0.f, 0.f, 0.f};
        for (int k0 = 0; k0 < 128; k0 += 16) { f32x4 w4[16];
#pragma unroll
            for (int kk = 0; kk < 16; ++kk) w4[kk] = *(const f32x4*)(W + (size_t)(k0 + kk) * (2 * D));
#pragma unroll
            for (int kk = 0; kk < 16; ++kk)
#pragma unroll
                for (int b = 0; b < 16; ++b) acc[b] += w4[kk] * shl[b * 128 + k0 + kk]; }
        float* o = (float*)(a->ws + WS_BIASP) + ((size_t)(jl * 8 + ks) * 16) * 2048 + cg * 256 + lane * 4;
#pragma unroll
        for (int b = 0; b < 16; ++b) *(f32x4*)(o + (size_t)b * 2048) = acc[b];
        LDS_WAIT(); asm volatile("" ::: "memory"); }
}
DI void ph_slots(int wv) {
    const CArgs* a = kargs(); const Frame F = make_frame(wv);
    LAS int* H = (LAS int*)F.lds;
    const int* HIST = (const int*)(a->ws + WS_HIST);
    for (int idx = F.tid; idx < 2048 * 8; idx += NTHR) H[idx] = HIST[idx];
    __syncthreads();
    const int lane = F.lane;
    int* SLOTTOK = (int*)(a->ws + WS_SLOTTOK); i32x2* TOKSLOT = (i32x2*)(a->ws + WS_TOKSLOT); const int* TOPE = (const int*)(a->ws + WS_TOPE);
    for (int blk = F.vcu * NWAVES + F.wave; blk < T / 32; blk += F.G * NWAVES) {
        int tot[8], pre[8];
#pragma unroll
        for (int e = 0; e < 8; ++e) { tot[e] = 0; pre[e] = 0; }
#pragma unroll 2
        for (int bb = lane; bb < 2048; bb += 64) { const LAS int* hp = H + ((bb * 8) ^ ((bb >> 2) & 4) * 0);
            typedef int i32x4 __attribute__((ext_vector_type(4)));
            const i32x4 h0 = *(const LAS i32x4*)(hp), h1 = *(const LAS i32x4*)(hp + 4); const bool lt = bb < blk;
            tot[0] += h0[0]; tot[1] += h0[1]; tot[2] += h0[2]; tot[3] += h0[3]; tot[4] += h1[0]; tot[5] += h1[1]; tot[6] += h1[2]; tot[7] += h1[3];
            pre[0] += lt ? h0[0] : 0; pre[1] += lt ? h0[1] : 0; pre[2] += lt ? h0[2] : 0; pre[3] += lt ? h0[3] : 0; pre[4] += lt ? h1[0] : 0; pre[5] += lt ? h1[1] : 0; pre[6] += lt ? h1[2] : 0; pre[7] += lt ? h1[3] : 0;
            asm volatile("" ::: "memory"); }
#pragma unroll
        for (int e = 0; e < 8; ++e) { tot[e] = wave_sum_i(tot[e]); pre[e] = wave_sum_i(pre[e]); }
        int sb[8]; int ts = 0;
#pragma unroll
        for (int e = 0; e < 8; ++e) { sb[e] = ts * 256; ts += (tot[e] + 255) >> 8; }
        const int row = blk * 32 + (lane & 31);
        int e0 = 255, e1 = 255;
        if (lane < 32) { const int pe = TOPE[row]; e0 = pe & 255; e1 = (pe >> 8) & 255; }
        int s0 = 0, s1 = 0;
        const unsigned long long below = (1ull << lane) - 1ull;
#pragma unroll
        for (int e = 0; e < 8; ++e) { const unsigned long long m = __ballot(e0 == e || e1 == e); const int rank = __popcll(m & below);
            if (e0 == e) s0 = sb[e] + pre[e] + rank; if (e1 == e) s1 = sb[e] + pre[e] + rank; }
        if (lane < 32) { SLOTTOK[s0] = row; SLOTTOK[s1] = row; TOKSLOT[row] = (i32x2){s0, s1}; }
        if (blk < 8) {
            int sbe = 0, tote = 0;
#pragma unroll
            for (int e = 0; e < 8; ++e) if (e == blk) { sbe = sb[e]; tote = tot[e]; }
            const int end = sbe + (((tote + 255) >> 8) << 8);
            for (int s = sbe + tote + lane; s < end; s += 64) SLOTTOK[s] = 0;
        }
        if (blk == 0 && lane == 0) { unsigned* META = (unsigned*)(a->ws + WS_CTL) + CW_META; int t2 = 0;
#pragma unroll
            for (int e = 0; e < 8; ++e) { META[1 + e] = (unsigned)t2; t2 += (tot[e] + 255) >> 8; }
            META[9] = (unsigned)t2; META[0] = (unsigned)t2; }
    }
}

DI bf16x8 gather8(const LAS bf16_t* p, int stride) {
    u32x4 w;
#pragma unroll
    for (int q = 0; q < 4; ++q) w[q] = (unsigned)p[(2 * q) * stride] | ((unsigned)p[(2 * q + 1) * stride] << 16);
    return __builtin_bit_cast(bf16x8, w);
}
#define CHAIN_BAR() do { asm volatile("s_waitcnt lgkmcnt(0)" ::: "memory"); __builtin_amdgcn_s_barrier(); asm volatile("" ::: "memory"); } while (0)
DI void tr_frag10(unsigned ak, unsigned av, bf16x8 (&fk)[2], bf16x8 (&fv)[4][2]) {
    u32x2 r[20];
    asm volatile("ds_read_b64_tr_b16 %0, %20\n\tds_read_b64_tr_b16 %1, %20 offset:576\n\tds_read_b64_tr_b16 %2, %20 offset:4608\n\tds_read_b64_tr_b16 %3, %20 offset:5184\n\t"
                 "ds_read_b64_tr_b16 %4, %21\n\tds_read_b64_tr_b16 %5, %21 offset:1088\n\tds_read_b64_tr_b16 %6, %21 offset:8704\n\tds_read_b64_tr_b16 %7, %21 offset:9792\n\t"
                 "ds_read_b64_tr_b16 %8, %21 offset:32\n\tds_read_b64_tr_b16 %9, %21 offset:1120\n\tds_read_b64_tr_b16 %10, %21 offset:8736\n\tds_read_b64_tr_b16 %11, %21 offset:9824\n\t"
                 "ds_read_b64_tr_b16 %12, %21 offset:64\n\tds_read_b64_tr_b16 %13, %21 offset:1152\n\tds_read_b64_tr_b16 %14, %21 offset:8768\n\tds_read_b64_tr_b16 %15, %21 offset:9856\n\t"
                 "ds_read_b64_tr_b16 %16, %21 offset:96\n\tds_read_b64_tr_b16 %17, %21 offset:1184\n\tds_read_b64_tr_b16 %18, %21 offset:8800\n\tds_read_b64_tr_b16 %19, %21 offset:9888\n\ts_waitcnt lgkmcnt(0)"
                 : "=&v"(r[0]), "=&v"(r[1]), "=&v"(r[2]), "=&v"(r[3]), "=&v"(r[4]), "=&v"(r[5]), "=&v"(r[6]), "=&v"(r[7]), "=&v"(r[8]), "=&v"(r[9]),
                   "=&v"(r[10]), "=&v"(r[11]), "=&v"(r[12]), "=&v"(r[13]), "=&v"(r[14]), "=&v"(r[15]), "=&v"(r[16]), "=&v"(r[17]), "=&v"(r[18]), "=&v"(r[19])
                 : "v"(ak), "v"(av) : "memory");
#define TRCAT(i) __builtin_bit_cast(bf16x8, (u32x4){r[i].x, r[i].y, r[(i) + 1].x, r[(i) + 1].y})
    fk[0] = TRCAT(0); fk[1] = TRCAT(2);
    fv[0][0] = TRCAT(4); fv[0][1] = TRCAT(6); fv[1][0] = TRCAT(8); fv[1][1] = TRCAT(10); fv[2][0] = TRCAT(12); fv[2][1] = TRCAT(14); fv[3][0] = TRCAT(16); fv[3][1] = TRCAT(18);
#undef TRCAT
}
DI void tr_frag2(unsigned a0, unsigned rs, bf16x8& f0, bf16x8& f1) {
    u32x2 r0, r1, r2, r3; const unsigned a1 = a0 + 4u * rs, a2 = a0 + 32u * rs, a3 = a0 + 36u * rs;
    asm volatile("ds_read_b64_tr_b16 %0, %4\n\tds_read_b64_tr_b16 %1, %5\n\tds_read_b64_tr_b16 %2, %6\n\tds_read_b64_tr_b16 %3, %7\n\ts_waitcnt lgkmcnt(0)"
                 : "=&v"(r0), "=&v"(r1), "=&v"(r2), "=&v"(r3) : "v"(a0), "v"(a1), "v"(a2), "v"(a3) : "memory");
    u32x4 w0, w1; w0.x = r0.x; w0.y = r0.y; w0.z = r1.x; w0.w = r1.y; w1.x = r2.x; w1.y = r2.y; w1.z = r3.x; w1.w = r3.y;
    f0 = __builtin_bit_cast(bf16x8, w0); f1 = __builtin_bit_cast(bf16x8, w1);
}
DI void ph_moe_convert(int wv, int jl) {
    const CArgs* a = kargs(); const Frame F = make_frame(wv); asm volatile("" : "+s"(jl));
    LAS float* scr = (LAS float*)(F.lds + F.wave * 8448);
    const int nw = ((int)gridDim.x - BATCH * ML_H) * NWAVES;
    const int cw0 = ((int)blockIdx.x - BATCH * ML_H) * NWAVES + F.wave;
    if (jl == 0) {
        LAS float* cact = (LAS float*)(F.lds + 8 * 8448);
        for (int idx = F.tid; idx < 16 * D; idx += NTHR) { const float c = a->in[I_C][idx]; cact[idx] = c * sigmoid_f(c); }
        __syncthreads();
        if (F.wave == 0 && (int)blockIdx.x - BATCH * ML_H < 96) mod_item_full(a, (int)blockIdx.x - BATCH * ML_H, cact, F.lane);
        for (int idx = cw0 * 64 + F.lane; idx < 2 * D; idx += nw * 64) ((float*)(a->ws + WS_SP))[idx] = log1p_exp_neg(a->in[I_LAP][idx]);
    }
    const int first = jl == 0 ? CI0 : CI_PER_J + CI0, end = jl == 0 ? CI_PER_J + CI0 : 2 * CI_PER_J;
    if (jl == 0) { if (F.wave != 0) conv_stream(a, first + ((int)blockIdx.x - BATCH * ML_H) * (NWAVES - 1) + F.wave - 1, ((int)gridDim.x - BATCH * ML_H) * (NWAVES - 1), end, scr, F.lane); }
    else conv_stream(a, first + cw0, nw, end, scr, F.lane);
}
DI float dpp_f(float v, int ctrl_sel) {
    const int x = __builtin_bit_cast(int, v); int r;
    if (ctrl_sel == 0) r = __builtin_amdgcn_update_dpp(x, x, 0xB1, 0xf, 0xf, true); else if (ctrl_sel == 1) r = __builtin_amdgcn_update_dpp(x, x, 0x4E, 0xf, 0xf, true);
    else if (ctrl_sel == 2) r = __builtin_amdgcn_update_dpp(x, x, 0x141, 0xf, 0xf, true); else r = __builtin_amdgcn_update_dpp(x, x, 0x140, 0xf, 0xf, true);
    return __builtin_bit_cast(float, r); }
DI float row16_sum(float p) { p += dpp_f(p, 0); p += dpp_f(p, 1); p += dpp_f(p, 2); p += dpp_f(p, 3); return p; }
DI unsigned cvtpk(float lo, float hi) { unsigned r; asm("v_cvt_pk_bf16_f32 %0, %1, %2" : "=v"(r) : "v"(lo), "v"(hi)); return r; }
DI void ph_mlstm(int wv, int jl) {
    const CArgs* a = kargs(); const Frame F = make_frame(wv); asm volatile("" : "+s"(jl));
    const int chain = blockIdx.x, b = chain >> 3, h = chain & 7;
    const int tid = F.tid, lane = F.lane, w = F.wave, fr = lane & 15, fq = lane >> 4;
    LAS bf16_t* Qs = (LAS bf16_t*)(F.lds);
    LAS bf16_t* Ks = (LAS bf16_t*)(F.lds + 9216);
    LAS bf16_t* Vs = (LAS bf16_t*)(F.lds + 18432);
    LAS bf16_t* Sp = (LAS bf16_t*)(F.lds + 35840);
    LAS bf16_t* CT = (LAS bf16_t*)(F.lds + 45056);
    LAS bf16_t* Hs = (LAS bf16_t*)(F.lds + 63488);
    LAS float* nvec = (LAS float*)(F.lds + 80896);
    LAS float* rss = nvec + 64;
    LAS float* npart = nvec + 192;
    LAS float* GA = (LAS float*)(F.lds + 86016);
    LAS float* GB = GA + 4096;
    LAS float* GP = GA + 8192;
    LAS float* MR = GA + 12288;
    const bf16_t* Qg = (const bf16_t*)(a->ws + WS_R + R_Q) + (size_t)b * SEQ * 512 + h * 64;
    const bf16_t* Kg = (const bf16_t*)(a->ws + WS_R + R_K) + (size_t)b * SEQ * 512 + h * 64;
    const bf16_t* Vg = (const bf16_t*)(a->ws + WS_R + R_V) + (size_t)b * SEQ * 1024 + h * 128;
    const bf16_t* Og = (const bf16_t*)(a->ws + WS_R + R_O) + (size_t)b * SEQ * 1024 + h * 128;
    bf16_t* Hg = (bf16_t*)(a->ws + WS_R + R_HS) + (size_t)b * SEQ * 1024 + h * 128;
    const float* Gg = (const float*)(a->ws + WS_GATES) + (size_t)b * SEQ * 16 + h;
    const int qrow = tid >> 3, qch = tid & 7;
    u32x4 qreg, kreg, vreg[2], oreg[2], qN, kN, vN[2];
    qreg = *(const u32x4*)(Qg + (size_t)qrow * 512 + qch * 8); kreg = *(const u32x4*)(Kg + (size_t)qrow * 512 + qch * 8);
    qN = *(const u32x4*)(Qg + (size_t)(CHK + qrow) * 512 + qch * 8); kN = *(const u32x4*)(Kg + (size_t)(CHK + qrow) * 512 + qch * 8);
#pragma unroll
    for (int i = 0; i < 2; ++i) { const int id = tid + 512 * i; vreg[i] = *(const u32x4*)(Vg + (size_t)(id >> 4) * 1024 + (id & 15) * 8); oreg[i] = (u32x4){0u, 0u, 0u, 0u};
        vN[i] = *(const u32x4*)(Vg + (size_t)(CHK + (id >> 4)) * 1024 + (id & 15) * 8); }
    for (int idx = tid; idx < 128 * 72 / 2; idx += NTHR) ((LAS unsigned*)CT)[idx] = 0u;
    if (tid < 64) nvec[tid] = 0.f;
    for (int cc = 0; cc < 8; ++cc) { const int c = 8 * w + cc; const float gi = Gg[(size_t)(c * CHK + lane) * 16], gf = Gg[(size_t)(c * CHK + lane) * 16 + 8];
        float bsum = gf;
#pragma unroll
        for (int o = 1; o < 64; o <<= 1) { const float t = __shfl_up(bsum, o); if (lane >= o) bsum += t; }
        const float av = gi - bsum; float pm = av;
#pragma unroll
        for (int o = 1; o < 64; o <<= 1) { const float t = __shfl_up(pm, o); if (lane >= o) pm = fmaxf(pm, t); }
        GA[c * 64 + lane] = av; GB[c * 64 + lane] = bsum; GP[c * 64 + lane] = pm; }
    __syncthreads();
    if (tid == 0) { float m = 0.f; MR[0] = 0.f; for (int c = 0; c < 64; ++c) { m = GB[c * 64 + 63] + fmaxf(m, GP[c * 64 + 63]); MR[c + 1] = m; } }
    const int ti = w >> 1, vi0 = 4 * (w & 1);
    const int trq = (lane & 15) >> 2, trp = lane & 3;
    const unsigned vs_tr = (unsigned)(size_t)Vs + (unsigned)(((8 * fq + trq) * 136 + 16 * vi0 + 4 * trp) * 2);
    const unsigned ks_tr = (unsigned)(size_t)Ks + (unsigned)(((8 * fq + trq) * 72 + 16 * ti + 4 * trp) * 2);
    float hg[4];
#pragma unroll
    for (int x = 0; x < 4; ++x) hg[x] = a->in[I_MLHG][(size_t)jl * 1024 + h * 128 + 16 * (vi0 + x) + fr];
    f32x4 Cacc[4];
#pragma unroll
    for (int x = 0; x < 4; ++x) Cacc[x] = (f32x4){0.f, 0.f, 0.f, 0.f};
    __syncthreads();
    for (int c = 0; c <= SEQ / CHK; ++c) {
        const int r0 = c * CHK;
        if (c < SEQ / CHK) {
            *(LAS u32x4*)(Qs + qrow * 72 + qch * 8) = qreg; *(LAS u32x4*)(Ks + qrow * 72 + qch * 8) = kreg;
#pragma unroll
            for (int i = 0; i < 2; ++i) { const int id = tid + 512 * i; *(LAS u32x4*)(Vs + (id >> 4) * 136 + (id & 15) * 8) = vreg[i]; }
            if (w == 0 && c > 0) { const float mp = MR[c - 1]; float n = nvec[lane] * __expf(mp - fmaxf(mp, GP[(c - 1) * 64 + 63]));
#pragma unroll
                for (int sp = 0; sp < 8; ++sp) n += npart[sp * 64 + lane];
                nvec[lane] = n; }
            CHAIN_BAR();
            {
                const int si = w >> 1; const float mr = MR[c];
                bf16x8 ak[2];
#pragma unroll
                for (int kk = 0; kk < 2; ++kk) ak[kk] = *(const LAS bf16x8*)(Ks + (16 * si + fr) * 72 + 32 * kk + 8 * fq);
                const f32x4 a4 = *(const LAS f32x4*)(GA + c * 64 + 16 * si + 4 * fq);
#pragma unroll
                for (int tt = 0; tt < 2; ++tt) { const int tj = 2 * (w & 1) + tt;
                    f32x4 s4 = (f32x4){0.f, 0.f, 0.f, 0.f};
#pragma unroll
                    for (int kk = 0; kk < 2; ++kk) { const bf16x8 bq = *(const LAS bf16x8*)(Qs + (16 * tj + fr) * 72 + 32 * kk + 8 * fq); s4 = __builtin_amdgcn_mfma_f32_16x16x32_bf16(ak[kk], bq, s4, 0, 0, 0); }
                    const int t = 16 * tj + fr; const float Mt = fmaxf(mr, GP[c * 64 + t]); float vv[4];
#pragma unroll
                    for (int r = 0; r < 4; ++r) { const int s = 16 * si + 4 * fq + r; vv[r] = (s <= t) ? s4[r] * __expf(a4[r] - Mt) : 0.f; }
                    u32x2 pw; pw.x = cvtpk(vv[0], vv[1]); pw.y = cvtpk(vv[2], vv[3]);
                    *(LAS u32x2*)(Sp + t * 72 + 16 * si + 4 * fq) = pw; }
            }
            CHAIN_BAR();
        }
        else CHAIN_BAR();
        if (c > 0) {
#pragma unroll
            for (int i = 0; i < 2; ++i) { const int id = tid + 512 * i, row = id >> 4, ch = id & 15;
                const u32x4 hs = *(const LAS u32x4*)(Hs + row * 136 + ch * 8); u32x4 o;
#pragma unroll
                for (int q = 0; q < 4; ++q) o[q] = cvtpk(bflo(hs[q]) * bflo(oreg[i][q]), bfhi(hs[q]) * bfhi(oreg[i][q]));
                *(u32x4*)(Hg + (size_t)(r0 - CHK + row) * 1024 + ch * 8) = o; }
        }
        if (c == SEQ / CHK) break;
        {
            const int rn = (c + 2 < SEQ / CHK) ? r0 + 2 * CHK : r0;
            qreg = qN; kreg = kN; vreg[0] = vN[0]; vreg[1] = vN[1];
            qN = *(const u32x4*)(Qg + (size_t)(rn + qrow) * 512 + qch * 8); kN = *(const u32x4*)(Kg + (size_t)(rn + qrow) * 512 + qch * 8);
#pragma unroll
            for (int i = 0; i < 2; ++i) { const int id = tid + 512 * i; vN[i] = *(const u32x4*)(Vg + (size_t)(rn + (id >> 4)) * 1024 + (id & 15) * 8);
                oreg[i] = *(const u32x4*)(Og + (size_t)(r0 + (id >> 4)) * 1024 + (id & 15) * 8); }
        }
        float hv[4][4];
        {
            const float mr = MR[c]; const float M63 = fmaxf(mr, GP[c * 64 + 63]); const float decay = __expf(mr - M63);
            float den[4], et[4], enm[4];
            {
                const f32x4 n4 = *(const LAS f32x4*)(nvec + 4 * fr);
                const f32x4 p4 = *(const LAS f32x4*)(GP + c * 64 + 16 * ti + 4 * fq), b4 = *(const LAS f32x4*)(GB + c * 64 + 16 * ti + 4 * fq);
#pragma unroll
                for (int r = 0; r < 4; ++r) { const int t = 16 * ti + 4 * fq + r;
                    const u32x2 sp = *(const LAS u32x2*)(Sp + t * 72 + 4 * fr), qq = *(const LAS u32x2*)(Qs + t * 72 + 4 * fr);
                    const float ssum = (bflo(sp.x) + bfhi(sp.x)) + (bflo(sp.y) + bfhi(sp.y));
                    const float qn = (bflo(qq.x) * n4[0] + bfhi(qq.x) * n4[1]) + (bflo(qq.y) * n4[2] + bfhi(qq.y) * n4[3]);
                    const float Mt = fmaxf(mr, p4[r]); et[r] = __expf(mr - Mt); enm[r] = __expf(-(b4[r] + Mt));
                    float p = ssum + et[r] * qn;
                    p = row16_sum(p);
                    den[r] = __builtin_amdgcn_rcpf(fmaxf(fabsf(p), enm[r])); }
            }
            bf16x8 as_[2], aq[2], akw[2], kf[2], bVall[4][2];
            tr_frag10(ks_tr, vs_tr, kf, bVall);
#pragma unroll
            for (int kk = 0; kk < 2; ++kk) { as_[kk] = *(const LAS bf16x8*)(Sp + (16 * ti + fr) * 72 + 32 * kk + 8 * fq); aq[kk] = *(const LAS bf16x8*)(Qs + (16 * ti + fr) * 72 + 32 * kk + 8 * fq); }
            {
                const bf16x8 k0 = kf[0], k1 = kf[1];
#pragma unroll
                for (int kk = 0; kk < 2; ++kk) { const u32x4 kw = __builtin_bit_cast(u32x4, kk ? k1 : k0);
                    const f32x4 a0 = *(const LAS f32x4*)(GA + c * 64 + 32 * kk + 8 * fq), a1 = *(const LAS f32x4*)(GA + c * 64 + 32 * kk + 8 * fq + 4);
                    u32x4 pk; pk.x = cvtpk(bflo(kw.x) * __expf(a0[0] - M63), bfhi(kw.x) * __expf(a0[1] - M63)); pk.y = cvtpk(bflo(kw.y) * __expf(a0[2] - M63), bfhi(kw.y) * __expf(a0[3] - M63));
                    pk.z = cvtpk(bflo(kw.z) * __expf(a1[0] - M63), bfhi(kw.z) * __expf(a1[1] - M63)); pk.w = cvtpk(bflo(kw.w) * __expf(a1[2] - M63), bfhi(kw.w) * __expf(a1[3] - M63));
                    akw[kk] = __builtin_bit_cast(bf16x8, pk); }
            }
            float ssq[4] = {0.f, 0.f, 0.f, 0.f};
#pragma unroll
            for (int x = 0; x < 4; ++x) { const int vi = vi0 + x;
                bf16x8 bV[2], bC[2]; bV[0] = bVall[x][0]; bV[1] = bVall[x][1];
#pragma unroll
                for (int kk = 0; kk < 2; ++kk) bC[kk] = *(const LAS bf16x8*)(CT + (16 * vi + fr) * 72 + 32 * kk + 8 * fq);
                f32x4 a1 = (f32x4){0.f, 0.f, 0.f, 0.f}, a2 = (f32x4){0.f, 0.f, 0.f, 0.f};
                a1 = __builtin_amdgcn_mfma_f32_16x16x32_bf16(as_[0], bV[0], a1, 0, 0, 0); a1 = __builtin_amdgcn_mfma_f32_16x16x32_bf16(as_[1], bV[1], a1, 0, 0, 0);
                a2 = __builtin_amdgcn_mfma_f32_16x16x32_bf16(aq[0], bC[0], a2, 0, 0, 0); a2 = __builtin_amdgcn_mfma_f32_16x16x32_bf16(aq[1], bC[1], a2, 0, 0, 0);
                Cacc[x] = Cacc[x] * decay;
                Cacc[x] = __builtin_amdgcn_mfma_f32_16x16x32_bf16(akw[0], bV[0], Cacc[x], 0, 0, 0); Cacc[x] = __builtin_amdgcn_mfma_f32_16x16x32_bf16(akw[1], bV[1], Cacc[x], 0, 0, 0);
#pragma unroll
                for (int r = 0; r < 4; ++r) { const float hh = (a1[r] + et[r] * a2[r]) * den[r]; hv[x][r] = hh; ssq[r] += hh * hh; } }
#pragma unroll
            for (int r = 0; r < 4; ++r) { const float p = row16_sum(ssq[r]);
                if (fr == 0) rss[(16 * ti + 4 * fq + r) * 2 + (w & 1)] = p; }
            { float pn = 0.f; const int d = tid & 63; const f32x4 a0 = *(const LAS f32x4*)(GA + c * 64 + 8 * w), a1 = *(const LAS f32x4*)(GA + c * 64 + 8 * w + 4);
#pragma unroll
              for (int s = 0; s < 8; ++s) pn += __expf((s < 4 ? a0[s & 3] : a1[s & 3]) - M63) * bf2f(Ks[(8 * w + s) * 72 + d]);
              npart[w * 64 + d] = pn; }
        }
        CHAIN_BAR();
        {
#pragma unroll
            for (int r = 0; r < 4; ++r) { const int t = 16 * ti + 4 * fq + r; const float rstd = __builtin_amdgcn_rsqf((rss[t * 2] + rss[t * 2 + 1]) * (1.f / DV) + RMS_EPS);
#pragma unroll
                for (int x = 0; x < 4; ++x) Hs[t * 136 + 16 * (vi0 + x) + fr] = (bf16_t)f2bf(hv[x][r] * rstd * hg[x]); }
#pragma unroll
            for (int x = 0; x < 4; ++x) { u32x2 pw; pw.x = cvtpk(Cacc[x][0], Cacc[x][1]); pw.y = cvtpk(Cacc[x][2], Cacc[x][3]);
                *(LAS u32x2*)(CT + (16 * (vi0 + x) + fr) * 72 + 16 * ti + 4 * fq) = pw; }
        }
    }
}

DI void ph_conv(int wv, int jl) {
    const CArgs* a = kargs(); const Frame F = make_frame(wv); asm volatile("" : "+s"(jl));
    const bf16_t* XRH = (const bf16_t*)(a->ws + WS_R + R_XR); bf16_t* XC = (bf16_t*)(a->ws + WS_R + R_XC);
    for (int it = F.vcu * NTHR + F.tid; it < (T / 64) * 3 * 128; it += F.G * NTHR) {
        const int chg = it & 127, i = (it >> 7) % 3, blk = it / (3 * 128), c0 = chg * 8;
        const u32x4 z = (u32x4){0u, 0u, 0u, 0u}; u32x4 x[4];
#pragma unroll
        for (int j = 0; j < 4; ++j) { const int rel = i - 3 + j;
            if (rel >= 0) x[j] = *(const u32x4*)(XRH + ((size_t)blk * 6 + rel) * D + c0);
            else if ((blk & 63) == 0) x[j] = z;
            else x[j] = *(const u32x4*)(XRH + ((size_t)(blk - 1) * 6 + 6 + rel) * D + c0); }
        u32x4 o;
#pragma unroll
        for (int q = 0; q < 4; ++q) { float lo = a->in[I_LCB][jl * D + c0 + 2 * q], hi = a->in[I_LCB][jl * D + c0 + 2 * q + 1];
#pragma unroll
            for (int j = 0; j < 4; ++j) { lo += a->in[I_LCW][((size_t)jl * 4 + j) * D + c0 + 2 * q] * bflo(x[j][q]); hi += a->in[I_LCW][((size_t)jl * 4 + j) * D + c0 + 2 * q + 1] * bfhi(x[j][q]); }
            o[q] = pk2(lo, hi); }
        *(u32x4*)(XC + (size_t)(blk * 64 + i) * D + c0) = o;
    }
}
constexpr int SEGL = 128, NSEG = SEQ / SEGL;
DI void ph_scan(int wv) {
    const CArgs* a = kargs(); const Frame F = make_frame(wv);
    const bf16_t* LA = (const bf16_t*)(a->ws + WS_R + R_LA); const bf16_t* U = (const bf16_t*)(a->ws + WS_R + R_U);
    const bf16_t* GB = (const bf16_t*)(a->ws + WS_R + R_GB); bf16_t* Y = (bf16_t*)(a->ws + WS_R + R_XR);
    const f32x4* CAR = (const f32x4*)(a->ws + WS_MODP);
    for (int gid = F.vcu * NTHR + F.tid; gid < BATCH * NSEG * 256; gid += F.G * NTHR) {
        const int c4 = gid & 255, seg = (gid >> 8) & (NSEG - 1), b = gid >> 13;
        const size_t base = ((size_t)b * SEQ + seg * SEGL) * D + 4 * c4;
        f32x4 h = (f32x4){0.f, 0.f, 0.f, 0.f};
#pragma unroll 4
        for (int blk = 0; blk < 2 * seg; ++blk) { const f32x4 p = CAR[((size_t)(b * 64 + blk) * 256 + c4) * 2], q = CAR[((size_t)(b * 64 + blk) * 256 + c4) * 2 + 1];
            h[0] = p[0] * h[0] + p[1]; h[1] = p[2] * h[1] + p[3]; h[2] = q[0] * h[2] + q[1]; h[3] = q[2] * h[3] + q[3]; }
#pragma unroll 8
        for (int r = 0; r < SEGL; ++r) { const u32x2 la = *(const u32x2*)(LA + base + (size_t)r * D), uu = *(const u32x2*)(U + base + (size_t)r * D);
            h[0] = __expf(bflo(la.x)) * h[0] + bflo(uu.x); h[1] = __expf(bfhi(la.x)) * h[1] + bfhi(uu.x); h[2] = __expf(bflo(la.y)) * h[2] + bflo(uu.y); h[3] = __expf(bfhi(la.y)) * h[3] + bfhi(uu.y);
            const u32x2 g = *(const u32x2*)(GB + base + (size_t)r * D); u32x2 o; o.x = pk2(h[0] * bflo(g.x), h[1] * bfhi(g.x)); o.y = pk2(h[2] * bflo(g.y), h[3] * bfhi(g.y));
            *(u32x2*)(Y + base + (size_t)r * D) = o; }
    }
}

#define PH_COMMON(jl) const CArgs* a = kargs(); const Frame F = make_frame(wv); asm volatile("" : "+s"(jl)); unsigned char* ws = a->ws; unsigned char* R = ws + WS_R; \
    const bf16_t* Wj = (const bf16_t*)(ws + WS_W) + (size_t)jl * W_PER_J; const bf16_t* HN = (const bf16_t*)(ws + WS_HN); float* XS = a->out; const float* MOD = (const float*)(ws + WS_MOD); \
    int bx = blockIdx.x; asm volatile("" : "+s"(bx)); (void)R; (void)Wj; (void)HN; (void)XS; (void)MOD
DI void ph_mlstm_gates(int wv, int jl) {
    const CArgs* a = kargs(); const Frame F = make_frame(wv); asm volatile("" : "+s"(jl));
    const bf16_t* HN = (const bf16_t*)(a->ws + WS_HN); float* G = (float*)(a->ws + WS_GATES);
    const bf16_t* Wg = (const bf16_t*)(a->ws + WS_W) + (size_t)jl * W_PER_J + W_WIN + (size_t)3072 * D;
    const int lane = F.lane, fr = lane & 15, fq = lane >> 4;
    { const int row = F.tid >> 5, ch = F.tid & 31;
#pragma unroll
      for (int q = 0; q < 4; ++q) *(LAS u32x4*)(F.lds + row * 2064 + ch * 64 + q * 16) = *(const u32x4*)(Wg + (size_t)row * D + ch * 32 + q * 8); }
    __syncthreads();
    const float bias = a->in[I_MLGB][jl * 16 + fr];
    float ln2s = 0.69314718f; asm volatile("" : "+s"(ln2s));
    const LAS unsigned char* bp = F.lds + fr * 2064 + fq * 16;
    for (int tile = F.vcu; tile < T / 256; tile += F.G) {
        const int R0 = tile * 256 + F.wave * 32;
        const bf16_t* a0 = HN + (size_t)(R0 + fr) * D + fq * 8; const bf16_t* a1 = a0 + (size_t)16 * D;
        f32x4 acc0 = (f32x4){0.f, 0.f, 0.f, 0.f}, acc1 = (f32x4){0.f, 0.f, 0.f, 0.f};
#pragma unroll 8
        for (int s = 0; s < 32; ++s) {
            const bf16x8 af0 = *(const bf16x8*)(a0 + s * 32), af1 = *(const bf16x8*)(a1 + s * 32);
            const bf16x8 bf = *(const LAS bf16x8*)(bp + s * 64);
            acc0 = __builtin_amdgcn_mfma_f32_16x16x32_bf16(af0, bf, acc0, 0, 0, 0); acc1 = __builtin_amdgcn_mfma_f32_16x16x32_bf16(af1, bf, acc1, 0, 0, 0);
        }
#pragma unroll
        for (int r = 0; r < 4; ++r) { float x0 = acc0[r] + bias, x1 = acc1[r] + bias;
            if (fr >= 8) { x0 = fminf(x0, 0.f) - ln2s * __builtin_amdgcn_logf(1.f + __expf(-fabsf(x0))); x1 = fminf(x1, 0.f) - ln2s * __builtin_amdgcn_logf(1.f + __expf(-fabsf(x1))); }
            G[(size_t)(R0 + 4 * fq + r) * 16 + fr] = x0; G[(size_t)(R0 + 16 + 4 * fq + r) * 16 + fr] = x1; }
    }
    __syncthreads();
}
DI void ph_gemm_mlstm_in(int wv, int jl) { PH_COMMON(jl);
    pg8::Gemm g{HN, Wj + W_WIN, D, D, nullptr, 0, 0}; pg8::SchedPlain S; S.init(T / 256, 3072 / 256, F.G, bx);
    pg8::EpiMlstmIn E{(bf16_t*)(R + R_Q), (bf16_t*)(R + R_K), (bf16_t*)(R + R_V), (bf16_t*)(R + R_O), (float*)(ws + WS_GATES), a->in[I_MLGB] + jl * 16};
    pg8::gemm_phase<pg8::EpiMlstmIn, pg8::SchedPlain, false>(F.lds, F.tid, g, S, E); }
DI void ph_gemm_resid(int wv, int jl, int which) { PH_COMMON(jl); asm volatile("" : "+s"(which));
    const int layer = 2 * jl + (which == 2 ? 1 : 0);
    pg8::SchedPlain S; S.init(T / 256, D / 256, F.G, bx);
    if (which != 1) {
        pg8::Gemm g{which == 0 ? (const bf16_t*)(R + R_HS) : (const bf16_t*)(R + R_XR), Wj + (which == 0 ? W_WOUT : W_LOUT), D, D, nullptr, 0, 0};
        pg8::EpiMix E{(bf16_t*)(R + R_M1), MOD + (size_t)layer * 16 * 6144 + 2048};
        pg8::gemm_phase<pg8::EpiMix, pg8::SchedPlain, false>(F.lds, F.tid, g, S, E);
    } else {
#define RESID_ARGS a->in[I_X], (bf16_t*)(R + R_XSB), MOD + (size_t)layer * 16 * 6144 + 5120, (const bf16_t*)(R + R_M1), (const float*)(ws + WS_CA1) + (size_t)jl * 16 * D, (bf16_t*)(ws + WS_HN), (float*)(ws + WS_GATES), F.lds
        if (DENSE_FP8_AT(jl)) { pg8::Gemm g{(const bf16_t*)(R + R_ACT), Wj + W_W2, DFF / 2, DFF / 2, nullptr, pg8::E8_W2, pg8::E8_ACT};
            if (jl == 0) { pg8::EpiResidT<false> E{RESID_ARGS}; pg8::gemm_phase<pg8::EpiResidT<false>, pg8::SchedPlain, false, true>(F.lds, F.tid, g, S, E); }
            else { pg8::EpiResidT<true> E{RESID_ARGS}; pg8::gemm_phase<pg8::EpiResidT<true>, pg8::SchedPlain, false, true>(F.lds, F.tid, g, S, E); } }
        else { pg8::Gemm g{(const bf16_t*)(R + R_ACT), Wj + W_W2, DFF, DFF, nullptr, 0, 0};
            if (jl == 0) { pg8::EpiResidT<false> E{RESID_ARGS}; pg8::gemm_phase<pg8::EpiResidT<false>, pg8::SchedPlain, false>(F.lds, F.tid, g, S, E); }
            else { pg8::EpiResidT<true> E{RESID_ARGS}; pg8::gemm_phase<pg8::EpiResidT<true>, pg8::SchedPlain, false>(F.lds, F.tid, g, S, E); } }
#undef RESID_ARGS
    }
}
DI void ph_gemm_ffn_up(int wv, int jl) { PH_COMMON(jl);
    pg8::SchedPlain S; S.init(T / 256, 2 * DFF / 256, F.G, bx);
    if (DENSE_FP8_AT(jl)) { pg8::EpiSwigluT<true> E{(unsigned char*)(R + R_ACT)}; pg8::Gemm g{HN, Wj + W_W13, D / 2, D / 2, nullptr, pg8::E8_W13, pg8::E8_HN}; pg8::gemm_phase<pg8::EpiSwigluT<true>, pg8::SchedPlain, false, true>(F.lds, F.tid, g, S, E); }
    else { pg8::EpiSwigluT<false> E{(unsigned char*)(R + R_ACT)}; pg8::Gemm g{HN, Wj + W_W13, D, D, nullptr, 0, 0}; pg8::gemm_phase<pg8::EpiSwigluT<false>, pg8::SchedPlain, false, false>(F.lds, F.tid, g, S, E); } }
DI void ph_gemm_lru_in(int wv, int jl) { PH_COMMON(jl);
    pg8::Gemm g{HN, Wj + W_LIN, D, D, nullptr, 0, 0}; pg8::SchedPlain S; S.init(T / 256, 2 * D / 256, F.G, bx);
    pg8::EpiLruIn E{(bf16_t*)(R + R_GB), (bf16_t*)(R + R_XC), (bf16_t*)(R + R_XR), a->in[I_LCW] + (size_t)jl * 4 * D, a->in[I_LCB] + (size_t)jl * D, F.lds,
                     (const float*)(ws + WS_GATES), (const float*)(ws + WS_BIASP) + (size_t)jl * 8 * 16 * 2048};
    pg8::gemm_phase<pg8::EpiLruIn, pg8::SchedPlain, false>(F.lds, F.tid, g, S, E); }
DI void ph_gemm_lru_gate(int wv, int jl) { PH_COMMON(jl);
    pg8::Gemm g{(const bf16_t*)(R + R_XC), Wj + W_GW, D, 256, nullptr, 0, 0}; pg8::SchedLruGate S; S.init(T / 256, 8, F.G, bx);
    pg8::EpiLruGate E{(const bf16_t*)(R + R_XC), (bf16_t*)(R + R_LA), (bf16_t*)(R + R_U), a->in[I_LGB] + (size_t)jl * 4 * 512, (const float*)(ws + WS_SP) + jl * D, (float*)(ws + WS_MODP)};
    pg8::gemm_phase<pg8::EpiLruGate, pg8::SchedLruGate, false>(F.lds, F.tid, g, S, E); }
DI void moe_sched(pg8::SchedMoe& S, unsigned char* ws, int& nti) { unsigned* META = (unsigned*)(ws + WS_CTL) + CW_META;
    nti = (int)__hip_atomic_load(META + 0, __ATOMIC_RELAXED, __HIP_MEMORY_SCOPE_AGENT);
    S.ts1 = (int)__hip_atomic_load(META + 2, __ATOMIC_RELAXED, __HIP_MEMORY_SCOPE_AGENT); S.ts2 = (int)__hip_atomic_load(META + 3, __ATOMIC_RELAXED, __HIP_MEMORY_SCOPE_AGENT);
    S.ts3 = (int)__hip_atomic_load(META + 4, __ATOMIC_RELAXED, __HIP_MEMORY_SCOPE_AGENT); S.ts4 = (int)__hip_atomic_load(META + 5, __ATOMIC_RELAXED, __HIP_MEMORY_SCOPE_AGENT);
    S.ts5 = (int)__hip_atomic_load(META + 6, __ATOMIC_RELAXED, __HIP_MEMORY_SCOPE_AGENT); S.ts6 = (int)__hip_atomic_load(META + 7, __ATOMIC_RELAXED, __HIP_MEMORY_SCOPE_AGENT);
    S.ts7 = (int)__hip_atomic_load(META + 8, __ATOMIC_RELAXED, __HIP_MEMORY_SCOPE_AGENT);
    nti = __builtin_amdgcn_readfirstlane(nti); S.ts1 = __builtin_amdgcn_readfirstlane(S.ts1); S.ts2 = __builtin_amdgcn_readfirstlane(S.ts2); S.ts3 = __builtin_amdgcn_readfirstlane(S.ts3);
    S.ts4 = __builtin_amdgcn_readfirstlane(S.ts4); S.ts5 = __builtin_amdgcn_readfirstlane(S.ts5); S.ts6 = __builtin_amdgcn_readfirstlane(S.ts6); S.ts7 = __builtin_amdgcn_readfirstlane(S.ts7); }
DI void ph_gemm_moe_up(int wv, int jl) { PH_COMMON(jl);
    pg8::SchedMoe S; int nti; moe_sched(S, ws, nti);
    pg8::Gemm g{HN, Wj + W_MW13, D / 2, D / 2, (const int*)(ws + WS_SLOTTOK), pg8::E8_W13, pg8::E8_HN}; S.init(nti, 2 * DFF / 256, F.G, bx); S.estride = (size_t)DFF * D;
    pg8::EpiSwiglu E{(unsigned char*)(R + R_ACT)};
    pg8::gemm_phase<pg8::EpiSwiglu, pg8::SchedMoe, true, true>(F.lds, F.tid, g, S, E); }
DI void ph_gemm_moe_down(int wv, int jl) { PH_COMMON(jl);
    pg8::SchedMoe S; int nti; moe_sched(S, ws, nti);
    pg8::Gemm g{(const bf16_t*)(R + R_ACT), Wj + W_MW2, DFF / 2, DFF / 2, nullptr, pg8::E8_W2, pg8::E8_ACT}; S.init(nti, D / 256, F.G, bx); S.estride = (size_t)D * DFF / 2;
    pg8::EpiBf16 E{(bf16_t*)(R + R_YS), D};
    pg8::gemm_phase<pg8::EpiBf16, pg8::SchedMoe, false, true>(F.lds, F.tid, g, S, E); }

constexpr int N_PHASES = 3 + 2 * 18;
#ifndef ONLY
#define ONLY -1
#endif
#define EN(k) (ONLY < 0 || ONLY == (k))
#ifndef DUP_MASK
#define DUP_MASK 0ull
#endif
#define DUP(k) (((DUP_MASK) >> (k)) & 1ull)
DI void seam() { XcdBarrier b; b.bar = (unsigned*)(kargs()->ws + WS_CTL) + CW_BAR; b.x = xb_xcc_id(); b.st = (volatile LAS unsigned*)((LAS unsigned char*)lds_raw + MISC_OFF) + 8; xcd_barrier(b); }
__global__ void __launch_bounds__(NTHR, 2) fwd(Args args) {
    { volatile LAS unsigned* MISC = (volatile LAS unsigned*)((LAS unsigned char*)lds_raw + MISC_OFF);
      if (threadIdx.x < 64) MISC[threadIdx.x] = 0u;
      __syncthreads();
      if (!MK_PER_PHASE) (void)xcd_barrier_post((unsigned*)(args.ws + WS_CTL) + CW_BAR, MISC + 8); }
    const int wv = __builtin_amdgcn_readfirstlane((int)threadIdx.x >> 6);
    const int lo = args.ph_lo, hi = args.ph_hi;
#define IN(k) (lo <= (k) && (k) < hi)
#define SEAM(k) do { if (IN(k) && IN((k) + 1)) seam(); } while (0)
    if (EN(100) && IN(0)) { ph_prologue_a(wv); if (DUP(20)) { __syncthreads(); ph_prologue_a(wv); } }
    SEAM(0);
    if (EN(102) && IN(2)) { row_pass<0, false>(wv, 0, 0, 0, 0, 0, 0); if (DUP(22)) row_pass<0, false>(wv, 0, 0, 0, 0, 0, 0); }
    SEAM(2);
#pragma nounroll
    for (int jl = 0; jl < 2; ++jl) {
        const int P = 3 + 18 * jl, LA_ = 2 * jl, LB_ = 2 * jl + 1;
        if (EN(0) && IN(P + 0)) { ph_mlstm_gates(wv, jl); ph_gemm_mlstm_in(wv, jl); if (DUP(0)) ph_gemm_mlstm_in(wv, jl); }
        SEAM(P + 0);
        if (EN(1) && IN(P + 1)) { if (blockIdx.x >= BATCH * ML_H) { ph_moe_convert(wv, jl); if (DUP(2)) ph_moe_convert(wv, jl); } else { ph_mlstm(wv, jl); if (DUP(1)) { __syncthreads(); ph_mlstm(wv, jl); } } }
        SEAM(P + 1);
        if (EN(2) && IN(P + 2)) ph_gemm_resid(wv, jl, 0);
        SEAM(P + 2);
        if (EN(3) && IN(P + 3)) { ph_lru_tables(wv, jl); if (jl == 0) row_pass<0, false>(wv, 0, LA_ * 2 + 1, LA_, 1, jl, 1); else row_pass<0, true>(wv, 1, LA_ * 2 + 1, LA_, 1, jl, 1); }
        SEAM(P + 3);
        if (EN(4) && IN(P + 4)) { ph_gemm_ffn_up(wv, jl); if (DUP(4)) ph_gemm_ffn_up(wv, jl); }
        SEAM(P + 4);
        if (EN(2) && IN(P + 5)) ph_gemm_resid(wv, jl, 1);
        SEAM(P + 5);
        if (EN(7) && IN(P + 7)) { ph_gemm_lru_in(wv, jl); if (DUP(7)) ph_gemm_lru_in(wv, jl); }
        SEAM(P + 7);
        if (EN(8) && IN(P + 8)) { ph_conv(wv, jl); if (DUP(8)) ph_conv(wv, jl); }
        SEAM(P + 8);
        if (EN(9) && IN(P + 9)) { ph_gemm_lru_gate(wv, jl); if (DUP(9)) ph_gemm_lru_gate(wv, jl); }
        SEAM(P + 9);
        if (EN(11) && IN(P + 11)) { ph_scan(wv); if (DUP(11)) ph_scan(wv); }
        SEAM(P + 11);
        if (EN(2) && IN(P + 12)) ph_gemm_resid(wv, jl, 2);
        SEAM(P + 12);
        if (EN(13) && IN(P + 13)) { row_pass<1, true>(wv, 1, LB_ * 2 + 1, LB_, 1, jl, 1); if (DUP(13)) { __syncthreads(); row_pass<1, true>(wv, 1, LB_ * 2 + 1, LB_, 1, jl, 1); } }
        SEAM(P + 13);
        if (EN(14) && IN(P + 14)) { ph_slots(wv); if (DUP(14)) { __syncthreads(); ph_slots(wv); } }
        SEAM(P + 14);
        if (EN(15) && IN(P + 15)) { ph_gemm_moe_up(wv, jl); if (DUP(15)) ph_gemm_moe_up(wv, jl); }
        SEAM(P + 15);
        if (EN(16) && IN(P + 16)) { ph_gemm_moe_down(wv, jl); if (DUP(16)) ph_gemm_moe_down(wv, jl); }
        SEAM(P + 16);
        if (EN(17) && IN(P + 17)) { if (jl == 0) row_pass<2, true>(wv, 1, (LB_ + 1) * 2 + 0, LB_ + 1, 0, jl, 1); else row_pass<3, true>(wv, 1, -1, LB_, 0, jl, 1); }
        SEAM(P + 17);
    }
#undef IN
#undef SEAM
}

extern "C" void kernel_launch(void* const* d_in, const int* in_sizes, int n_in, void* d_out, int out_size, void* d_ws, size_t ws_size, hipStream_t stream) {
    static int grid = 0;
    if (grid == 0) {
        if (n_in != N_IN || out_size != T * D || ws_size < WS_END) { fprintf(stderr, "kernel_launch: unexpected problem (n_in %d out %d ws %zu, need %zu)\n", n_in, out_size, ws_size, (size_t)WS_END); grid = -1; return; }
        int dev = 0, cus = 0, per_cu = 0;
        if (hipGetDevice(&dev) != hipSuccess || hipDeviceGetAttribute(&cus, hipDeviceAttributeMultiprocessorCount, dev) != hipSuccess) { grid = -1; return; }
        if (hipFuncSetAttribute((const void*)fwd, hipFuncAttributeMaxDynamicSharedMemorySize, LDS_BYTES) != hipSuccess) { fprintf(stderr, "kernel_launch: hipFuncSetAttribute failed\n"); grid = -1; return; }
        if (hipOccupancyMaxActiveBlocksPerMultiprocessor(&per_cu, (const void*)fwd, NTHR, LDS_BYTES) != hipSuccess || per_cu < 1) fprintf(stderr, "kernel_launch: occupancy query says %d\n", per_cu);
        (void)hipGetLastError();
        grid = cus;
    }
    if (grid < 0) return;
    (void)hipMemsetAsync((char*)d_ws + WS_CTL, 0, CTL_ZERO_BYTES, stream);
    Args a{};
    for (int i = 0; i < N_IN; ++i) a.in[i] = (const float*)d_in[i];
    a.out = (float*)d_out; a.ws = (unsigned char*)d_ws;
#if MK_PER_PHASE
    for (int p = 0; p < N_PHASES; ++p) { a.ph_lo = p; a.ph_hi = p + 1; hipLaunchKernelGGL(fwd, dim3(grid), dim3(NTHR), LDS_BYTES, stream, a); }
#else
    a.ph_lo = 0; a.ph_hi = N_PHASES; hipLaunchKernelGGL(fwd, dim3(grid), dim3(NTHR), LDS_BYTES, stream, a);
#endif
}
```

```cpp
#include <hip/hip_runtime.h>
#include <cstdio>
#include <cstdint>

#ifndef DENSE_FP8_MASK
#define DENSE_FP8_MASK 3
#endif
#define DENSE_FP8_AT(jl) (((DENSE_FP8_MASK) >> (jl)) & 1)
#ifndef MK_PER_PHASE
#define MK_PER_PHASE 0
#endif

#define DI __device__ __forceinline__
#define GAS __attribute__((address_space(1)))
#define LAS __attribute__((address_space(3)))
typedef unsigned short bf16_t;
typedef short bf16x8 __attribute__((ext_vector_type(8)));
typedef float f32x4 __attribute__((ext_vector_type(4)));
typedef float f32x2 __attribute__((ext_vector_type(2)));
typedef unsigned u32x4 __attribute__((ext_vector_type(4)));
typedef unsigned u32x2 __attribute__((ext_vector_type(2)));
typedef int i32x2 __attribute__((ext_vector_type(2)));

constexpr int D = 1024, BATCH = 16, SEQ = 4096, T = BATCH * SEQ;
constexpr int ML_H = 8, DV = 128, DQK = 64, CHK = 64, MLP = 3088, MLPP = 3328;
constexpr int DFF = 3584, NE = 8;
constexpr int MAXSLOT = 2 * T + 8 * 256;
constexpr float RMS_EPS = 1e-6f;
constexpr int NWAVES = 8, NTHR = 512;

enum { I_X = 0, I_C, I_ADAW, I_ADAB, I_NORMG, I_MLWIN, I_MLGB, I_MLHG, I_MLWOUT, I_FW13, I_FW2, I_LWIN, I_LCW, I_LCB, I_LGW, I_LGB, I_LAP, I_LWOUT, I_RW, I_RB, I_MW13, I_MW2, I_FNG, N_IN };

constexpr size_t MiB = 1u << 20;
constexpr size_t WS_CTL = 0, CTL_ZERO_BYTES = 1 * MiB;
constexpr size_t WS_MOD = 1 * MiB;
constexpr size_t WS_MODP = 3 * MiB;
constexpr size_t WS_SP = 15 * MiB;
constexpr size_t WS_CA1 = 15 * MiB + 64 * 1024;
constexpr size_t WS_GATES = 16 * MiB;
constexpr size_t WS_BIASP = 20 * MiB;
constexpr size_t WS_TOPE = 22 * MiB;
constexpr size_t WS_TOPW = 22 * MiB + 512 * 1024;
constexpr size_t WS_HIST = 23 * MiB;
constexpr size_t WS_SLOTTOK = 23 * MiB + 256 * 1024;
constexpr size_t WS_TOKSLOT = 24 * MiB;
constexpr size_t WS_W = 32 * MiB;
constexpr size_t WS_HN = 448 * MiB;
constexpr size_t WS_R = 576 * MiB;
constexpr size_t WS_END = WS_R + 1170 * MiB;
constexpr size_t W_WIN = 0, W_WOUT = W_WIN + (size_t)MLPP * D, W_W13 = W_WOUT + (size_t)D * D, W_W2 = W_W13 + (size_t)2 * DFF * D, W_LIN = W_W2 + (size_t)D * DFF,
                 W_GW = W_LIN + (size_t)2 * D * D, W_LOUT = W_GW + (size_t)4 * 512 * 256, W_MW13 = W_LOUT + (size_t)D * D, W_MW2 = W_MW13 + (size_t)NE * 2 * DFF * D, W_PER_J = W_MW2 + (size_t)NE * D * DFF;
static_assert(WS_W + 2 * W_PER_J * 2 <= WS_HN, "weights fit");
constexpr size_t R_Q = 0, R_K = 64 * MiB, R_V = 128 * MiB, R_O = 256 * MiB, R_HS = 384 * MiB;
constexpr size_t R_ACT = 0;
constexpr size_t R_GB = 0, R_XR = 128 * MiB, R_XC = 256 * MiB, R_LA = 384 * MiB, R_U = 512 * MiB;
constexpr size_t R_M1 = 512 * MiB;
constexpr size_t R_XSB = 640 * MiB;
constexpr size_t R_YS = 910 * MiB;
static_assert((size_t)MAXSLOT * DFF * 2 == 910 * MiB, "moe act size");
constexpr int CW_BAR = 4096, CW_META = 8192;

constexpr int LDS_BYTES = 147456, MISC_OFF = 147200;

DI float bf2f(unsigned short b) { return __uint_as_float(((unsigned)b) << 16); }
DI float bflo(unsigned u) { return __uint_as_float(u << 16); }
DI float bfhi(unsigned u) { return __uint_as_float(u & 0xffff0000u); }
DI unsigned f2bf(float f) { unsigned u = __float_as_uint(f); return (u + 0x7fffu + ((u >> 16) & 1u)) >> 16; }
DI unsigned pk2(float lo, float hi) { return f2bf(lo) | (f2bf(hi) << 16); }
DI float sigmoid_f(float x) { return __builtin_amdgcn_rcpf(1.f + __expf(-x)); }
DI float log1p_exp_neg(float x) {
    float ln2 = 0.69314718f; asm volatile("" : "+s"(ln2));
    const float e = __expf(-x), u = 1.f + e, d = u - 1.f;
    return d == 0.f ? e : ln2 * __builtin_amdgcn_logf(u) * (e / d);
}
DI float wave_sum(float v) {
    { const int x = __builtin_bit_cast(int, v); v += __builtin_bit_cast(float, __builtin_amdgcn_update_dpp(x, x, 0xB1, 0xf, 0xf, true)); }
    { const int x = __builtin_bit_cast(int, v); v += __builtin_bit_cast(float, __builtin_amdgcn_update_dpp(x, x, 0x4E, 0xf, 0xf, true)); }
    { const int x = __builtin_bit_cast(int, v); v += __builtin_bit_cast(float, __builtin_amdgcn_update_dpp(x, x, 0x141, 0xf, 0xf, true)); }
    { const int x = __builtin_bit_cast(int, v); v += __builtin_bit_cast(float, __builtin_amdgcn_update_dpp(x, x, 0x140, 0xf, 0xf, true)); }
    const int y = __builtin_bit_cast(int, v);
    const float r0 = __builtin_bit_cast(float, __builtin_amdgcn_readlane(y, 0)), r1 = __builtin_bit_cast(float, __builtin_amdgcn_readlane(y, 16));
    const float r2 = __builtin_bit_cast(float, __builtin_amdgcn_readlane(y, 32)), r3 = __builtin_bit_cast(float, __builtin_amdgcn_readlane(y, 48));
    return (r0 + r1) + (r2 + r3);
}
DI int wave_sum_i(int v) {
#pragma unroll
    for (int o = 1; o < 64; o <<= 1) v += __shfl_xor(v, o);
    return v;
}
#define LDS_WAIT() asm volatile("s_waitcnt lgkmcnt(0)" ::: "memory")

#define XB_TMO      128
#define XB_XCNT(j)  (256  + 64 * (j))
#define XB_XSUB(j)  (1280 + 64 * (j))
#define XB_XGEN(j)  (2304 + 64 * (j))
#define XB_TOP      3328
#define XB_TOPGEN   3392
#define XCD_BAR_WORDS 3456
#define XB_SPIN_CAP (1u << 19)
DI unsigned xb_ld(unsigned* p)              { return __hip_atomic_load(p, __ATOMIC_RELAXED, __HIP_MEMORY_SCOPE_AGENT); }
DI unsigned xb_add(unsigned* p, unsigned v) { return __hip_atomic_fetch_add(p, v, __ATOMIC_RELAXED, __HIP_MEMORY_SCOPE_AGENT); }
DI unsigned xb_xcc_id() { return (unsigned)__builtin_amdgcn_s_getreg((3 << 11) | 20) & 0xFu; }
#define XB_SPIN(cond, bar) do { unsigned _sp = 0; while (cond) { __builtin_amdgcn_s_sleep(1); \
    if ((++_sp & 255u) == 0u) { if (xb_ld(&(bar)[XB_TMO])) break; if (_sp > XB_SPIN_CAP) { atomicAdd(&(bar)[XB_TMO], 1u); break; } } } } while (0)
struct XcdBarrier { unsigned* bar; unsigned x; volatile LAS unsigned* st; };
DI XcdBarrier xcd_barrier_post(unsigned* bar, volatile LAS unsigned* st) {
    XcdBarrier b; b.bar = bar; b.x = xb_xcc_id(); b.st = st;
    if (threadIdx.x == 0) (void)xb_add(&bar[XB_XCNT(b.x)], 1u);
    return b;
}
DI void xcd_barrier_complete(unsigned* bar, unsigned x, unsigned& nloc, unsigned& nx) {
    const unsigned G = gridDim.x * gridDim.y * gridDim.z;
    unsigned sum, cnt, mine, sp = 0u;
    for (;;) {
        sum = 0u; cnt = 0u; mine = 0u;
#pragma unroll
        for (unsigned j = 0; j < 16; ++j) { const unsigned c = xb_ld(&bar[XB_XCNT(j)]); sum += c; cnt += (c > 0u) ? 1u : 0u; mine = (j == x) ? c : mine; }
        if (sum == G) break;
        __builtin_amdgcn_s_sleep(1);
        if ((++sp & 255u) == 0u) { if (xb_ld(&bar[XB_TMO])) break; if (sp > XB_SPIN_CAP) { atomicAdd(&bar[XB_TMO], 1u); break; } }
    }
    nloc = mine > 0u ? mine : 1u; nx = cnt > 0u ? cnt : 1u;
}
DI void xcd_barrier(const XcdBarrier& b) {
    asm volatile("s_waitcnt vmcnt(0)" ::: "memory");
    __syncthreads();
    if (threadIdx.x == 0) {
        unsigned* bar = b.bar;
        __builtin_amdgcn_s_waitcnt(0);
        unsigned nloc = b.st[0], nx = b.st[1];
        if (nloc == 0u) { xcd_barrier_complete(bar, b.x, nloc, nx); b.st[0] = nloc; b.st[1] = nx; }
        const unsigned old = xb_add(&bar[XB_XSUB(b.x)], 1u);
        const unsigned gen = old / nloc;
        if (old + 1u == (gen + 1u) * nloc) {
            __builtin_amdgcn_fence(__ATOMIC_RELEASE, "agent");
            asm volatile("s_waitcnt vmcnt(0)" ::: "memory");
            const unsigned og = xb_add(&bar[XB_TOP], 1u);
            const unsigned tg = og / nx;
            if (og + 1u == (tg + 1u) * nx) xb_add(&bar[XB_TOPGEN], 1u);
            else XB_SPIN(xb_ld(&bar[XB_TOPGEN]) == tg, bar);
            __builtin_amdgcn_fence(__ATOMIC_ACQUIRE, "agent");
            xb_add(&bar[XB_XGEN(b.x)], 1u);
            asm volatile("s_waitcnt vmcnt(0)" ::: "memory");
        } else {
            XB_SPIN(xb_ld(&bar[XB_XGEN(b.x)]) == gen, bar);
            __builtin_amdgcn_fence(__ATOMIC_ACQUIRE, "agent");
            asm volatile("s_waitcnt vmcnt(0)" ::: "memory");
        }
    }
    __syncthreads();
}

namespace pg8 {
constexpr int BM = 256, BK = 64, HALF = 128, HTB = HALF * BK * 2, STAGE_BYTES = 8 * HTB, NXCD = 8, WGM = 8;
__host__ __device__ __forceinline__ int lds_byte(int r, int c) { const int st = (r >> 4) * 2 + (c >> 5), rr = r & 15, cc = c & 31, ob = rr * 64 + cc * 2; return st * 1024 + (ob ^ (((ob >> 9) & 1) << 5)); }
__host__ __device__ __forceinline__ void stage_rc(int b, int& R, int& C) { const int st = b / 1024, sb = b % 1024, swz = sb ^ (((sb >> 9) & 1) << 5); R = (st >> 1) * 16 + swz / 64; C = (st & 1) * 32 + (swz % 64) / 2; }
__host__ __device__ __forceinline__ int perm32(int rho) { const int n = rho >> 4, i = rho & 15; return 8 * (i >> 2) + 4 * n + (i & 3); }
struct Unit { int pm, pn; };
struct Gemm { const bf16_t* A; const bf16_t* Bt; int lda, K; const int* gidx; int sc_w, sc_a; };

struct Order {
    int nM, nN, nwg, G, c;
    DI void init(int nM_, int nN_, int G_, int c_) { nM = nM_; nN = nN_; nwg = nM * nN; G = G_; c = c_; }
    DI bool next(int i, Unit& u) const {
        const long L = (long)i * G + c; if (L >= nwg) return false;
        int wgid = (int)L; { const int q = nwg / NXCD, r = nwg % NXCD, xcd = wgid % NXCD, off = wgid / NXCD; wgid = (xcd < r ? xcd * (q + 1) : r * (q + 1) + (xcd - r) * q) + off; }
        const int nig = WGM * nN, gid = wgid / nig, fm = gid * WGM, gsz = (nM - fm) < WGM ? (nM - fm) : WGM;
        u.pm = fm + ((wgid % nig) % gsz); u.pn = (wgid % nig) / gsz; return true;
    }
};
struct SchedPlain : Order { DI size_t a_off(const Unit&) const { return 0; } DI size_t b_off(const Unit&) const { return 0; } };
struct SchedLruGate : Order { DI size_t a_off(const Unit& u) const { return (size_t)(u.pn >> 1) * 256; } DI size_t b_off(const Unit&) const { return 0; } };
struct SchedMoe : Order { int ts1, ts2, ts3, ts4, ts5, ts6, ts7; size_t estride;
    DI size_t a_off(const Unit&) const { return 0; }
    DI size_t b_off(const Unit& u) const { const int e = (u.pm >= ts1) + (u.pm >= ts2) + (u.pm >= ts3) + (u.pm >= ts4) + (u.pm >= ts5) + (u.pm >= ts6) + (u.pm >= ts7); return (size_t)e * estride; } };

DI unsigned cvt_pk_bf16(float lo, float hi) { unsigned r; asm volatile("v_cvt_pk_bf16_f32 %0, %1, %2" : "=v"(r) : "v"(lo), "v"(hi)); return r; }
DI u32x4 pack8(const f32x4& v0, const f32x4& v1) { u32x4 w; w.x = cvt_pk_bf16(v0[0], v0[1]); w.y = cvt_pk_bf16(v0[2], v0[3]); w.z = cvt_pk_bf16(v1[0], v1[1]); w.w = cvt_pk_bf16(v1[2], v1[3]); return w; }

typedef f32x4 Acc[2][2][4][2];

struct EpiMlstmIn { static constexpr bool PERM = true;
    bf16_t *Q, *K, *V, *O; float* gates; const float* gate_b;
    DI void operator()(const Acc& acc, const Unit& u, int wr, int wc, int fr, int fq) const {
        const int row0 = u.pm * BM + wr * 64 + fr;
        if (u.pn < 12) {
            bf16_t* base; int ldc, colt; float sc = 1.f; bool act = false;
            if (u.pn < 2) { base = Q; ldc = 512; colt = u.pn * 256; sc = 0.125f; }
            else if (u.pn < 4) { base = K; ldc = 512; colt = (u.pn - 2) * 256; }
            else if (u.pn < 8) { base = V; ldc = 1024; colt = (u.pn - 4) * 256; }
            else { base = O; ldc = 1024; colt = (u.pn - 8) * 256; act = true; }
            const int col0 = colt + wc * 32 + 8 * fq;
#pragma unroll
            for (int ai = 0; ai < 2; ++ai)
#pragma unroll
                for (int m = 0; m < 4; ++m) { bf16_t* rowp = base + (size_t)(row0 + ai * HALF + m * 16) * ldc + col0;
#pragma unroll
                    for (int bj = 0; bj < 2; ++bj) { f32x4 v0 = acc[ai][bj][m][0], v1 = acc[ai][bj][m][1];
                        if (act) {
#pragma unroll
                            for (int j = 0; j < 4; ++j) { v0[j] = sigmoid_f(v0[j]); v1[j] = sigmoid_f(v1[j]); } }
                        v0 = v0 * sc; v1 = v1 * sc;
                        *(u32x4*)(rowp + bj * HALF) = pack8(v0, v1); } }
        }
    }
};
template <bool SB> struct EpiResidT { static constexpr bool PERM = true;
    const float* src; bf16_t* xs; const float* gmod; const bf16_t* m1;
    const float* ca; bf16_t* xa; float* ssq; LAS unsigned char* lds;
    DI void operator()(const Acc& acc, const Unit& u, int wr, int wc, int fr_, int fq_) const {
        unsigned ones = ~0u; asm volatile("" : "+s"(ones)); const int ln = (int)__builtin_amdgcn_mbcnt_hi(ones, __builtin_amdgcn_mbcnt_lo(ones, 0u)); const int fr = ln & 15, fq = ln >> 4; (void)fr_; (void)fq_;
        const int row0 = u.pm * BM + wr * 64 + fr, col0 = u.pn * BM + wc * 32 + 8 * fq;
        const int tid = (wr * 4 + wc) * 64 + ln;
        if (tid < 256) *(LAS float*)(lds + STAGE_BYTES + 6144 + tid * 4) = gmod[(size_t)(u.pm >> 4) * 6144 + u.pn * BM + tid];
        else *(LAS float*)(lds + STAGE_BYTES + 7168 + (tid - 256) * 4) = ca[(size_t)(u.pm >> 4) * D + u.pn * BM + (tid - 256)];
        asm volatile("s_waitcnt vmcnt(0) lgkmcnt(0)" ::: "memory"); __builtin_amdgcn_s_barrier(); asm volatile("" ::: "memory");
        const LAS float* GS = (const LAS float*)(lds + STAGE_BYTES + 6144) + wc * 32 + 8 * fq; const LAS float* CS = (const LAS float*)(lds + STAGE_BYTES + 7168) + wc * 32 + 8 * fq;
#pragma unroll
        for (int am = 0; am < 8; ++am) { const int ai = am >> 2, m = am & 3;
            const int row = row0 + ai * HALF + m * 16; const size_t off = (size_t)row * D + col0; float ss = 0.f;
            f32x4 sv[2][2]; u32x4 sw[2], mw[2];
#pragma unroll
            for (int bj = 0; bj < 2; ++bj) {
                if constexpr (SB) sw[bj] = *(const u32x4*)(xs + off + bj * HALF);
                else { sv[bj][0] = *(const f32x4*)(src + off + bj * HALF); sv[bj][1] = *(const f32x4*)(src + off + bj * HALF + 4); }
                mw[bj] = *(const u32x4*)(m1 + off + bj * HALF); }
#pragma unroll
            for (int bj = 0; bj < 2; ++bj) { f32x4 y[2], xo[2];
#pragma unroll
                for (int n = 0; n < 2; ++n) { const unsigned w0 = mw[bj][2 * n], w1 = mw[bj][2 * n + 1]; const f32x4 mv = (f32x4){bflo(w0), bfhi(w0), bflo(w1), bfhi(w1)};
                    f32x4 s; if constexpr (SB) { const unsigned a0 = sw[bj][2 * n], a1 = sw[bj][2 * n + 1]; s = (f32x4){bflo(a0), bfhi(a0), bflo(a1), bfhi(a1)}; } else s = sv[bj][n];
                    const f32x4 x = (s + mv) + *(const LAS f32x4*)(GS + bj * HALF + n * 4) * acc[ai][bj][m][n];
                    xo[n] = x; ss += (x[0] * x[0] + x[1] * x[1]) + (x[2] * x[2] + x[3] * x[3]); y[n] = x * *(const LAS f32x4*)(CS + bj * HALF + n * 4); }
                *(u32x4*)(xs + off + bj * HALF) = pack8(xo[0], xo[1]);
                *(u32x4*)(xa + off + bj * HALF) = pack8(y[0], y[1]); }
            ss += __shfl_xor(ss, 16); ss += __shfl_xor(ss, 32);
            if (fq == 0) *(LAS float*)(lds + STAGE_BYTES + 2048 + ((wr * 64 + ai * HALF + m * 16 + fr) * 4 + wc) * 4) = ss;
        }
        asm volatile("s_waitcnt lgkmcnt(0)" ::: "memory"); __builtin_amdgcn_s_barrier(); asm volatile("" ::: "memory");
        if (tid < 256) { const f32x4 t = *(const LAS f32x4*)(lds + STAGE_BYTES + 2048 + tid * 16); ssq[(size_t)(u.pm * BM + tid) * 4 + u.pn] = (t[0] + t[1]) + (t[2] + t[3]); }
    }
};
struct EpiMix { static constexpr bool PERM = true;
    bf16_t* M; const float* gmod;
    DI void operator()(const Acc& acc, const Unit& u, int wr, int wc, int fr, int fq) const {
        const int row0 = u.pm * BM + wr * 64 + fr, col0 = u.pn * BM + wc * 32 + 8 * fq;
        const float* gv = gmod + (size_t)(u.pm >> 4) * 6144 + col0;
        f32x4 g4[2][2];
#pragma unroll
        for (int bj = 0; bj < 2; ++bj)
#pragma unroll
            for (int n = 0; n < 2; ++n) g4[bj][n] = *(const f32x4*)(gv + bj * HALF + n * 4);
#pragma unroll
        for (int ai = 0; ai < 2; ++ai)
#pragma unroll
            for (int m = 0; m < 4; ++m) { bf16_t* rowp = M + (size_t)(row0 + ai * HALF + m * 16) * D + col0;
#pragma unroll
                for (int bj = 0; bj < 2; ++bj) *(u32x4*)(rowp + bj * HALF) = pack8(acc[ai][bj][m][0] * g4[bj][0], acc[ai][bj][m][1] * g4[bj][1]); }
    }
};
constexpr float ACT_SCALE = 4.f, HN_SCALE = 4.f, W13_SCALE = 32.f, W2_SCALE = 64.f;
constexpr int E8_ACT = 0x7d7d7d7d, E8_HN = 0x7d7d7d7d, E8_W13 = 0x7a7a7a7a, E8_W2 = 0x79797979;
DI unsigned pk4_fp8(float a, float b, float c, float d) {
    a = __builtin_amdgcn_fmed3f(a, -448.f, 448.f); b = __builtin_amdgcn_fmed3f(b, -448.f, 448.f); c = __builtin_amdgcn_fmed3f(c, -448.f, 448.f); d = __builtin_amdgcn_fmed3f(d, -448.f, 448.f);
    int w = 0; w = __builtin_amdgcn_cvt_pk_fp8_f32(a, b, w, false); w = __builtin_amdgcn_cvt_pk_fp8_f32(c, d, w, true); return (unsigned)w; }
template <bool F8> struct EpiSwigluT { static constexpr bool PERM = true;
    unsigned char* O;
    DI void operator()(const Acc& acc, const Unit& u, int wr, int wc, int fr, int fq) const {
        const int row0 = u.pm * BM + wr * 64 + fr, col0 = u.pn * HALF + wc * 32 + 8 * fq;
#pragma unroll
        for (int ai = 0; ai < 2; ++ai)
#pragma unroll
            for (int m = 0; m < 4; ++m) { f32x4 v0, v1;
#pragma unroll
                for (int j = 0; j < 4; ++j) { const float a0 = acc[ai][0][m][0][j], a1 = acc[ai][0][m][1][j];
                    if constexpr (F8) {
                        v0[j] = a0 * __builtin_amdgcn_rcpf(__builtin_fmaf(__builtin_amdgcn_exp2f(-a0), 1.f / ACT_SCALE, 1.f / ACT_SCALE)) * acc[ai][1][m][0][j];
                        v1[j] = a1 * __builtin_amdgcn_rcpf(__builtin_fmaf(__builtin_amdgcn_exp2f(-a1), 1.f / ACT_SCALE, 1.f / ACT_SCALE)) * acc[ai][1][m][1][j]; }
                    else { v0[j] = a0 * sigmoid_f(a0) * acc[ai][1][m][0][j]; v1[j] = a1 * sigmoid_f(a1) * acc[ai][1][m][1][j]; } }
                if constexpr (F8) { u32x2 w; w.x = pk4_fp8(v0[0], v0[1], v0[2], v0[3]); w.y = pk4_fp8(v1[0], v1[1], v1[2], v1[3]);
                    *(u32x2*)(O + (size_t)(row0 + ai * HALF + m * 16) * DFF + col0) = w; }
                else *(u32x4*)((bf16_t*)O + (size_t)(row0 + ai * HALF + m * 16) * DFF + col0) = pack8(v0, v1); }
    }
};
typedef EpiSwigluT<true> EpiSwiglu;
template <int K> DI float dpp_ror(float v) { const int x = __builtin_bit_cast(int, v); return __builtin_bit_cast(float, __builtin_amdgcn_update_dpp(x, x, 0x120 + K, 0xf, 0xf, true)); }
struct EpiLruIn { static constexpr bool PERM = true;
    bf16_t *GB, *XC, *XRH; const float* cw; const float* cb; LAS unsigned char* lds;
    const float* ssq; const float* biasp;
    DI void operator()(const Acc& acc, const Unit& u, int wr, int wc, int fr_, int fq_) const {
        unsigned ones = ~0u; asm volatile("" : "+s"(ones)); const int ln = (int)__builtin_amdgcn_mbcnt_hi(ones, __builtin_amdgcn_mbcnt_lo(ones, 0u)); const int fr = ln & 15, fq = ln >> 4; (void)fr_; (void)fq_;
        const int row0 = u.pm * BM + wr * 64 + fr; const bool isg = u.pn < 4; const int tid = (wr * 4 + wc) * 64 + ln;
        LAS float* RS = (LAS float*)(lds + STAGE_BYTES + 6144); LAS float* BS = (LAS float*)(lds + STAGE_BYTES + 7168); LAS float* TB = (LAS float*)(lds + STAGE_BYTES + 8192);
        if (tid < 256) { const f32x4 t = *(const f32x4*)(ssq + (size_t)(u.pm * BM + tid) * 4); RS[tid] = __builtin_amdgcn_rsqf(((t[0] + t[1]) + (t[2] + t[3])) * (1.f / D) + RMS_EPS); }
        else { const float* bp = biasp + (size_t)(u.pm >> 4) * 2048 + u.pn * BM + (tid - 256); float s = 0.f;
#pragma unroll
            for (int ks = 0; ks < 8; ++ks) s += bp[(size_t)ks * 16 * 2048];
            BS[tid - 256] = s; }
        const int c0 = (u.pn - 4) * 256;
        if (!isg) for (int idx = tid; idx < 5 * 256; idx += 512) TB[idx] = (idx < 1024) ? cw[(size_t)(idx >> 8) * D + c0 + (idx & 255)] : cb[c0 + idx - 1024];
        asm volatile("s_waitcnt vmcnt(0) lgkmcnt(0)" ::: "memory"); __builtin_amdgcn_s_barrier(); asm volatile("" ::: "memory");
        const int cl = wc * 32 + 8 * fq;
        if (isg) {
            const int col0 = u.pn * 256 + cl;
#pragma unroll
            for (int ai = 0; ai < 2; ++ai)
#pragma unroll
                for (int m = 0; m < 4; ++m) { bf16_t* rowp = GB + (size_t)(row0 + ai * HALF + m * 16) * D + col0; const float r = RS[wr * 64 + fr + ai * HALF + m * 16];
#pragma unroll
                    for (int bj = 0; bj < 2; ++bj) { f32x4 v0 = acc[ai][bj][m][0] * r + *(const LAS f32x4*)(BS + cl + bj * HALF), v1 = acc[ai][bj][m][1] * r + *(const LAS f32x4*)(BS + cl + bj * HALF + 4);
#pragma unroll
                        for (int j = 0; j < 4; ++j) { float x = v0[j]; float z = 1.5957691216f * (x + 0.044715f * x * x * x); v0[j] = x * sigmoid_f(z);
                            x = v1[j]; z = 1.5957691216f * (x + 0.044715f * x * x * x); v1[j] = x * sigmoid_f(z); }
                        *(u32x4*)(rowp + bj * HALF) = pack8(v0, v1); }
                    asm volatile("" ::: "memory"); }
        } else {
            const int col0 = c0 + cl;
#pragma unroll
            for (int ai = 0; ai < 2; ++ai)
#pragma unroll
                for (int m = 0; m < 4; ++m) { const int row = row0 + ai * HALF + m * 16; const float r = RS[wr * 64 + fr + ai * HALF + m * 16], rp = (m > 0) ? RS[wr * 64 + fr + ai * HALF + (m > 0 ? m - 1 : 0) * 16] : 0.f;
#pragma unroll
                    for (int bj = 0; bj < 2; ++bj) { f32x4 o[2], xs[2];
#pragma unroll
                        for (int n = 0; n < 2; ++n) { const LAS float* tp = TB + cl + bj * HALF + 4 * n; const f32x4 bq = *(const LAS f32x4*)(BS + cl + bj * HALF + 4 * n);
                            const f32x4 w0 = *(const LAS f32x4*)(tp), w1 = *(const LAS f32x4*)(tp + 256), w2 = *(const LAS f32x4*)(tp + 512), w3 = *(const LAS f32x4*)(tp + 768), b4 = *(const LAS f32x4*)(tp + 1024);
#pragma unroll
                            for (int j = 0; j < 4; ++j) { const float x0 = acc[ai][bj][m][n][j] * r + bq[j]; const float xp = (m > 0) ? acc[ai][bj][m > 0 ? m - 1 : 0][n][j] * rp + bq[j] : 0.f;
                                const float c1 = dpp_ror<1>(x0), c2 = dpp_ror<2>(x0), c3 = dpp_ror<3>(x0), p1 = dpp_ror<1>(xp), p2 = dpp_ror<2>(xp), p3 = dpp_ror<3>(xp);
                                const float x1 = (fr >= 1) ? c1 : p1, x2 = (fr >= 2) ? c2 : p2, x3 = (fr >= 3) ? c3 : p3;
                                xs[n][j] = x0; o[n][j] = b4[j] + w0[j] * x3 + w1[j] * x2 + w2[j] * x1 + w3[j] * x0; }
                            asm volatile("" ::: "memory"); }
                        *(u32x4*)(XC + (size_t)row * D + col0 + bj * HALF) = pack8(o[0], o[1]);
                        if (m == 0 && fr < 3) *(u32x4*)(XRH + ((size_t)(row >> 6) * 6 + fr) * D + col0 + bj * HALF) = pack8(xs[0], xs[1]);
                        if (m == 3 && fr >= 13) *(u32x4*)(XRH + ((size_t)(row >> 6) * 6 + 3 + (fr - 13)) * D + col0 + bj * HALF) = pack8(xs[0], xs[1]);
                        __builtin_amdgcn_sched_barrier(0); }
                    asm volatile("" ::: "memory"); }
        }
    }
};
template <int K> DI float dpp_shr(float v) { const int x = __builtin_bit_cast(int, v); return __builtin_bit_cast(float, __builtin_amdgcn_update_dpp(x, x, 0x110 + K, 0xf, 0xf, true)); }
struct EpiLruGate { static constexpr bool PERM = true;
    const bf16_t* XC; bf16_t *LA, *U; const float* gate_b; const float* sp; float* car64;
    DI void operator()(const Acc& acc, const Unit& u, int wr, int wc, int fr, int fq) const {
        const int row0 = u.pm * BM + wr * 64 + fr, ch0 = u.pn * HALF + wc * 32 + 8 * fq;
        const int hd = u.pn >> 1, o0 = (u.pn & 1) * HALF + wc * 32 + 8 * fq;
        u32x4 xw[2][4];
#pragma unroll
        for (int ai = 0; ai < 2; ++ai)
#pragma unroll
            for (int m = 0; m < 4; ++m) xw[ai][m] = *(const u32x4*)(XC + (size_t)(row0 + ai * HALF + m * 16) * D + ch0);
#pragma unroll
        for (int n = 0; n < 2; ++n) {
            const f32x4 bx = *(const f32x4*)(gate_b + hd * 512 + o0 + 4 * n), ba = *(const f32x4*)(gate_b + hd * 512 + 256 + o0 + 4 * n), s4 = *(const f32x4*)(sp + ch0 + 4 * n);
#pragma unroll
            for (int ai = 0; ai < 2; ++ai) {
                float Ab[4] = {1.f, 1.f, 1.f, 1.f}, Hb[4] = {0.f, 0.f, 0.f, 0.f};
#pragma unroll
                for (int m = 0; m < 4; ++m) { const size_t off = (size_t)(row0 + ai * HALF + m * 16) * D + ch0 + 4 * n;
                    float la[4], uu[4];
#pragma unroll
                    for (int j = 0; j < 4; ++j) { const unsigned w = xw[ai][m][2 * n + (j >> 1)]; const float xc = (j & 1) ? bfhi(w) : bflo(w);
                        const float ig = sigmoid_f(acc[ai][0][m][n][j] + bx[j]), rg = sigmoid_f(acc[ai][1][m][n][j] + ba[j]);
                        const float l = -8.f * rg * s4[j]; const float av = __expf(l);
                        la[j] = l; uu[j] = xc * ig * __builtin_amdgcn_sqrtf(1.f - av * av); }
                    u32x2 lw, uw; lw.x = cvt_pk_bf16(la[0], la[1]); lw.y = cvt_pk_bf16(la[2], la[3]); uw.x = cvt_pk_bf16(uu[0], uu[1]); uw.y = cvt_pk_bf16(uu[2], uu[3]);
                    *(u32x2*)(LA + off) = lw; *(u32x2*)(U + off) = uw;
#pragma unroll
                    for (int j = 0; j < 4; ++j) { const unsigned lq = (j < 2) ? lw.x : lw.y, uq = (j < 2) ? uw.x : uw.y;
                        float A = __expf((j & 1) ? bfhi(lq) : bflo(lq)), H = (j & 1) ? bfhi(uq) : bflo(uq);
                        { const float Al = dpp_shr<1>(A), Hl = dpp_shr<1>(H); H = A * Hl + H; A = Al * A; }
                        { const float Al = dpp_shr<2>(A), Hl = dpp_shr<2>(H); H = A * Hl + H; A = Al * A; }
                        { const float Al = dpp_shr<4>(A), Hl = dpp_shr<4>(H); H = A * Hl + H; A = Al * A; }
                        { const float Al = dpp_shr<8>(A), Hl = dpp_shr<8>(H); H = A * Hl + H; A = Al * A; }
                        Hb[j] = A * Hb[j] + H; Ab[j] = Ab[j] * A; } }
                if (fr == 15) { float* cp = car64 + ((size_t)(u.pm * 4 + 2 * ai + wr) * D + ch0 + 4 * n) * 2;
                    *(f32x4*)(cp) = (f32x4){Ab[0], Hb[0], Ab[1], Hb[1]}; *(f32x4*)(cp + 4) = (f32x4){Ab[2], Hb[2], Ab[3], Hb[3]}; }
            }
        }
    }
};
struct EpiBf16 { static constexpr bool PERM = true;
    bf16_t* O; int ldc;
    DI void operator()(const Acc& acc, const Unit& u, int wr, int wc, int fr, int fq) const {
        const int row0 = u.pm * BM + wr * 64 + fr, col0 = u.pn * BM + wc * 32 + 8 * fq;
#pragma unroll
        for (int ai = 0; ai < 2; ++ai)
#pragma unroll
            for (int m = 0; m < 4; ++m) { bf16_t* rowp = O + (size_t)(row0 + ai * HALF + m * 16) * ldc + col0;
#pragma unroll
                for (int bj = 0; bj < 2; ++bj) *(u32x4*)(rowp + bj * HALF) = pack8(acc[ai][bj][m][0], acc[ai][bj][m][1]); }
    }
};

typedef int i32x4 __attribute__((ext_vector_type(4)));
typedef int i32x8 __attribute__((ext_vector_type(8)));
template <class Epi, class Sched, bool GATHER, bool FP8 = false>
DI void gemm_phase(LAS unsigned char* lds, const int tid, const Gemm g, const Sched& S, const Epi& E) {
    const int wid = __builtin_amdgcn_readfirstlane(tid >> 6), lane = tid & 63, wr = wid >> 2, wc = wid & 3, fr = lane & 15, fq = lane >> 4;
    const int K = g.K, lda = g.lda, nt = K / BK;
    unsigned voffA[2], voffB[2]; int RA[2]; unsigned CA2[2];
#pragma unroll
    for (int i = 0; i < 2; ++i) { int R, C; stage_rc(tid * 16 + i * 8192, R, C); const int Rb = Epi::PERM ? ((R & ~31) + perm32(R & 31)) : R;
        voffA[i] = (unsigned)(R * lda + C) * 2u; voffB[i] = (unsigned)(Rb * K + C) * 2u; RA[i] = R; CA2[i] = (unsigned)C * 2u; }
    const size_t kstep = (size_t)(BK * 2);
    const size_t hstepA = GATHER ? 0 : (size_t)HALF * lda * 2, hstepB = (size_t)HALF * K * 2;
    const size_t tstepA = GATHER ? 0 : 2 * hstepA, tstepB = 2 * hstepB;
    const unsigned ldsw = (unsigned)wid * 1024u;
    const int aoff = lds_byte(wr * 64 + fr, fq * 8), boff = lds_byte(wc * 32 + fr, fq * 8);
    unsigned vc[2][2];
#define PG8_SA(b, h) (((b) * 2 + (h)) * HTB)
#define PG8_SB(b, h) ((4 + (b) * 2 + (h)) * HTB)
#define PG8_STAGE(bufoff, gbase, voff) do { _Pragma("unroll") for (int _i = 0; _i < 2; ++_i) \
        __builtin_amdgcn_global_load_lds((const unsigned*)((const char*)(gbase) + (voff)[_i]), (LAS unsigned*)(lds + (bufoff) + ldsw + _i * 8192), 16, 0, 0); } while (0)
#define PG8_STAGE_A(bufoff, kptr, h, VV) do { if constexpr (GATHER) { PG8_STAGE(bufoff, kptr, (VV)[h]); } else { PG8_STAGE(bufoff, (kptr) + (h) * hstepA, voffA); } } while (0)
#define PG8_LDA(dst, b, h) do { _Pragma("unroll") for (int m = 0; m < 4; ++m) _Pragma("unroll") for (int k = 0; k < 2; ++k) dst[m][k] = *(const LAS bf16x8*)(lds + PG8_SA(b, h) + aoff + m * 2048 + k * 1024); } while (0)
#define PG8_LDB(dst, b, h) do { _Pragma("unroll") for (int n = 0; n < 2; ++n) _Pragma("unroll") for (int k = 0; k < 2; ++k) dst[n][k] = *(const LAS bf16x8*)(lds + PG8_SB(b, h) + boff + n * 2048 + k * 1024); } while (0)
#define PG8_CAT(f) __builtin_shufflevector(__builtin_bit_cast(i32x4, (f)[0]), __builtin_bit_cast(i32x4, (f)[1]), 0, 1, 2, 3, 4, 5, 6, 7)
#define PG8_MMA(ai, bj, At, Bt) do { __builtin_amdgcn_s_setprio(1); _Pragma("unroll") for (int m = 0; m < 4; ++m) _Pragma("unroll") for (int n = 0; n < 2; ++n) { \
        if constexpr (FP8) { const i32x8 _b = PG8_CAT(Bt[n]), _a = PG8_CAT(At[m]); asm volatile("v_mfma_scale_f32_16x16x128_f8f6f4 %0, %1, %2, %0, %3, %4 op_sel_hi:[0,0,0]" : "+v"(acc[ai][bj][m][n]) : "v"(_b), "v"(_a), "v"(scw), "v"(sca)); } \
        else { _Pragma("unroll") for (int k = 0; k < 2; ++k) acc[ai][bj][m][n] = __builtin_amdgcn_mfma_f32_16x16x32_bf16(Bt[n][k], At[m][k], acc[ai][bj][m][n], 0, 0, 0); } } __builtin_amdgcn_s_setprio(0); } while (0)
#define PG8_WAIT_V(n) asm volatile("s_waitcnt vmcnt(" #n ")" ::: "memory")
#define PG8_WAIT_L(n) asm volatile("s_waitcnt lgkmcnt(" #n ")" ::: "memory")
#define PG8_BAR __builtin_amdgcn_s_barrier()
#define PG8_SCHED __builtin_amdgcn_sched_barrier(0)
#define PG8_GIDX(VV, U) do { if constexpr (GATHER) { _Pragma("unroll") for (int _h = 0; _h < 2; ++_h) _Pragma("unroll") for (int _i = 0; _i < 2; ++_i) { \
        const int _tok = g.gidx[(U).pm * BM + _h * HALF + RA[_i]]; (VV)[_h][_i] = (unsigned)_tok * (unsigned)(lda * 2) + CA2[_i]; } } } while (0)
#define PG8_GIDX_LDS(VV, BUF) do { if constexpr (GATHER) { _Pragma("unroll") for (int _h = 0; _h < 2; ++_h) _Pragma("unroll") for (int _i = 0; _i < 2; ++_i) { \
        const int _tok = *(const LAS int*)(lds + STAGE_BYTES + (BUF) * 1024 + (_h * HALF + RA[_i]) * 4); (VV)[_h][_i] = (unsigned)_tok * (unsigned)(lda * 2) + CA2[_i]; } } } while (0)
    Unit cur, nxt; int ui = 0;
    if (!S.next(0, cur)) return;
    int scw = 0, sca = 0; if constexpr (FP8) { scw = g.sc_w; sca = g.sc_a; asm volatile("" : "+v"(scw), "+v"(sca)); }
    Acc acc;
#pragma unroll
    for (int a = 0; a < 2; ++a)
#pragma unroll
        for (int b = 0; b < 2; ++b)
#pragma unroll
            for (int m = 0; m < 4; ++m)
#pragma unroll
                for (int n = 0; n < 2; ++n) acc[a][b][m][n] = (f32x4){0.f, 0.f, 0.f, 0.f};
    bf16x8 At[4][2], B0[2][2], B1[2][2];
    const char* cA = (const char*)(g.A + S.a_off(cur)) + (size_t)cur.pm * tstepA; const char* cB = (const char*)(g.Bt + S.b_off(cur)) + (size_t)cur.pn * tstepB;
    vc[0][0] = vc[0][1] = vc[1][0] = vc[1][1] = 0u;
    PG8_GIDX(vc, cur);
    PG8_STAGE(PG8_SB(0, 0), cB, voffB); PG8_STAGE(PG8_SB(0, 1), cB + hstepB, voffB); PG8_STAGE_A(PG8_SA(0, 0), cA, 0, vc); PG8_STAGE_A(PG8_SA(0, 1), cA, 1, vc);
    if (wr == 1) PG8_BAR;
    PG8_WAIT_V(2); PG8_BAR;
    PG8_STAGE(PG8_SB(1, 0), cB + kstep, voffB); PG8_STAGE_A(PG8_SA(1, 0), cA + kstep, 0, vc); PG8_STAGE(PG8_SB(1, 1), cB + hstepB + kstep, voffB);
    PG8_WAIT_V(6); PG8_BAR;
    for (;;) {
        const bool has_next = S.next(ui + 1, nxt);
        const char* nA = has_next ? (const char*)(g.A + S.a_off(nxt)) + (size_t)nxt.pm * tstepA : cA; const char* nB = has_next ? (const char*)(g.Bt + S.b_off(nxt)) + (size_t)nxt.pn * tstepB : cB;
        if constexpr (GATHER) { if (has_next && wid == 0)
            __builtin_amdgcn_global_load_lds((const unsigned*)(g.gidx + (size_t)nxt.pm * BM + lane * 4), (LAS unsigned*)(lds + STAGE_BYTES + (ui & 1) * 1024), 16, 0, 0); }
#pragma nounroll
        for (int t = 0; t < nt; t += 2) {
            const bool last = (t == nt - 2);
            const char* a1 = cA + (size_t)(t + 1) * kstep;
            const char* a2 = last ? nA : cA + (size_t)(t + 2) * kstep; const char* b2 = last ? nB : cB + (size_t)(t + 2) * kstep;
            const char* a3 = a2 + kstep; const char* b3 = b2 + kstep;
            unsigned v2[2][2];
#pragma unroll
            for (int h = 0; h < 2; ++h)
#pragma unroll
                for (int i = 0; i < 2; ++i) v2[h][i] = vc[h][i];
            if (last && has_next) { PG8_GIDX_LDS(v2, ui & 1); }
            PG8_LDB(B0, 0, 0); PG8_LDB(B1, 0, 1); PG8_SCHED; PG8_LDA(At, 0, 0); PG8_STAGE_A(PG8_SA(1, 1), a1, 1, vc);
            PG8_WAIT_V(8); PG8_WAIT_L(0); PG8_BAR; PG8_MMA(0, 0, At, B0); PG8_MMA(0, 1, At, B1); PG8_BAR; PG8_SCHED;
            PG8_LDA(At, 0, 1); PG8_STAGE(PG8_SB(0, 0), b2, voffB); PG8_STAGE(PG8_SB(0, 1), b2 + hstepB, voffB); PG8_STAGE_A(PG8_SA(0, 0), a2, 0, v2);
            PG8_WAIT_V(8); PG8_WAIT_L(0); PG8_BAR; PG8_MMA(1, 0, At, B0); PG8_MMA(1, 1, At, B1); PG8_BAR; PG8_SCHED;
            PG8_LDB(B0, 1, 0); PG8_LDB(B1, 1, 1); PG8_SCHED; PG8_LDA(At, 1, 0); PG8_STAGE_A(PG8_SA(0, 1), a2, 1, v2);
            PG8_WAIT_V(8); PG8_WAIT_L(0); PG8_BAR; PG8_MMA(0, 0, At, B0); PG8_MMA(0, 1, At, B1); PG8_BAR; PG8_SCHED;
            PG8_LDA(At, 1, 1); PG8_STAGE(PG8_SB(1, 0), b3, voffB); PG8_STAGE(PG8_SB(1, 1), b3 + hstepB, voffB); PG8_STAGE_A(PG8_SA(1, 0), a3, 0, v2);
            PG8_WAIT_V(8); PG8_WAIT_L(0); PG8_BAR; PG8_MMA(1, 0, At, B0); PG8_MMA(1, 1, At, B1); PG8_BAR; PG8_SCHED;
            if constexpr (GATHER) { if (last) {
#pragma unroll
                for (int h = 0; h < 2; ++h)
#pragma unroll
                    for (int i = 0; i < 2; ++i) vc[h][i] = v2[h][i]; } }
        }
        if (wr == 0) PG8_BAR;
        if constexpr (FP8) asm volatile("s_nop 15\n\ts_nop 15\n\ts_nop 15\n\ts_nop 15\n\ts_nop 15" ::: "memory");
        E(acc, cur, wr, wc, fr, fq);
        if (!has_next) break;
#pragma unroll
        for (int a = 0; a < 2; ++a)
#pragma unroll
            for (int b = 0; b < 2; ++b)
#pragma unroll
                for (int m = 0; m < 4; ++m)
#pragma unroll
                    for (int n = 0; n < 2; ++n) acc[a][b][m][n] = (f32x4){0.f, 0.f, 0.f, 0.f};
        cur = nxt; cA = nA; cB = nB; ++ui;
        if (wr == 1) PG8_BAR;
    }
    PG8_WAIT_V(0);
    PG8_BAR;
#undef PG8_SA
#undef PG8_SB
#undef PG8_STAGE
#undef PG8_STAGE_A
#undef PG8_LDA
#undef PG8_LDB
#undef PG8_MMA
#undef PG8_CAT
#undef PG8_WAIT_V
#undef PG8_WAIT_L
#undef PG8_BAR
#undef PG8_SCHED
#undef PG8_GIDX
#undef PG8_GIDX_LDS
}
}

struct Args { const float* in[N_IN]; float* out; unsigned char* ws; int ph_lo, ph_hi; };
static_assert(sizeof(Args) == (N_IN + 2) * 8 + 8, "Args has no padding");

typedef const Args __attribute__((address_space(4))) CArgs;
DI const CArgs* kargs() { const CArgs* p = (const CArgs*)__builtin_amdgcn_kernarg_segment_ptr(); asm volatile("" : "+s"(p)); return p; }
struct Frame { LAS unsigned char* lds; int tid, lane, wave, vcu, G; };
extern __shared__ __attribute__((aligned(16))) unsigned char lds_raw[];
DI Frame make_frame(int wv) { Frame F; F.lds = (LAS unsigned char*)lds_raw; unsigned ones = ~0u; asm volatile("" : "+s"(ones)); int t = wv * 64 + (int)__builtin_amdgcn_mbcnt_hi(ones, __builtin_amdgcn_mbcnt_lo(ones, 0u)); asm volatile("" : "+v"(t)); F.tid = t; F.lane = t & 63; F.wave = __builtin_amdgcn_readfirstlane(t >> 6);
    F.G = gridDim.x; { int bx = blockIdx.x; asm volatile("" : "+s"(bx)); F.vcu = (F.G % 8 == 0) ? (bx % 8) * (F.G / 8) + bx / 8 : bx; } return F; }

struct TrItem { const float* W; bf16_t* WT; int K, N, half, item; float f8scale; };
DI void tr_load(const TrItem& q, int lane, float (&v)[32]) {
    const int nblk = (q.N + 31) >> 5, kb = q.item / nblk, nb = q.item - kb * nblk, k0 = 64 * kb, n0 = 32 * nb;
    const int n = n0 + (lane & 31); const bool ok = n < q.N; const int nc = ok ? n : q.N - 1;
    const float* p = q.W + (size_t)(k0 + (lane >> 5)) * q.N + nc; const size_t rs = (size_t)2 * q.N;
#pragma unroll
    for (int i = 0; i < 32; ++i) v[i] = __builtin_nontemporal_load(p + (size_t)i * rs);
    if (!ok) {
#pragma unroll
        for (int i = 0; i < 32; ++i) v[i] = 0.f; }
}
DI void tr_store(const TrItem& q, int lane, const float (&v)[32], LAS float* scr) {
    const int nblk = (q.N + 31) >> 5, kb = q.item / nblk, nb = q.item - kb * nblk, k0 = 64 * kb, n0 = 32 * nb;
#pragma unroll
    for (int i = 0; i < 32; ++i) { const int kk = 2 * i + (lane >> 5); scr[kk * 33 + (lane & 31)] = v[i]; }
    LDS_WAIT(); asm volatile("" ::: "memory");
    const int c = lane & 7;
#pragma unroll
    for (int j = 0; j < 4; ++j) { const int nl = (lane >> 3) + 8 * j; const LAS float* s = scr + (8 * c) * 33 + nl;
        u32x4 o; o.x = pk2(s[0 * 33], s[1 * 33]); o.y = pk2(s[2 * 33], s[3 * 33]); o.z = pk2(s[4 * 33], s[5 * 33]); o.w = pk2(s[6 * 33], s[7 * 33]);
        const int n = n0 + nl; int rho = n;
        if (q.half) { const int nn = (n < q.half) ? n : n - q.half; rho = ((nn >> 7) << 8) + (nn & 127) + ((n < q.half) ? 0 : 128); }
        if (q.f8scale != 0.f) { const float f = q.f8scale * (q.half ? ((n < q.half) ? 1.44269504f : 0.693147181f) : 1.f); u32x2 o8;     o8.x = pg8::pk4_fp8(s[0 * 33] * f, s[1 * 33] * f, s[2 * 33] * f, s[3 * 33] * f); o8.y = pg8::pk4_fp8(s[4 * 33] * f, s[5 * 33] * f, s[6 * 33] * f, s[7 * 33] * f);
            *(u32x2*)((unsigned char*)q.WT + (size_t)rho * q.K + k0 + 8 * c) = o8; }
        else *(u32x4*)(q.WT + (size_t)rho * q.K + k0 + 8 * c) = o; }
    LDS_WAIT(); asm volatile("" ::: "memory");
}
constexpr int CI0 = 16 * 97, CI1 = 512, CI2 = 3584, CI3 = 1792, CI4 = 1024, CI5 = 256, CI6 = 512, CI7 = 8 * 3584, CI8 = 8 * 1792, CI_PER_J = CI0 + CI1 + CI2 + CI3 + CI4 + CI5 + CI6 + CI7 + CI8;
constexpr int N_MODIT = 4 * 24 * 8;
constexpr int CI_A_FWD = CI0 + CI1 + CI2 + CI3 + CI4 + CI5 + CI6;
DI TrItem conv_desc(const CArgs* a, int it) {
    const int j = it / CI_PER_J; int r = it - j * CI_PER_J;
    bf16_t* wb = (bf16_t*)(a->ws + WS_W) + (size_t)j * W_PER_J;
    if (r < CI0) return TrItem{a->in[I_MLWIN] + (size_t)j * D * MLP, wb + W_WIN, D, MLP, 0, r, 0.f}; r -= CI0;
    if (r < CI1) return TrItem{a->in[I_MLWOUT] + (size_t)j * D * D, wb + W_WOUT, D, D, 0, r, 0.f}; r -= CI1;
    if (r < CI2) return TrItem{a->in[I_FW13] + (size_t)j * D * 2 * DFF, wb + W_W13, D, 2 * DFF, DFF, r, DENSE_FP8_AT(j) ? pg8::W13_SCALE : 0.f}; r -= CI2;
    if (r < CI3) return TrItem{a->in[I_FW2] + (size_t)j * DFF * D, wb + W_W2, DFF, D, 0, r, DENSE_FP8_AT(j) ? pg8::W2_SCALE : 0.f}; r -= CI3;
    if (r < CI4) return TrItem{a->in[I_LWIN] + (size_t)j * D * 2 * D, wb + W_LIN, D, 2 * D, 0, r, 0.f}; r -= CI4;
    if (r < CI5) { const int hd = r >> 6; return TrItem{a->in[I_LGW] + (size_t)(j * 4 + hd) * 256 * 512, wb + W_GW + (size_t)hd * 512 * 256, 256, 512, 256, r & 63, 0.f}; } r -= CI5;
    if (r < CI6) return TrItem{a->in[I_LWOUT] + (size_t)j * D * D, wb + W_LOUT, D, D, 0, r, 0.f}; r -= CI6;
    if (r < CI7) { const int e = r / 3584; return TrItem{a->in[I_MW13] + (size_t)(j * NE + e) * D * 2 * DFF, wb + W_MW13 + (size_t)e * DFF * D, D, 2 * DFF, DFF, r - e * 3584, pg8::W13_SCALE}; } r -= CI7;
    { const int e = r / 1792; return TrItem{a->in[I_MW2] + (size_t)(j * NE + e) * DFF * D, wb + W_MW2 + (size_t)e * (D * DFF / 2), DFF, D, 0, r - e * 1792, pg8::W2_SCALE}; }
}
DI void conv_stream(const CArgs* a, int first, int step, int end, LAS float* scr, int lane) {
    if (first >= end) return;
    float va[32], vb[32];
    TrItem qa = conv_desc(a, first), qb = qa;
    tr_load(qa, lane, va);
    for (int it = first; it < end; it += 2 * step) {
        const bool hb = it + step < end;
        if (hb) { qb = conv_desc(a, it + step); tr_load(qb, lane, vb); }
        tr_store(qa, lane, va, scr);
        if (!hb) break;
        const bool ha = it + 2 * step < end;
        if (ha) { qa = conv_desc(a, it + 2 * step); tr_load(qa, lane, va); }
        tr_store(qb, lane, vb, scr);
        if (!ha) break;
    }
}
DI void mod_item(const CArgs* a, int it, const LAS float* cact, int lane) {
    const int i = it / 192, rem = it - i * 192, cg = rem >> 3, ks = rem & 7;
    const float* w = a->in[I_ADAW] + ((size_t)i * D + ks * 128) * 6144 + cg * 256 + lane * 4;
    f32x4 acc[16];
#pragma unroll
    for (int b = 0; b < 16; ++b) acc[b] = (f32x4){0.f, 0.f, 0.f, 0.f};
#pragma unroll 4
    for (int k = 0; k < 128; ++k) { const f32x4 w4 = *(const f32x4*)(w + (size_t)k * 6144);
#pragma unroll
        for (int b = 0; b < 16; ++b) acc[b] += w4 * cact[b * D + ks * 128 + k]; }
    float* o = (float*)(a->ws + WS_MODP) + ((size_t)(ks * 4 + i) * 16) * 6144 + cg * 256 + lane * 4;
#pragma unroll
    for (int b = 0; b < 16; ++b) *(f32x4*)(o + (size_t)b * 6144) = acc[b];
}
DI void mod_item_full(const CArgs* a, int it, const LAS float* cact, int lane) {
    const int i = it / 24, cg = it - i * 24;
    const float* w = a->in[I_ADAW] + (size_t)i * D * 6144 + cg * 256 + lane * 4;
    f32x4 acc[16];
#pragma unroll
    for (int b = 0; b < 16; ++b) acc[b] = (f32x4){0.f, 0.f, 0.f, 0.f};
    for (int k0 = 0; k0 < D; k0 += 16) { f32x4 w4[16];
#pragma unroll
        for (int kk = 0; kk < 16; ++kk) w4[kk] = __builtin_nontemporal_load((const f32x4*)(w + (size_t)(k0 + kk) * 6144));
#pragma unroll
        for (int kk = 0; kk < 16; ++kk)
#pragma unroll
            for (int b = 0; b < 16; ++b) acc[b] += w4[kk] * cact[b * D + k0 + kk]; }
    const f32x4 bias = *(const f32x4*)(a->in[I_ADAB] + (size_t)i * 6144 + cg * 256 + lane * 4);
    float* o = (float*)(a->ws + WS_MOD) + ((size_t)i * 16) * 6144 + cg * 256 + lane * 4;
#pragma unroll
    for (int b = 0; b < 16; ++b) *(f32x4*)(o + (size_t)b * 6144) = acc[b] + bias;
}
DI void ph_prologue_a(int wv) {
    const CArgs* a = kargs(); const Frame F = make_frame(wv);
    LAS float* cact = (LAS float*)(F.lds + 8 * 8448);
    LAS float* scr = (LAS float*)(F.lds + F.wave * 8448);
    for (int idx = F.tid; idx < 16 * D; idx += NTHR) { const float c = a->in[I_C][idx]; cact[idx] = c * sigmoid_f(c); }
    __syncthreads();
    const int gw = F.vcu * NWAVES + F.wave, NGW = F.G * NWAVES;
    for (int it = gw; it < 64; it += NGW) mod_item(a, it, cact, F.lane);
    {
        float va[32];
        for (int r = gw; r < CI0; r += NGW) { const TrItem q = conv_desc(a, r); tr_load(q, F.lane, va); tr_store(q, F.lane, va, scr); }
    }
    for (int idx = F.vcu * NTHR + F.tid; idx < 2 * 28672; idx += F.G * NTHR) { const int j = idx / 28672, o = idx - j * 28672;
        ((u32x4*)((bf16_t*)(a->ws + WS_W) + (size_t)j * W_PER_J + W_WIN + (size_t)3104 * D))[o] = (u32x4){0u, 0u, 0u, 0u}; }
}
DI void ph_prologue_b(int wv) {
    const CArgs* a = kargs(); const Frame F = make_frame(wv);
    const f32x4* P = (const f32x4*)(a->ws + WS_MODP); f32x4* M = (f32x4*)(a->ws + WS_MOD); const f32x4* B4 = (const f32x4*)a->in[I_ADAB];
    for (int idx = F.vcu * NTHR + F.tid; idx < 4 * 16 * 1536; idx += F.G * NTHR) { const int i = idx / (16 * 1536), n4 = idx % 1536;
        f32x4 s = B4[i * 1536 + n4];
#pragma unroll
        for (int ks = 0; ks < 8; ++ks) s += P[(size_t)ks * (4 * 16 * 1536) + idx];
        M[idx] = s; }
    for (int idx = F.vcu * NTHR + F.tid; idx < 2 * D; idx += F.G * NTHR) ((float*)(a->ws + WS_SP))[idx] = log1p_exp_neg(a->in[I_LAP][idx]);
}

template <bool SB> DI void ld_src(const float* src, const bf16_t* xsb, int r, int lane, u32x4 (&raw)[4]) {
    if constexpr (SB) { const u32x2* xr = (const u32x2*)(xsb + (size_t)r * D) + lane;
#pragma unroll
        for (int j = 0; j < 4; ++j) { const u32x2 t = __builtin_nontemporal_load(xr + 64 * j); raw[j].x = t.x; raw[j].y = t.y; } }
    else { const u32x4* xr = (const u32x4*)(src + (size_t)r * D) + lane;
#pragma unroll
        for (int j = 0; j < 4; ++j) raw[j] = __builtin_nontemporal_load(xr + 64 * j); }
}
template <int MODE, bool SB>
DI void row_pass(int wv, int srcsel, int ngsel, int layer, int sub, int jl, int addm) {
    const CArgs* a = kargs(); const Frame F = make_frame(wv); asm volatile("" : "+s"(layer), "+s"(jl));
    (void)srcsel; const float* src = a->in[I_X]; bf16_t* XSB = (bf16_t*)(a->ws + WS_R + R_XSB); const float* ngain = ngsel < 0 ? a->in[I_FNG] : a->in[I_NORMG] + (size_t)ngsel * D;
    float* XS = a->out; bf16_t* HN = (bf16_t*)(a->ws + WS_HN); const bf16_t* M1 = (const bf16_t*)(a->ws + WS_R + R_M1); asm volatile("" : "+s"(addm));
    const int gw = F.vcu * NWAVES + F.wave, lane = F.lane;
    LAS float* rw = (LAS float*)F.lds;
    if (MODE == 1) { const float* RW = a->in[I_RW] + (size_t)jl * D * NE; for (int idx = F.tid; idx < D * NE; idx += NTHR) { const int d = idx >> 3, e = idx & 7;
            rw[((((d >> 8) * 4 + (d & 3)) * 2 + (e >> 2)) * 64 + ((d & 255) >> 2)) * 4 + (e & 3)] = RW[idx]; }
        __syncthreads(); }
    int cnt0 = 0, cnt1 = 0, cnt2 = 0, cnt3 = 0, cnt4 = 0, cnt5 = 0, cnt6 = 0, cnt7 = 0;
    float rb[8];
    if (MODE == 1) {
#pragma unroll
        for (int e = 0; e < 8; ++e) rb[e] = a->in[I_RB][jl * NE + e]; }
    for (int blk = gw; blk < T / 32; blk += F.G * NWAVES) {
        const int r0 = blk * 32, b = r0 >> 12;
        const float* mod = (const float*)(a->ws + WS_MOD) + ((size_t)layer * 16 + b) * 6144;
        f32x4 CA[4], CB[4], G2[4];
#pragma unroll
        for (int j = 0; j < 4; ++j) { const int c = 256 * j + 4 * lane; const f32x4 g = *(const f32x4*)(ngain + c);
            if (MODE == 3) { CA[j] = g; CB[j] = (f32x4){0.f, 0.f, 0.f, 0.f}; }
            else if (MODE == 0 && layer == 0 && sub == 0) {
                f32x4 sh = *(const f32x4*)(a->in[I_ADAB] + c), sc = *(const f32x4*)(a->in[I_ADAB] + 1024 + c);
#pragma unroll
                for (int ks = 0; ks < 8; ++ks) { const float* pp = (const float*)(a->ws + WS_MODP) + ((size_t)(ks * 4) * 16 + b) * 6144; sh += *(const f32x4*)(pp + c); sc += *(const f32x4*)(pp + 1024 + c); }
                CA[j] = g * (sc + 1.f); CB[j] = sh; }
            else { const f32x4 sh = *(const f32x4*)(mod + sub * 3072 + c), sc = *(const f32x4*)(mod + sub * 3072 + 1024 + c); CA[j] = g * (sc + 1.f); CB[j] = sh; }
            if (MODE >= 2) G2[j] = *(const f32x4*)((const float*)(a->ws + WS_MOD) + ((size_t)(layer - (MODE == 2 ? 1 : 0)) * 16 + b) * 6144 + 5120 + c); }
        u32x4 vnx[4]; u32x2 mnx[4]; i32x2 slnx = (i32x2){0, 0}; f32x2 twnx = (f32x2){0.f, 0.f};
#pragma unroll
        for (int j = 0; j < 4; ++j) { mnx[j] = (u32x2){0u, 0u}; vnx[j] = (u32x4){0u, 0u, 0u, 0u}; }
        { ld_src<SB>(src, XSB, r0, lane, vnx);
          if (addm) { const u32x2* mr = (const u32x2*)(M1 + (size_t)r0 * D) + lane;
#pragma unroll
              for (int j = 0; j < 4; ++j) mnx[j] = __builtin_nontemporal_load(mr + 64 * j); }
          if (MODE >= 2) { slnx = ((const i32x2*)(a->ws + WS_TOKSLOT))[r0]; twnx = ((const f32x2*)(a->ws + WS_TOPW))[r0]; } }
        for (int rr = 0; rr < 32; ++rr) {
            const int row = r0 + rr;
            f32x4 v[4];
#pragma unroll
            for (int j = 0; j < 4; ++j) { const u32x4 rw_ = vnx[j]; if constexpr (SB) v[j] = (f32x4){bflo(rw_.x), bfhi(rw_.x), bflo(rw_.y), bfhi(rw_.y)}; else v[j] = __builtin_bit_cast(f32x4, rw_);
                const u32x2 mw = mnx[j]; v[j] += (f32x4){bflo(mw.x), bfhi(mw.x), bflo(mw.y), bfhi(mw.y)}; }
            const i32x2 sl = slnx; const f32x2 tw = twnx;
            { const int rnx = (rr + 1 < 32) ? row + 1 : row; ld_src<SB>(src, XSB, rnx, lane, vnx);
              if (addm) { const u32x2* mr = (const u32x2*)(M1 + (size_t)rnx * D) + lane;
#pragma unroll
                  for (int j = 0; j < 4; ++j) mnx[j] = __builtin_nontemporal_load(mr + 64 * j); }
              if (MODE >= 2) { slnx = ((const i32x2*)(a->ws + WS_TOKSLOT))[rnx]; twnx = ((const f32x2*)(a->ws + WS_TOPW))[rnx]; } }
            if (MODE >= 2) {
                const bf16_t* YS = (const bf16_t*)(a->ws + WS_R + R_YS);
                const u32x2* y0 = (const u32x2*)(YS + (size_t)sl.x * D) + lane; const u32x2* y1 = (const u32x2*)(YS + (size_t)sl.y * D) + lane;
#pragma unroll
                for (int j = 0; j < 4; ++j) { const u32x2 p = y0[64 * j], q = y1[64 * j];
                    f32x4 m; m[0] = tw.x * bflo(p.x) + tw.y * bflo(q.x); m[1] = tw.x * bfhi(p.x) + tw.y * bfhi(q.x); m[2] = tw.x * bflo(p.y) + tw.y * bflo(q.y); m[3] = tw.x * bfhi(p.y) + tw.y * bfhi(q.y);
                    v[j] += G2[j] * m; }
                if (MODE == 2) {
#pragma unroll
                    for (int j = 0; j < 4; ++j) { u32x2 w; w.x = pk2(v[j][0], v[j][1]); w.y = pk2(v[j][2], v[j][3]); ((u32x2*)(XSB + (size_t)row * D) + lane)[64 * j] = w; } }
            }
            float ss = 0.f;
#pragma unroll
            for (int j = 0; j < 4; ++j) ss += (v[j][0] * v[j][0] + v[j][1] * v[j][1]) + (v[j][2] * v[j][2] + v[j][3] * v[j][3]);
            const float rstd = __builtin_amdgcn_rsqf(wave_sum(ss) * (1.f / D) + RMS_EPS);
            f32x4 y[4];
#pragma unroll
            for (int j = 0; j < 4; ++j) y[j] = v[j] * rstd * CA[j] + CB[j];
            if (MODE == 3) {
#pragma unroll
                for (int j = 0; j < 4; ++j) ((f32x4*)(XS + (size_t)row * D) + lane)[64 * j] = y[j];
            } else if ((MODE == 0 && sub == 1 && DENSE_FP8_AT(jl)) || MODE == 1) {
                unsigned* o4 = (unsigned*)((unsigned char*)HN + (size_t)row * D) + lane;
#pragma unroll
                for (int j = 0; j < 4; ++j) o4[64 * j] = pg8::pk4_fp8(y[j][0] * pg8::HN_SCALE, y[j][1] * pg8::HN_SCALE, y[j][2] * pg8::HN_SCALE, y[j][3] * pg8::HN_SCALE);
            } else {
                u32x2* o8 = (u32x2*)(HN + (size_t)row * D) + lane;
#pragma unroll
                for (int j = 0; j < 4; ++j) { u32x2 w; w.x = pk2(y[j][0], y[j][1]); w.y = pk2(y[j][2], y[j][3]); o8[64 * j] = w; }
            }
            if (MODE == 1) {
                float lg[8];
#pragma unroll
                for (int e = 0; e < 8; ++e) lg[e] = 0.f;
#pragma unroll
                for (int j = 0; j < 4; ++j)
#pragma unroll
                    for (int q = 0; q < 4; ++q) { const LAS float* wp = rw + (((j * 4 + q) * 2) * 64 + lane) * 4; const f32x4 w0 = *(const LAS f32x4*)(wp), w1 = *(const LAS f32x4*)(wp + 256); const float yv = y[j][q];
                        lg[0] += yv * w0[0]; lg[1] += yv * w0[1]; lg[2] += yv * w0[2]; lg[3] += yv * w0[3]; lg[4] += yv * w1[0]; lg[5] += yv * w1[1]; lg[6] += yv * w1[2]; lg[7] += yv * w1[3];
                        if (q == 3) asm volatile("" ::: "memory"); }
#pragma unroll
                for (int e = 0; e < 8; ++e) lg[e] = wave_sum(lg[e]) + rb[e];
                int e0 = 0; float l0 = lg[0];
#pragma unroll
                for (int e = 1; e < 8; ++e) if (lg[e] > l0) { l0 = lg[e]; e0 = e; }
                int e1 = -1; float l1 = -3.0e38f;
#pragma unroll
                for (int e = 0; e < 8; ++e) if (e != e0 && lg[e] > l1) { l1 = lg[e]; e1 = e; }
                const float w0 = __builtin_amdgcn_rcpf(1.f + __expf(l1 - l0)), w1 = 1.f - w0;
                if (lane == 0) { ((int*)(a->ws + WS_TOPE))[row] = e0 | (e1 << 8); ((f32x2*)(a->ws + WS_TOPW))[row] = (f32x2){w0, w1}; }
                cnt0 += (e0 == 0) + (e1 == 0); cnt1 += (e0 == 1) + (e1 == 1); cnt2 += (e0 == 2) + (e1 == 2); cnt3 += (e0 == 3) + (e1 == 3);
                cnt4 += (e0 == 4) + (e1 == 4); cnt5 += (e0 == 5) + (e1 == 5); cnt6 += (e0 == 6) + (e1 == 6); cnt7 += (e0 == 7) + (e1 == 7);
            }
        }
        if (MODE == 1) {
            const int cv = lane == 0 ? cnt0 : lane == 1 ? cnt1 : lane == 2 ? cnt2 : lane == 3 ? cnt3 : lane == 4 ? cnt4 : lane == 5 ? cnt5 : lane == 6 ? cnt6 : cnt7;
            if (lane < 8) ((int*)(a->ws + WS_HIST))[blk * 8 + lane] = cv;
            cnt0 = cnt1 = cnt2 = cnt3 = cnt4 = cnt5 = cnt6 = cnt7 = 0;
        }
    }
}

DI void ph_lru_tables(int wv, int jl) {
    const CArgs* a = kargs(); const Frame F = make_frame(wv); asm volatile("" : "+s"(jl));
    const float* MODL = (const float*)(a->ws + WS_MOD) + (size_t)(2 * jl + 1) * 16 * 6144;
    for (int idx = F.vcu * NTHR + F.tid; idx < 16 * D; idx += F.G * NTHR) { const int col = idx & (D - 1), b = idx >> 10;
        ((float*)(a->ws + WS_CA1))[(size_t)jl * 16 * D + idx] = a->in[I_NORMG][(size_t)((2 * jl + 1) * 2) * D + col] * (1.f + MODL[(size_t)b * 6144 + 1024 + col]); }
    LAS float* shl = (LAS float*)(F.lds + F.wave * 8192);
    for (int it = F.vcu * NWAVES + F.wave; it < 64; it += F.G * NWAVES) { const int ks = it & 7, cg = it >> 3, lane = F.lane;
        const float* W = a->in[I_LWIN] + (size_t)jl * D * 2 * D + (size_t)(ks * 128) * (2 * D) + cg * 256 + lane * 4;
        for (int idx = lane; idx < 16 * 128; idx += 64) shl[idx] = MODL[(size_t)(idx >> 7) * 6144 + ks * 128 + (idx & 127)];
        LDS_WAIT(); asm volatile("" ::: "memory");
        f32x4 acc[16];
#pragma unroll
        for (int b = 0; b < 16; ++b) acc[b] = (f32x4){0.f, 0.f, 0.f, 0.f};
        for (int k0 = 0; k0 < 128; k0 += 16) { f32x4 w4[16];
#pragma unroll
            for (int kk = 0; kk < 16; ++kk) w4[kk] = *(const f32x4*)(W + (size_t)(k0 + kk) * (2 * D));
#pragma unroll
            for (int kk = 0; kk < 16; ++kk)
#pragma unroll
                for (int b = 0; b < 16; ++b) acc[b] += w4[kk] * shl[b * 128 + k0 + kk]; }
        float* o = (float*)(a->ws + WS_BIASP) + ((size_t)(jl * 8 + ks) * 16) * 2048 + cg * 256 + lane * 4;
#pragma unroll
        for (int b = 0; b < 16; ++b) *(f32x4*)(o + (size_t)b * 2048) = acc[b];
        LDS_WAIT(); asm volatile("" ::: "memory"); }
}
DI void ph_slots(int wv) {
    const CArgs* a = kargs(); const Frame F = make_frame(wv);
    LAS int* H = (LAS int*)F.lds;
    const int* HIST = (const int*)(a->ws + WS_HIST);
    for (int idx = F.tid; idx < 2048 * 8; idx += NTHR) H[idx] = HIST[idx];
    __syncthreads();
    const int lane = F.lane;
    int* SLOTTOK = (int*)(a->ws + WS_SLOTTOK); i32x2* TOKSLOT = (i32x2*)(a->ws + WS_TOKSLOT); const int* TOPE = (const int*)(a->ws + WS_TOPE);
    for (int blk = F.vcu * NWAVES + F.wave; blk < T / 32; blk += F.G * NWAVES) {
        int tot[8], pre[8];
#pragma unroll
        for (int e = 0; e < 8; ++e) { tot[e] = 0; pre[e] = 0; }
#pragma unroll 2
        for (int bb = lane; bb < 2048; bb += 64) { const LAS int* hp = H + ((bb * 8) ^ ((bb >> 2) & 4) * 0);
            typedef int i32x4 __attribute__((ext_vector_type(4)));
            const i32x4 h0 = *(const LAS i32x4*)(hp), h1 = *(const LAS i32x4*)(hp + 4); const bool lt = bb < blk;
            tot[0] += h0[0]; tot[1] += h0[1]; tot[2] += h0[2]; tot[3] += h0[3]; tot[4] += h1[0]; tot[5] += h1[1]; tot[6] += h1[2]; tot[7] += h1[3];
            pre[0] += lt ? h0[0] : 0; pre[1] += lt ? h0[1] : 0; pre[2] += lt ? h0[2] : 0; pre[3] += lt ? h0[3] : 0; pre[4] += lt ? h1[0] : 0; pre[5] += lt ? h1[1] : 0; pre[6] += lt ? h1[2] : 0; pre[7] += lt ? h1[3] : 0;
            asm volatile("" ::: "memory"); }
#pragma unroll
        for (int e = 0; e < 8; ++e) { tot[e] = wave_sum_i(tot[e]); pre[e] = wave_sum_i(pre[e]); }
        int sb[8]; int ts = 0;
#pragma unroll
        for (int e = 0; e < 8; ++e) { sb[e] = ts * 256; ts += (tot[e] + 255) >> 8; }
        const int row = blk * 32 + (lane & 31);
        int e0 = 255, e1 = 255;
        if (lane < 32) { const int pe = TOPE[row]; e0 = pe & 255; e1 = (pe >> 8) & 255; }
        int s0 = 0, s1 = 0;
        const unsigned long long below = (1ull << lane) - 1ull;
#pragma unroll
        for (int e = 0; e < 8; ++e) { const unsigned long long m = __ballot(e0 == e || e1 == e); const int rank = __popcll(m & below);
            if (e0 == e) s0 = sb[e] + pre[e] + rank; if (e1 == e) s1 = sb[e] + pre[e] + rank; }
        if (lane < 32) { SLOTTOK[s0] = row; SLOTTOK[s1] = row; TOKSLOT[row] = (i32x2){s0, s1}; }
        if (blk < 8) {
            int sbe = 0, tote = 0;
#pragma unroll
            for (int e = 0; e < 8; ++e) if (e == blk) { sbe = sb[e]; tote = tot[e]; }
            const int end = sbe + (((tote + 255) >> 8) << 8);
            for (int s = sbe + tote + lane; s < end; s += 64) SLOTTOK[s] = 0;
        }
        if (blk == 0 && lane == 0) { unsigned* META = (unsigned*)(a->ws + WS_CTL) + CW_META; int t2 = 0;
#pragma unroll
            for (int e = 0; e < 8; ++e) { META[1 + e] = (unsigned)t2; t2 += (tot[e] + 255) >> 8; }
            META[9] = (unsigned)t2; META[0] = (unsigned)t2; }
    }
}

DI bf16x8 gather8(const LAS bf16_t* p, int stride) {
    u32x4 w;
#pragma unroll
    for (int q = 0; q < 4; ++q) w[q] = (unsigned)p[(2 * q) * stride] | ((unsigned)p[(2 * q + 1) * stride] << 16);
    return __builtin_bit_cast(bf16x8, w);
}
#define CHAIN_BAR() do { asm volatile("s_waitcnt lgkmcnt(0)" ::: "memory"); __builtin_amdgcn_s_barrier(); asm volatile("" ::: "memory"); } while (0)
DI void tr_frag10(unsigned ak, unsigned av, bf16x8 (&fk)[2], bf16x8 (&fv)[4][2]) {
    u32x2 r[20];
    asm volatile("ds_read_b64_tr_b16 %0, %20\n\tds_read_b64_tr_b16 %1, %20 offset:576\n\tds_read_b64_tr_b16 %2, %20 offset:4608\n\tds_read_b64_tr_b16 %3, %20 offset:5184\n\t"
                 "ds_read_b64_tr_b16 %4, %21\n\tds_read_b64_tr_b16 %5, %21 offset:1088\n\tds_read_b64_tr_b16 %6, %21 offset:8704\n\tds_read_b64_tr_b16 %7, %21 offset:9792\n\t"
                 "ds_read_b64_tr_b16 %8, %21 offset:32\n\tds_read_b64_tr_b16 %9, %21 offset:1120\n\tds_read_b64_tr_b16 %10, %21 offset:8736\n\tds_read_b64_tr_b16 %11, %21 offset:9824\n\t"
                 "ds_read_b64_tr_b16 %12, %21 offset:64\n\tds_read_b64_tr_b16 %13, %21 offset:1152\n\tds_read_b64_tr_b16 %14, %21 offset:8768\n\tds_read_b64_tr_b16 %15, %21 offset:9856\n\t"
                 "ds_read_b64_tr_b16 %16, %21 offset:96\n\tds_read_b64_tr_b16 %17, %21 offset:1184\n\tds_read_b64_tr_b16 %18, %21 offset:8800\n\tds_read_b64_tr_b16 %19, %21 offset:9888\n\ts_waitcnt lgkmcnt(0)"
                 : "=&v"(r[0]), "=&v"(r[1]), "=&v"(r[2]), "=&v"(r[3]), "=&v"(r[4]), "=&v"(r[5]), "=&v"(r[6]), "=&v"(r[7]), "=&v"(r[8]), "=&v"(r[9]),
                   "=&v"(r[10]), "=&v"(r[11]), "=&v"(r[12]), "=&v"(r[13]), "=&v"(r[14]), "=&v"(r[15]), "=&v"(r[16]), "=&v"(r[17]), "=&v"(r[18]), "=&v"(r[19])
                 : "v"(ak), "v"(av) : "memory");
#define TRCAT(i) __builtin_bit_cast(bf16x8, (u32x4){r[i].x, r[i].y, r[(i) + 1].x, r[(i) + 1].y})
    fk[0] = TRCAT(0); fk[1] = TRCAT(2);
    fv[0][0] = TRCAT(4); fv[0][1] = TRCAT(6); fv[1][0] = TRCAT(8); fv[1][1] = TRCAT(10); fv[2][0] = TRCAT(12); fv[2][1] = TRCAT(14); fv[3][0] = TRCAT(16); fv[3][1] = TRCAT(18);
#undef TRCAT
}
DI void tr_frag2(unsigned a0, unsigned rs, bf16x8& f0, bf16x8& f1) {
    u32x2 r0, r1, r2, r3; const unsigned a1 = a0 + 4u * rs, a2 = a0 + 32u * rs, a3 = a0 + 36u * rs;
    asm volatile("ds_read_b64_tr_b16 %0, %4\n\tds_read_b64_tr_b16 %1, %5\n\tds_read_b64_tr_b16 %2, %6\n\tds_read_b64_tr_b16 %3, %7\n\ts_waitcnt lgkmcnt(0)"
                 : "=&v"(r0), "=&v"(r1), "=&v"(r2), "=&v"(r3) : "v"(a0), "v"(a1), "v"(a2), "v"(a3) : "memory");
    u32x4 w0, w1; w0.x = r0.x; w0.y = r0.y; w0.z = r1.x; w0.w = r1.y; w1.x = r2.x; w1.y = r2.y; w1.z = r3.x; w1.w = r3.y;
    f0 = __builtin_bit_cast(bf16x8, w0); f1 = __builtin_bit_cast(bf16x8, w1);
}
DI void ph_moe_convert(int wv, int jl) {
    const CArgs* a = kargs(); const Frame F = make_frame(wv); asm volatile("" : "+s"(jl));
    LAS float* scr = (LAS float*)(F.lds + F.wave * 8448);
    const int nw = ((int)gridDim.x - BATCH * ML_H) * NWAVES;
    const int cw0 = ((int)blockIdx.x - BATCH * ML_H) * NWAVES + F.wave;
    if (jl == 0) {
        LAS float* cact = (LAS float*)(F.lds + 8 * 8448);
        for (int idx = F.tid; idx < 16 * D; idx += NTHR) { const float c = a->in[I_C][idx]; cact[idx] = c * sigmoid_f(c); }
        __syncthreads();
        if (F.wave == 0 && (int)blockIdx.x - BATCH * ML_H < 96) mod_item_full(a, (int)blockIdx.x - BATCH * ML_H, cact, F.lane);
        for (int idx = cw0 * 64 + F.lane; idx < 2 * D; idx += nw * 64) ((float*)(a->ws + WS_SP))[idx] = log1p_exp_neg(a->in[I_LAP][idx]);
    }
    const int first = jl == 0 ? CI0 : CI_PER_J + CI0, end = jl == 0 ? CI_PER_J + CI0 : 2 * CI_PER_J;
    if (jl == 0) { if (F.wave != 0) conv_stream(a, first + ((int)blockIdx.x - BATCH * ML_H) * (NWAVES - 1) + F.wave - 1, ((int)gridDim.x - BATCH * ML_H) * (NWAVES - 1), end, scr, F.lane); }
    else conv_stream(a, first + cw0, nw, end, scr, F.lane);
}
DI float dpp_f(float v, int ctrl_sel) {
    const int x = __builtin_bit_cast(int, v); int r;
    if (ctrl_sel == 0) r = __builtin_amdgcn_update_dpp(x, x, 0xB1, 0xf, 0xf, true); else if (ctrl_sel == 1) r = __builtin_amdgcn_update_dpp(x, x, 0x4E, 0xf, 0xf, true);
    else if (ctrl_sel == 2) r = __builtin_amdgcn_update_dpp(x, x, 0x141, 0xf, 0xf, true); else r = __builtin_amdgcn_update_dpp(x, x, 0x140, 0xf, 0xf, true);
    return __builtin_bit_cast(float, r); }
DI float row16_sum(float p) { p += dpp_f(p, 0); p += dpp_f(p, 1); p += dpp_f(p, 2); p += dpp_f(p, 3); return p; }
DI unsigned cvtpk(float lo, float hi) { unsigned r; asm("v_cvt_pk_bf16_f32 %0, %1, %2" : "=v"(r) : "v"(lo), "v"(hi)); return r; }
DI void ph_mlstm(int wv, int jl) {
    const CArgs* a = kargs(); const Frame F = make_frame(wv); asm volatile("" : "+s"(jl));
    const int chain = blockIdx.x, b = chain >> 3, h = chain & 7;
    const int tid = F.tid, lane = F.lane, w = F.wave, fr = lane & 15, fq = lane >> 4;
    LAS bf16_t* Qs = (LAS bf16_t*)(F.lds);
    LAS bf16_t* Ks = (LAS bf16_t*)(F.lds + 9216);
    LAS bf16_t* Vs = (LAS bf16_t*)(F.lds + 18432);
    LAS bf16_t* Sp = (LAS bf16_t*)(F.lds + 35840);
    LAS bf16_t* CT = (LAS bf16_t*)(F.lds + 45056);
    LAS bf16_t* Hs = (LAS bf16_t*)(F.lds + 63488);
    LAS float* nvec = (LAS float*)(F.lds + 80896);
    LAS float* rss = nvec + 64;
    LAS float* npart = nvec + 192;
    LAS float* GA = (LAS float*)(F.lds + 86016);
    LAS float* GB = GA + 4096;
    LAS float* GP = GA + 8192;
    LAS float* MR = GA + 12288;
    const bf16_t* Qg = (const bf16_t*)(a->ws + WS_R + R_Q) + (size_t)b * SEQ * 512 + h * 64;
    const bf16_t* Kg = (const bf16_t*)(a->ws + WS_R + R_K) + (size_t)b * SEQ * 512 + h * 64;
    const bf16_t* Vg = (const bf16_t*)(a->ws + WS_R + R_V) + (size_t)b * SEQ * 1024 + h * 128;
    const bf16_t* Og = (const bf16_t*)(a->ws + WS_R + R_O) + (size_t)b * SEQ * 1024 + h * 128;
    bf16_t* Hg = (bf16_t*)(a->ws + WS_R + R_HS) + (size_t)b * SEQ * 1024 + h * 128;
    const float* Gg = (const float*)(a->ws + WS_GATES) + (size_t)b * SEQ * 16 + h;
    const int qrow = tid >> 3, qch = tid & 7;
    u32x4 qreg, kreg, vreg[2], oreg[2], qN, kN, vN[2];
    qreg = *(const u32x4*)(Qg + (size_t)qrow * 512 + qch * 8); kreg = *(const u32x4*)(Kg + (size_t)qrow * 512 + qch * 8);
    qN = *(const u32x4*)(Qg + (size_t)(CHK + qrow) * 512 + qch * 8); kN = *(const u32x4*)(Kg + (size_t)(CHK + qrow) * 512 + qch * 8);
#pragma unroll
    for (int i = 0; i < 2; ++i) { const int id = tid + 512 * i; vreg[i] = *(const u32x4*)(Vg + (size_t)(id >> 4) * 1024 + (id & 15) * 8); oreg[i] = (u32x4){0u, 0u, 0u, 0u};
        vN[i] = *(const u32x4*)(Vg + (size_t)(CHK + (id >> 4)) * 1024 + (id & 15) * 8); }
    for (int idx = tid; idx < 128 * 72 / 2; idx += NTHR) ((LAS unsigned*)CT)[idx] = 0u;
    if (tid < 64) nvec[tid] = 0.f;
    for (int cc = 0; cc < 8; ++cc) { const int c = 8 * w + cc; const float gi = Gg[(size_t)(c * CHK + lane) * 16], gf = Gg[(size_t)(c * CHK + lane) * 16 + 8];
        float bsum = gf;
#pragma unroll
        for (int o = 1; o < 64; o <<= 1) { const float t = __shfl_up(bsum, o); if (lane >= o) bsum += t; }
        const float av = gi - bsum; float pm = av;
#pragma unroll
        for (int o = 1; o < 64; o <<= 1) { const float t = __shfl_up(pm, o); if (lane >= o) pm = fmaxf(pm, t); }
        GA[c * 64 + lane] = av; GB[c * 64 + lane] = bsum; GP[c * 64 + lane] = pm; }
    __syncthreads();
    if (tid == 0) { float m = 0.f; MR[0] = 0.f; for (int c = 0; c < 64; ++c) { m = GB[c * 64 + 63] + fmaxf(m, GP[c * 64 + 63]); MR[c + 1] = m; } }
    const int ti = w >> 1, vi0 = 4 * (w & 1);
    const int trq = (lane & 15) >> 2, trp = lane & 3;
    const unsigned vs_tr = (unsigned)(size_t)Vs + (unsigned)(((8 * fq + trq) * 136 + 16 * vi0 + 4 * trp) * 2);
    const unsigned ks_tr = (unsigned)(size_t)Ks + (unsigned)(((8 * fq + trq) * 72 + 16 * ti + 4 * trp) * 2);
    float hg[4];
#pragma unroll
    for (int x = 0; x < 4; ++x) hg[x] = a->in[I_MLHG][(size_t)jl * 1024 + h * 128 + 16 * (vi0 + x) + fr];
    f32x4 Cacc[4];
#pragma unroll
    for (int x = 0; x < 4; ++x) Cacc[x] = (f32x4){0.f, 0.f, 0.f, 0.f};
    __syncthreads();
    for (int c = 0; c <= SEQ / CHK; ++c) {
        const int r0 = c * CHK;
        if (c < SEQ / CHK) {
            *(LAS u32x4*)(Qs + qrow * 72 + qch * 8) = qreg; *(LAS u32x4*)(Ks + qrow * 72 + qch * 8) = kreg;
#pragma unroll
            for (int i = 0; i < 2; ++i) { const int id = tid + 512 * i; *(LAS u32x4*)(Vs + (id >> 4) * 136 + (id & 15) * 8) = vreg[i]; }
            if (w == 0 && c > 0) { const float mp = MR[c - 1]; float n = nvec[lane] * __expf(mp - fmaxf(mp, GP[(c - 1) * 64 + 63]));
#pragma unroll
                for (int sp = 0; sp < 8; ++sp) n += npart[sp * 64 + lane];
                nvec[lane] = n; }
            CHAIN_BAR();
            {
                const int si = w >> 1; const float mr = MR[c];
                bf16x8 ak[2];
#pragma unroll
                for (int kk = 0; kk < 2; ++kk) ak[kk] = *(const LAS bf16x8*)(Ks + (16 * si + fr) * 72 + 32 * kk + 8 * fq);
                const f32x4 a4 = *(const LAS f32x4*)(GA + c * 64 + 16 * si + 4 * fq);
#pragma unroll
                for (int tt = 0; tt < 2; ++tt) { const int tj = 2 * (w & 1) + tt;
                    f32x4 s4 = (f32x4){0.f, 0.f, 0.f, 0.f};
#pragma unroll
                    for (int kk = 0; kk < 2; ++kk) { const bf16x8 bq = *(const LAS bf16x8*)(Qs + (16 * tj + fr) * 72 + 32 * kk + 8 * fq); s4 = __builtin_amdgcn_mfma_f32_16x16x32_bf16(ak[kk], bq, s4, 0, 0, 0); }
                    const int t = 16 * tj + fr; const float Mt = fmaxf(mr, GP[c * 64 + t]); float vv[4];
#pragma unroll
                    for (int r = 0; r < 4; ++r) { const int s = 16 * si + 4 * fq + r; vv[r] = (s <= t) ? s4[r] * __expf(a4[r] - Mt) : 0.f; }
                    u32x2 pw; pw.x = cvtpk(vv[0], vv[1]); pw.y = cvtpk(vv[2], vv[3]);
                    *(LAS u32x2*)(Sp + t * 72 + 16 * si + 4 * fq) = pw; }
            }
            CHAIN_BAR();
        }
        else CHAIN_BAR();
        if (c > 0) {
#pragma unroll
            for (int i = 0; i < 2; ++i) { const int id = tid + 512 * i, row = id >> 4, ch = id & 15;
                const u32x4 hs = *(const LAS u32x4*)(Hs + row * 136 + ch * 8); u32x4 o;
#pragma unroll
                for (int q = 0; q < 4; ++q) o[q] = cvtpk(bflo(hs[q]) * bflo(oreg[i][q]), bfhi(hs[q]) * bfhi(oreg[i][q]));
                *(u32x4*)(Hg + (size_t)(r0 - CHK + row) * 1024 + ch * 8) = o; }
        }
        if (c == SEQ / CHK) break;
        {
            const int rn = (c + 2 < SEQ / CHK) ? r0 + 2 * CHK : r0;
            qreg = qN; kreg = kN; vreg[0] = vN[0]; vreg[1] = vN[1];
            qN = *(const u32x4*)(Qg + (size_t)(rn + qrow) * 512 + qch * 8); kN = *(const u32x4*)(Kg + (size_t)(rn + qrow) * 512 + qch * 8);
#pragma unroll
            for (int i = 0; i < 2; ++i) { const int id = tid + 512 * i; vN[i] = *(const u32x4*)(Vg + (size_t)(rn + (id >> 4)) * 1024 + (id & 15) * 8);
                oreg[i] = *(const u32x4*)(Og + (size_t)(r0 + (id >> 4)) * 1024 + (id & 15) * 8); }
        }
        float hv[4][4];
        {
            const float mr = MR[c]; const float M63 = fmaxf(mr, GP[c * 64 + 63]); const float decay = __expf(mr - M63);
            float den[4], et[4], enm[4];
            {
                const f32x4 n4 = *(const LAS f32x4*)(nvec + 4 * fr);
                const f32x4 p4 = *(const LAS f32x4*)(GP + c * 64 + 16 * ti + 4 * fq), b4 = *(const LAS f32x4*)(GB + c * 64 + 16 * ti + 4 * fq);
#pragma unroll
                for (int r = 0; r < 4; ++r) { const int t = 16 * ti + 4 * fq + r;
                    const u32x2 sp = *(const LAS u32x2*)(Sp + t * 72 + 4 * fr), qq = *(const LAS u32x2*)(Qs + t * 72 + 4 * fr);
                    const float ssum = (bflo(sp.x) + bfhi(sp.x)) + (bflo(sp.y) + bfhi(sp.y));
                    const float qn = (bflo(qq.x) * n4[0] + bfhi(qq.x) * n4[1]) + (bflo(qq.y) * n4[2] + bfhi(qq.y) * n4[3]);
                    const float Mt = fmaxf(mr, p4[r]); et[r] = __expf(mr - Mt); enm[r] = __expf(-(b4[r] + Mt));
                    float p = ssum + et[r] * qn;
                    p = row16_sum(p);
                    den[r] = __builtin_amdgcn_rcpf(fmaxf(fabsf(p), enm[r])); }
            }
            bf16x8 as_[2], aq[2], akw[2], kf[2], bVall[4][2];
            tr_frag10(ks_tr, vs_tr, kf, bVall);
#pragma unroll
            for (int kk = 0; kk < 2; ++kk) { as_[kk] = *(const LAS bf16x8*)(Sp + (16 * ti + fr) * 72 + 32 * kk + 8 * fq); aq[kk] = *(const LAS bf16x8*)(Qs + (16 * ti + fr) * 72 + 32 * kk + 8 * fq); }
            {
                const bf16x8 k0 = kf[0], k1 = kf[1];
#pragma unroll
                for (int kk = 0; kk < 2; ++kk) { const u32x4 kw = __builtin_bit_cast(u32x4, kk ? k1 : k0);
                    const f32x4 a0 = *(const LAS f32x4*)(GA + c * 64 + 32 * kk + 8 * fq), a1 = *(const LAS f32x4*)(GA + c * 64 + 32 * kk + 8 * fq + 4);
                    u32x4 pk; pk.x = cvtpk(bflo(kw.x) * __expf(a0[0] - M63), bfhi(kw.x) * __expf(a0[1] - M63)); pk.y = cvtpk(bflo(kw.y) * __expf(a0[2] - M63), bfhi(kw.y) * __expf(a0[3] - M63));
                    pk.z = cvtpk(bflo(kw.z) * __expf(a1[0] - M63), bfhi(kw.z) * __expf(a1[1] - M63)); pk.w = cvtpk(bflo(kw.w) * __expf(a1[2] - M63), bfhi(kw.w) * __expf(a1[3] - M63));
                    akw[kk] = __builtin_bit_cast(bf16x8, pk); }
            }
            float ssq[4] = {0.f, 0.f, 0.f, 0.f};
#pragma unroll
            for (int x = 0; x < 4; ++x) { const int vi = vi0 + x;
                bf16x8 bV[2], bC[2]; bV[0] = bVall[x][0]; bV[1] = bVall[x][1];
#pragma unroll
                for (int kk = 0; kk < 2; ++kk) bC[kk] = *(const LAS bf16x8*)(CT + (16 * vi + fr) * 72 + 32 * kk + 8 * fq);
                f32x4 a1 = (f32x4){0.f, 0.f, 0.f, 0.f}, a2 = (f32x4){0.f, 0.f, 0.f, 0.f};
                a1 = __builtin_amdgcn_mfma_f32_16x16x32_bf16(as_[0], bV[0], a1, 0, 0, 0); a1 = __builtin_amdgcn_mfma_f32_16x16x32_bf16(as_[1], bV[1], a1, 0, 0, 0);
                a2 = __builtin_amdgcn_mfma_f32_16x16x32_bf16(aq[0], bC[0], a2, 0, 0, 0); a2 = __builtin_amdgcn_mfma_f32_16x16x32_bf16(aq[1], bC[1], a2, 0, 0, 0);
                Cacc[x] = Cacc[x] * decay;
                Cacc[x] = __builtin_amdgcn_mfma_f32_16x16x32_bf16(akw[0], bV[0], Cacc[x], 0, 0, 0); Cacc[x] = __builtin_amdgcn_mfma_f32_16x16x32_bf16(akw[1], bV[1], Cacc[x], 0, 0, 0);
#pragma unroll
                for (int r = 0; r < 4; ++r) { const float hh = (a1[r] + et[r] * a2[r]) * den[r]; hv[x][r] = hh; ssq[r] += hh * hh; } }
#pragma unroll
            for (int r = 0; r < 4; ++r) { const float p = row16_sum(ssq[r]);
                if (fr == 0) rss[(16 * ti + 4 * fq + r) * 2 + (w & 1)] = p; }
            { float pn = 0.f; const int d = tid & 63; const f32x4 a0 = *(const LAS f32x4*)(GA + c * 64 + 8 * w), a1 = *(const LAS f32x4*)(GA + c * 64 + 8 * w + 4);
#pragma unroll
              for (int s = 0; s < 8; ++s) pn += __expf((s < 4 ? a0[s & 3] : a1[s & 3]) - M63) * bf2f(Ks[(8 * w + s) * 72 + d]);
              npart[w * 64 + d] = pn; }
        }
        CHAIN_BAR();
        {
#pragma unroll
            for (int r = 0; r < 4; ++r) { const int t = 16 * ti + 4 * fq + r; const float rstd = __builtin_amdgcn_rsqf((rss[t * 2] + rss[t * 2 + 1]) * (1.f / DV) + RMS_EPS);
#pragma unroll
                for (int x = 0; x < 4; ++x) Hs[t * 136 + 16 * (vi0 + x) + fr] = (bf16_t)f2bf(hv[x][r] * rstd * hg[x]); }
#pragma unroll
            for (int x = 0; x < 4; ++x) { u32x2 pw; pw.x = cvtpk(Cacc[x][0], Cacc[x][1]); pw.y = cvtpk(Cacc[x][2], Cacc[x][3]);
                *(LAS u32x2*)(CT + (16 * (vi0 + x) + fr) * 72 + 16 * ti + 4 * fq) = pw; }
        }
    }
}

DI void ph_conv(int wv, int jl) {
    const CArgs* a = kargs(); const Frame F = make_frame(wv); asm volatile("" : "+s"(jl));
    const bf16_t* XRH = (const bf16_t*)(a->ws + WS_R + R_XR); bf16_t* XC = (bf16_t*)(a->ws + WS_R + R_XC);
    for (int it = F.vcu * NTHR + F.tid; it < (T / 64) * 3 * 128; it += F.G * NTHR) {
        const int chg = it & 127, i = (it >> 7) % 3, blk = it / (3 * 128), c0 = chg * 8;
        const u32x4 z = (u32x4){0u, 0u, 0u, 0u}; u32x4 x[4];
#pragma unroll
        for (int j = 0; j < 4; ++j) { const int rel = i - 3 + j;
            if (rel >= 0) x[j] = *(const u32x4*)(XRH + ((size_t)blk * 6 + rel) * D + c0);
            else if ((blk & 63) == 0) x[j] = z;
            else x[j] = *(const u32x4*)(XRH + ((size_t)(blk - 1) * 6 + 6 + rel) * D + c0); }
        u32x4 o;
#pragma unroll
        for (int q = 0; q < 4; ++q) { float lo = a->in[I_LCB][jl * D + c0 + 2 * q], hi = a->in[I_LCB][jl * D + c0 + 2 * q + 1];
#pragma unroll
            for (int j = 0; j < 4; ++j) { lo += a->in[I_LCW][((size_t)jl * 4 + j) * D + c0 + 2 * q] * bflo(x[j][q]); hi += a->in[I_LCW][((size_t)jl * 4 + j) * D + c0 + 2 * q + 1] * bfhi(x[j][q]); }
            o[q] = pk2(lo, hi); }
        *(u32x4*)(XC + (size_t)(blk * 64 + i) * D + c0) = o;
    }
}
constexpr int SEGL = 128, NSEG = SEQ / SEGL;
DI void ph_scan(int wv) {
    const CArgs* a = kargs(); const Frame F = make_frame(wv);
    const bf16_t* LA = (const bf16_t*)(a->ws + WS_R + R_LA); const bf16_t* U = (const bf16_t*)(a->ws + WS_R + R_U);
    const bf16_t* GB = (const bf16_t*)(a->ws + WS_R + R_GB); bf16_t* Y = (bf16_t*)(a->ws + WS_R + R_XR);
    const f32x4* CAR = (const f32x4*)(a->ws + WS_MODP);
    for (int gid = F.vcu * NTHR + F.tid; gid < BATCH * NSEG * 256; gid += F.G * NTHR) {
        const int c4 = gid & 255, seg = (gid >> 8) & (NSEG - 1), b = gid >> 13;
        const size_t base = ((size_t)b * SEQ + seg * SEGL) * D + 4 * c4;
        f32x4 h = (f32x4){0.f, 0.f, 0.f, 0.f};
#pragma unroll 4
        for (int blk = 0; blk < 2 * seg; ++blk) { const f32x4 p = CAR[((size_t)(b * 64 + blk) * 256 + c4) * 2], q = CAR[((size_t)(b * 64 + blk) * 256 + c4) * 2 + 1];
            h[0] = p[0] * h[0] + p[1]; h[1] = p[2] * h[1] + p[3]; h[2] = q[0] * h[2] + q[1]; h[3] = q[2] * h[3] + q[3]; }
#pragma unroll 8
        for (int r = 0; r < SEGL; ++r) { const u32x2 la = *(const u32x2*)(LA + base + (size_t)r * D), uu = *(const u32x2*)(U + base + (size_t)r * D);
            h[0] = __expf(bflo(la.x)) * h[0] + bflo(uu.x); h[1] = __expf(bfhi(la.x)) * h[1] + bfhi(uu.x); h[2] = __expf(bflo(la.y)) * h[2] + bflo(uu.y); h[3] = __expf(bfhi(la.y)) * h[3] + bfhi(uu.y);
            const u32x2 g = *(const u32x2*)(GB + base + (size_t)r * D); u32x2 o; o.x = pk2(h[0] * bflo(g.x), h[1] * bfhi(g.x)); o.y = pk2(h[2] * bflo(g.y), h[3] * bfhi(g.y));
            *(u32x2*)(Y + base + (size_t)r * D) = o; }
    }
}

#define PH_COMMON(jl) const CArgs* a = kargs(); const Frame F = make_frame(wv); asm volatile("" : "+s"(jl)); unsigned char* ws = a->ws; unsigned char* R = ws + WS_R; \
    const bf16_t* Wj = (const bf16_t*)(ws + WS_W) + (size_t)jl * W_PER_J; const bf16_t* HN = (const bf16_t*)(ws + WS_HN); float* XS = a->out; const float* MOD = (const float*)(ws + WS_MOD); \
    int bx = blockIdx.x; asm volatile("" : "+s"(bx)); (void)R; (void)Wj; (void)HN; (void)XS; (void)MOD
DI void ph_mlstm_gates(int wv, int jl) {
    const CArgs* a = kargs(); const Frame F = make_frame(wv); asm volatile("" : "+s"(jl));
    const bf16_t* HN = (const bf16_t*)(a->ws + WS_HN); float* G = (float*)(a->ws + WS_GATES);
    const bf16_t* Wg = (const bf16_t*)(a->ws + WS_W) + (size_t)jl * W_PER_J + W_WIN + (size_t)3072 * D;
    const int lane = F.lane, fr = lane & 15, fq = lane >> 4;
    { const int row = F.tid >> 5, ch = F.tid & 31;
#pragma unroll
      for (int q = 0; q < 4; ++q) *(LAS u32x4*)(F.lds + row * 2064 + ch * 64 + q * 16) = *(const u32x4*)(Wg + (size_t)row * D + ch * 32 + q * 8); }
    __syncthreads();
    const float bias = a->in[I_MLGB][jl * 16 + fr];
    float ln2s = 0.69314718f; asm volatile("" : "+s"(ln2s));
    const LAS unsigned char* bp = F.lds + fr * 2064 + fq * 16;
    for (int tile = F.vcu; tile < T / 256; tile += F.G) {
        const int R0 = tile * 256 + F.wave * 32;
        const bf16_t* a0 = HN + (size_t)(R0 + fr) * D + fq * 8; const bf16_t* a1 = a0 + (size_t)16 * D;
        f32x4 acc0 = (f32x4){0.f, 0.f, 0.f, 0.f}, acc1 = (f32x4){0.f, 0.f, 0.f, 0.f};
#pragma unroll 8
        for (int s = 0; s < 32; ++s) {
            const bf16x8 af0 = *(const bf16x8*)(a0 + s * 32), af1 = *(const bf16x8*)(a1 + s * 32);
            const bf16x8 bf = *(const LAS bf16x8*)(bp + s * 64);
            acc0 = __builtin_amdgcn_mfma_f32_16x16x32_bf16(af0, bf, acc0, 0, 0, 0); acc1 = __builtin_amdgcn_mfma_f32_16x16x32_bf16(af1, bf, acc1, 0, 0, 0);
        }
#pragma unroll
        for (int r = 0; r < 4; ++r) { float x0 = acc0[r] + bias, x1 = acc1[r] + bias;
            if (fr >= 8) { x0 = fminf(x0, 0.f) - ln2s * __builtin_amdgcn_logf(1.f + __expf(-fabsf(x0))); x1 = fminf(x1, 0.f) - ln2s * __builtin_amdgcn_logf(1.f + __expf(-fabsf(x1))); }
            G[(size_t)(R0 + 4 * fq + r) * 16 + fr] = x0; G[(size_t)(R0 + 16 + 4 * fq + r) * 16 + fr] = x1; }
    }
    __syncthreads();
}
DI void ph_gemm_mlstm_in(int wv, int jl) { PH_COMMON(jl);
    pg8::Gemm g{HN, Wj + W_WIN, D, D, nullptr, 0, 0}; pg8::SchedPlain S; S.init(T / 256, 3072 / 256, F.G, bx);
    pg8::EpiMlstmIn E{(bf16_t*)(R + R_Q), (bf16_t*)(R + R_K), (bf16_t*)(R + R_V), (bf16_t*)(R + R_O), (float*)(ws + WS_GATES), a->in[I_MLGB] + jl * 16};
    pg8::gemm_phase<pg8::EpiMlstmIn, pg8::SchedPlain, false>(F.lds, F.tid, g, S, E); }
DI void ph_gemm_resid(int wv, int jl, int which) { PH_COMMON(jl); asm volatile("" : "+s"(which));
    const int layer = 2 * jl + (which == 2 ? 1 : 0);
    pg8::SchedPlain S; S.init(T / 256, D / 256, F.G, bx);
    if (which != 1) {
        pg8::Gemm g{which == 0 ? (const bf16_t*)(R + R_HS) : (const bf16_t*)(R + R_XR), Wj + (which == 0 ? W_WOUT : W_LOUT), D, D, nullptr, 0, 0};
        pg8::EpiMix E{(bf16_t*)(R + R_M1), MOD + (size_t)layer * 16 * 6144 + 2048};
        pg8::gemm_phase<pg8::EpiMix, pg8::SchedPlain, false>(F.lds, F.tid, g, S, E);
    } else {
#define RESID_ARGS a->in[I_X], (bf16_t*)(R + R_XSB), MOD + (size_t)layer * 16 * 6144 + 5120, (const bf16_t*)(R + R_M1), (const float*)(ws + WS_CA1) + (size_t)jl * 16 * D, (bf16_t*)(ws + WS_HN), (float*)(ws + WS_GATES), F.lds
        if (DENSE_FP8_AT(jl)) { pg8::Gemm g{(const bf16_t*)(R + R_ACT), Wj + W_W2, DFF / 2, DFF / 2, nullptr, pg8::E8_W2, pg8::E8_ACT};
            if (jl == 0) { pg8::EpiResidT<false> E{RESID_ARGS}; pg8::gemm_phase<pg8::EpiResidT<false>, pg8::SchedPlain, false, true>(F.lds, F.tid, g, S, E); }
            else { pg8::EpiResidT<true> E{RESID_ARGS}; pg8::gemm_phase<pg8::EpiResidT<true>, pg8::SchedPlain, false, true>(F.lds, F.tid, g, S, E); } }
        else { pg8::Gemm g{(const bf16_t*)(R + R_ACT), Wj + W_W2, DFF, DFF, nullptr, 0, 0};
            if (jl == 0) { pg8::EpiResidT<false> E{RESID_ARGS}; pg8::gemm_phase<pg8::EpiResidT<false>, pg8::SchedPlain, false>(F.lds, F.tid, g, S, E); }
            else { pg8::EpiResidT<true> E{RESID_ARGS}; pg8::gemm_phase<pg8::EpiResidT<true>, pg8::SchedPlain, false>(F.lds, F.tid, g, S, E); } }
#undef RESID_ARGS
    }
}
DI void ph_gemm_ffn_up(int wv, int jl) { PH_COMMON(jl);
    pg8::SchedPlain S; S.init(T / 256, 2 * DFF / 256, F.G, bx);
    if (DENSE_FP8_AT(jl)) { pg8::EpiSwigluT<true> E{(unsigned char*)(R + R_ACT)}; pg8::Gemm g{HN, Wj + W_W13, D / 2, D / 2, nullptr, pg8::E8_W13, pg8::E8_HN}; pg8::gemm_phase<pg8::EpiSwigluT<true>, pg8::SchedPlain, false, true>(F.lds, F.tid, g, S, E); }
    else { pg8::EpiSwigluT<false> E{(unsigned char*)(R + R_ACT)}; pg8::Gemm g{HN, Wj + W_W13, D, D, nullptr, 0, 0}; pg8::gemm_phase<pg8::EpiSwigluT<false>, pg8::SchedPlain, false, false>(F.lds, F.tid, g, S, E); } }
DI void ph_gemm_lru_in(int wv, int jl) { PH_COMMON(jl);
    pg8::Gemm g{HN, Wj + W_LIN, D, D, nullptr, 0, 0}; pg8::SchedPlain S; S.init(T / 256, 2 * D / 256, F.G, bx);
    pg8::EpiLruIn E{(bf16_t*)(R + R_GB), (bf16_t*)(R + R_XC), (bf16_t*)(R + R_XR), a->in[I_LCW] + (size_t)jl * 4 * D, a->in[I_LCB] + (size_t)jl * D, F.lds,
                     (const float*)(ws + WS_GATES), (const float*)(ws + WS_BIASP) + (size_t)jl * 8 * 16 * 2048};
    pg8::gemm_phase<pg8::EpiLruIn, pg8::SchedPlain, false>(F.lds, F.tid, g, S, E); }
DI void ph_gemm_lru_gate(int wv, int jl) { PH_COMMON(jl);
    pg8::Gemm g{(const bf16_t*)(R + R_XC), Wj + W_GW, D, 256, nullptr, 0, 0}; pg8::SchedLruGate S; S.init(T / 256, 8, F.G, bx);
    pg8::EpiLruGate E{(const bf16_t*)(R + R_XC), (bf16_t*)(R + R_LA), (bf16_t*)(R + R_U), a->in[I_LGB] + (size_t)jl * 4 * 512, (const float*)(ws + WS_SP) + jl * D, (float*)(ws + WS_MODP)};
    pg8::gemm_phase<pg8::EpiLruGate, pg8::SchedLruGate, false>(F.lds, F.tid, g, S, E); }
DI void moe_sched(pg8::SchedMoe& S, unsigned char* ws, int& nti) { unsigned* META = (unsigned*)(ws + WS_CTL) + CW_META;
    nti = (int)__hip_atomic_load(META + 0, __ATOMIC_RELAXED, __HIP_MEMORY_SCOPE_AGENT);
    S.ts1 = (int)__hip_atomic_load(META + 2, __ATOMIC_RELAXED, __HIP_MEMORY_SCOPE_AGENT); S.ts2 = (int)__hip_atomic_load(META + 3, __ATOMIC_RELAXED, __HIP_MEMORY_SCOPE_AGENT);
    S.ts3 = (int)__hip_atomic_load(META + 4, __ATOMIC_RELAXED, __HIP_MEMORY_SCOPE_AGENT); S.ts4 = (int)__hip_atomic_load(META + 5, __ATOMIC_RELAXED, __HIP_MEMORY_SCOPE_AGENT);
    S.ts5 = (int)__hip_atomic_load(META + 6, __ATOMIC_RELAXED, __HIP_MEMORY_SCOPE_AGENT); S.ts6 = (int)__hip_atomic_load(META + 7, __ATOMIC_RELAXED, __HIP_MEMORY_SCOPE_AGENT);
    S.ts7 = (int)__hip_atomic_load(META + 8, __ATOMIC_RELAXED, __HIP_MEMORY_SCOPE_AGENT);
    nti = __builtin_amdgcn_readfirstlane(nti); S.ts1 = __builtin_amdgcn_readfirstlane(S.ts1); S.ts2 = __builtin_amdgcn_readfirstlane(S.ts2); S.ts3 = __builtin_amdgcn_readfirstlane(S.ts3);
    S.ts4 = __builtin_amdgcn_readfirstlane(S.ts4); S.ts5 = __builtin_amdgcn_readfirstlane(S.ts5); S.ts6 = __builtin_amdgcn_readfirstlane(S.ts6); S.ts7 = __builtin_amdgcn_readfirstlane(S.ts7); }
DI void ph_gemm_moe_up(int wv, int jl) { PH_COMMON(jl);
    pg8::SchedMoe S; int nti; moe_sched(S, ws, nti);
    pg8::Gemm g{HN, Wj + W_MW13, D / 2, D / 2, (const int*)(ws + WS_SLOTTOK), pg8::E8_W13, pg8::E8_HN}; S.init(nti, 2 * DFF / 256, F.G, bx); S.estride = (size_t)DFF * D;
    pg8::EpiSwiglu E{(unsigned char*)(R + R_ACT)};
    pg8::gemm_phase<pg8::EpiSwiglu, pg8::SchedMoe, true, true>(F.lds, F.tid, g, S, E); }
DI void ph_gemm_moe_down(int wv, int jl) { PH_COMMON(jl);
    pg8::SchedMoe S; int nti; moe_sched(S, ws, nti);
    pg8::Gemm g{(const bf16_t*)(R + R_ACT), Wj + W_MW2, DFF / 2, DFF / 2, nullptr, pg8::E8_W2, pg8::E8_ACT}; S.init(nti, D / 256, F.G, bx); S.estride = (size_t)D * DFF / 2;
    pg8::EpiBf16 E{(bf16_t*)(R + R_YS), D};
    pg8::gemm_phase<pg8::EpiBf16, pg8::SchedMoe, false, true>(F.lds, F.tid, g, S, E); }

constexpr int N_PHASES = 3 + 2 * 18;
#ifndef ONLY
#define ONLY -1
#endif
#define EN(k) (ONLY < 0 || ONLY == (k))
#ifndef DUP_MASK
#define DUP_MASK 0ull
#endif
#define DUP(k) (((DUP_MASK) >> (k)) & 1ull)
DI void seam() { XcdBarrier b; b.bar = (unsigned*)(kargs()->ws + WS_CTL) + CW_BAR; b.x = xb_xcc_id(); b.st = (volatile LAS unsigned*)((LAS unsigned char*)lds_raw + MISC_OFF) + 8; xcd_barrier(b); }
__global__ void __launch_bounds__(NTHR, 2) fwd(Args args) {
    { volatile LAS unsigned* MISC = (volatile LAS unsigned*)((LAS unsigned char*)lds_raw + MISC_OFF);
      if (threadIdx.x < 64) MISC[threadIdx.x] = 0u;
      __syncthreads();
      if (!MK_PER_PHASE) (void)xcd_barrier_post((unsigned*)(args.ws + WS_CTL) + CW_BAR, MISC + 8); }
    const int wv = __builtin_amdgcn_readfirstlane((int)threadIdx.x >> 6);
    const int lo = args.ph_lo, hi = args.ph_hi;
#define IN(k) (lo <= (k) && (k) < hi)
#define SEAM(k) do { if (IN(k) && IN((k) + 1)) seam(); } while (0)
    if (EN(100) && IN(0)) { ph_prologue_a(wv); if (DUP(20)) { __syncthreads(); ph_prologue_a(wv); } }
    SEAM(0);
    if (EN(102) && IN(2)) { row_pass<0, false>(wv, 0, 0, 0, 0, 0, 0); if (DUP(22)) row_pass<0, false>(wv, 0, 0, 0, 0, 0, 0); }
    SEAM(2);
#pragma nounroll
    for (int jl = 0; jl < 2; ++jl) {
        const int P = 3 + 18 * jl, LA_ = 2 * jl, LB_ = 2 * jl + 1;
        if (EN(0) && IN(P + 0)) { ph_mlstm_gates(wv, jl); ph_gemm_mlstm_in(wv, jl); if (DUP(0)) ph_gemm_mlstm_in(wv, jl); }
        SEAM(P + 0);
        if (EN(1) && IN(P + 1)) { if (blockIdx.x >= BATCH * ML_H) { ph_moe_convert(wv, jl); if (DUP(2)) ph_moe_convert(wv, jl); } else { ph_mlstm(wv, jl); if (DUP(1)) { __syncthreads(); ph_mlstm(wv, jl); } } }
        SEAM(P + 1);
        if (EN(2) && IN(P + 2)) ph_gemm_resid(wv, jl, 0);
        SEAM(P + 2);
        if (EN(3) && IN(P + 3)) { ph_lru_tables(wv, jl); if (jl == 0) row_pass<0, false>(wv, 0, LA_ * 2 + 1, LA_, 1, jl, 1); else row_pass<0, true>(wv, 1, LA_ * 2 + 1, LA_, 1, jl, 1); }
        SEAM(P + 3);
        if (EN(4) && IN(P + 4)) { ph_gemm_ffn_up(wv, jl); if (DUP(4)) ph_gemm_ffn_up(wv, jl); }
        SEAM(P + 4);
        if (EN(2) && IN(P + 5)) ph_gemm_resid(wv, jl, 1);
        SEAM(P + 5);
        if (EN(7) && IN(P + 7)) { ph_gemm_lru_in(wv, jl); if (DUP(7)) ph_gemm_lru_in(wv, jl); }
        SEAM(P + 7);
        if (EN(8) && IN(P + 8)) { ph_conv(wv, jl); if (DUP(8)) ph_conv(wv, jl); }
        SEAM(P + 8);
        if (EN(9) && IN(P + 9)) { ph_gemm_lru_gate(wv, jl); if (DUP(9)) ph_gemm_lru_gate(wv, jl); }
        SEAM(P + 9);
        if (EN(11) && IN(P + 11)) { ph_scan(wv); if (DUP(11)) ph_scan(wv); }
        SEAM(P + 11);
        if (EN(2) && IN(P + 12)) ph_gemm_resid(wv, jl, 2);
        SEAM(P + 12);
        if (EN(13) && IN(P + 13)) { row_pass<1, true>(wv, 1, LB_ * 2 + 1, LB_, 1, jl, 1); if (DUP(13)) { __syncthreads(); row_pass<1, true>(wv, 1, LB_ * 2 + 1, LB_, 1, jl, 1); } }
        SEAM(P + 13);
        if (EN(14) && IN(P + 14)) { ph_slots(wv); if (DUP(14)) { __syncthreads(); ph_slots(wv); } }
        SEAM(P + 14);
        if (EN(15) && IN(P + 15)) { ph_gemm_moe_up(wv, jl); if (DUP(15)) ph_gemm_moe_up(wv, jl); }
        SEAM(P + 15);
        if (EN(16) && IN(P + 16)) { ph_gemm_moe_down(wv, jl); if (DUP(16)) ph_gemm_moe_down(wv, jl); }
        SEAM(P + 16);
        if (EN(17) && IN(P + 17)) { if (jl == 0) row_pass<2, true>(wv, 1, (LB_ + 1) * 2 + 0, LB_ + 1, 0, jl, 1); else row_pass<3, true>(wv, 1, -1, LB_, 0, jl, 1); }
        SEAM(P + 17);
    }
#undef IN
#undef SEAM
}

extern "C" void kernel_launch(void* const* d_in, const int* in_sizes, int n_in, void* d_out, int out_size, void* d_ws, size_t ws_size, hipStream_t stream) {
    static int grid = 0;
    if (grid == 0) {
        if (n_in != N_IN || out_size != T * D || ws_size < WS_END) { fprintf(stderr, "kernel_launch: unexpected problem (n_in %d out %d ws %zu, need %zu)\n", n_in, out_size, ws_size, (size_t)WS_END); grid = -1; return; }
        int dev = 0, cus = 0, per_cu = 0;
        if (hipGetDevice(&dev) != hipSuccess || hipDeviceGetAttribute(&cus, hipDeviceAttributeMultiprocessorCount, dev) != hipSuccess) { grid = -1; return; }
        if (hipFuncSetAttribute((const void*)fwd, hipFuncAttributeMaxDynamicSharedMemorySize, LDS_BYTES) != hipSuccess) { fprintf(stderr, "kernel_launch: hipFuncSetAttribute failed\n"); grid = -1; return; }
        if (hipOccupancyMaxActiveBlocksPerMultiprocessor(&per_cu, (const void*)fwd, NTHR, LDS_BYTES) != hipSuccess || per_cu < 1) fprintf(stderr, "kernel_launch: occupancy query says %d\n", per_cu);
        (void)hipGetLastError();
        grid = cus;
    }
    if (grid < 0) return;
    (void)hipMemsetAsync((char*)d_ws + WS_CTL, 0, CTL_ZERO_BYTES, stream);
    Args a{};
    for (int i = 0; i < N_IN; ++i) a.in[i] = (const float*)d_in[i];
    a.out = (float*)d_out; a.ws = (unsigned char*)d_ws;
#if MK_PER_PHASE
    for (int p = 0; p < N_PHASES; ++p) { a.ph_lo = p; a.ph_hi = p + 1; hipLaunchKernelGGL(fwd, dim3(grid), dim3(NTHR), LDS_BYTES, stream, a); }
#else
    a.ph_lo = 0; a.ph_hi = N_PHASES; hipLaunchKernelGGL(fwd, dim3(grid), dim3(NTHR), LDS_BYTES, stream, a);
#endif
}
```

```cpp
#include <hip/hip_runtime.h>
#include <cstdio>
#include <cstdint>

#ifndef DENSE_FP8_MASK
#define DENSE_FP8_MASK 3
#endif
#define DENSE_FP8_AT(jl) (((DENSE_FP8_MASK) >> (jl)) & 1)
#ifndef MK_PER_PHASE
#define MK_PER_PHASE 0
#endif

#define DI __device__ __forceinline__
#define GAS __attribute__((address_space(1)))
#define LAS __attribute__((address_space(3)))
typedef unsigned short bf16_t;
typedef short bf16x8 __attribute__((ext_vector_type(8)));
typedef float f32x4 __attribute__((ext_vector_type(4)));
typedef float f32x2 __attribute__((ext_vector_type(2)));
typedef unsigned u32x4 __attribute__((ext_vector_type(4)));
typedef unsigned u32x2 __attribute__((ext_vector_type(2)));
typedef int i32x2 __attribute__((ext_vector_type(2)));

constexpr int D = 1024, BATCH = 16, SEQ = 4096, T = BATCH * SEQ;
constexpr int ML_H = 8, DV = 128, DQK = 64, CHK = 64, MLP = 3088, MLPP = 3328;
constexpr int DFF = 3584, NE = 8;
constexpr int MAXSLOT = 2 * T + 8 * 256;
constexpr float RMS_EPS = 1e-6f;
constexpr int NWAVES = 8, NTHR = 512;

enum { I_X = 0, I_C, I_ADAW, I_ADAB, I_NORMG, I_MLWIN, I_MLGB, I_MLHG, I_MLWOUT, I_FW13, I_FW2, I_LWIN, I_LCW, I_LCB, I_LGW, I_LGB, I_LAP, I_LWOUT, I_RW, I_RB, I_MW13, I_MW2, I_FNG, N_IN };

constexpr size_t MiB = 1u << 20;
constexpr size_t WS_CTL = 0, CTL_ZERO_BYTES = 1 * MiB;
constexpr size_t WS_MOD = 1 * MiB;
constexpr size_t WS_MODP = 3 * MiB;
constexpr size_t WS_SP = 15 * MiB;
constexpr size_t WS_CA1 = 15 * MiB + 64 * 1024;
constexpr size_t WS_GATES = 16 * MiB;
constexpr size_t WS_BIASP = 20 * MiB;
constexpr size_t WS_TOPE = 22 * MiB;
constexpr size_t WS_TOPW = 22 * MiB + 512 * 1024;
constexpr size_t WS_HIST = 23 * MiB;
constexpr size_t WS_SLOTTOK = 23 * MiB + 256 * 1024;
constexpr size_t WS_TOKSLOT = 24 * MiB;
constexpr size_t WS_W = 32 * MiB;
constexpr size_t WS_HN = 448 * MiB;
constexpr size_t WS_R = 576 * MiB;
constexpr size_t WS_END = WS_R + 1170 * MiB;
constexpr size_t W_WIN = 0, W_WOUT = W_WIN + (size_t)MLPP * D, W_W13 = W_WOUT + (size_t)D * D, W_W2 = W_W13 + (size_t)2 * DFF * D, W_LIN = W_W2 + (size_t)D * DFF,
                 W_GW = W_LIN + (size_t)2 * D * D, W_LOUT = W_GW + (size_t)4 * 512 * 256, W_MW13 = W_LOUT + (size_t)D * D, W_MW2 = W_MW13 + (size_t)NE * 2 * DFF * D, W_PER_J = W_MW2 + (size_t)NE * D * DFF;
static_assert(WS_W + 2 * W_PER_J * 2 <= WS_HN, "weights fit");
constexpr size_t R_Q = 0, R_K = 64 * MiB, R_V = 128 * MiB, R_O = 256 * MiB, R_HS = 384 * MiB;
constexpr size_t R_ACT = 0;
constexpr size_t R_GB = 0, R_XR = 128 * MiB, R_XC = 256 * MiB, R_LA = 384 * MiB, R_U = 512 * MiB;
constexpr size_t R_M1 = 512 * MiB;
constexpr size_t R_XSB = 640 * MiB;
constexpr size_t R_YS = 910 * MiB;
static_assert((size_t)MAXSLOT * DFF * 2 == 910 * MiB, "moe act size");
constexpr int CW_BAR = 4096, CW_META = 8192;

constexpr int LDS_BYTES = 147456, MISC_OFF = 147200;

DI float bf2f(unsigned short b) { return __uint_as_float(((unsigned)b) << 16); }
DI float bflo(unsigned u) { return __uint_as_float(u << 16); }
DI float bfhi(unsigned u) { return __uint_as_float(u & 0xffff0000u); }
DI unsigned f2bf(float f) { unsigned u = __float_as_uint(f); return (u + 0x7fffu + ((u >> 16) & 1u)) >> 16; }
DI unsigned pk2(float lo, float hi) { return f2bf(lo) | (f2bf(hi) << 16); }
DI float sigmoid_f(float x) { return __builtin_amdgcn_rcpf(1.f + __expf(-x)); }
DI float log1p_exp_neg(float x) {
    float ln2 = 0.69314718f; asm volatile("" : "+s"(ln2));
    const float e = __expf(-x), u = 1.f + e, d = u - 1.f;
    return d == 0.f ? e : ln2 * __builtin_amdgcn_logf(u) * (e / d);
}
DI float wave_sum(float v) {
    { const int x = __builtin_bit_cast(int, v); v += __builtin_bit_cast(float, __builtin_amdgcn_update_dpp(x, x, 0xB1, 0xf, 0xf, true)); }
    { const int x = __builtin_bit_cast(int, v); v += __builtin_bit_cast(float, __builtin_amdgcn_update_dpp(x, x, 0x4E, 0xf, 0xf, true)); }
    { const int x = __builtin_bit_cast(int, v); v += __builtin_bit_cast(float, __builtin_amdgcn_update_dpp(x, x, 0x141, 0xf, 0xf, true)); }
    { const int x = __builtin_bit_cast(int, v); v += __builtin_bit_cast(float, __builtin_amdgcn_update_dpp(x, x, 0x140, 0xf, 0xf, true)); }
    const int y = __builtin_bit_cast(int, v);
    const float r0 = __builtin_bit_cast(float, __builtin_amdgcn_readlane(y, 0)), r1 = __builtin_bit_cast(float, __builtin_amdgcn_readlane(y, 16));
    const float r2 = __builtin_bit_cast(float, __builtin_amdgcn_readlane(y, 32)), r3 = __builtin_bit_cast(float, __builtin_amdgcn_readlane(y, 48));
    return (r0 + r1) + (r2 + r3);
}
DI int wave_sum_i(int v) {
#pragma unroll
    for (int o = 1; o < 64; o <<= 1) v += __shfl_xor(v, o);
    return v;
}
#define LDS_WAIT() asm volatile("s_waitcnt lgkmcnt(0)" ::: "memory")

#define XB_TMO      128
#define XB_XCNT(j)  (256  + 64 * (j))
#define XB_XSUB(j)  (1280 + 64 * (j))
#define XB_XGEN(j)  (2304 + 64 * (j))
#define XB_TOP      3328
#define XB_TOPGEN   3392
#define XCD_BAR_WORDS 3456
#define XB_SPIN_CAP (1u << 19)
DI unsigned xb_ld(unsigned* p)              { return __hip_atomic_load(p, __ATOMIC_RELAXED, __HIP_MEMORY_SCOPE_AGENT); }
DI unsigned xb_add(unsigned* p, unsigned v) { return __hip_atomic_fetch_add(p, v, __ATOMIC_RELAXED, __HIP_MEMORY_SCOPE_AGENT); }
DI unsigned xb_xcc_id() { return (unsigned)__builtin_amdgcn_s_getreg((3 << 11) | 20) & 0xFu; }
#define XB_SPIN(cond, bar) do { unsigned _sp = 0; while (cond) { __builtin_amdgcn_s_sleep(1); \
    if ((++_sp & 255u) == 0u) { if (xb_ld(&(bar)[XB_TMO])) break; if (_sp > XB_SPIN_CAP) { atomicAdd(&(bar)[XB_TMO], 1u); break; } } } } while (0)
struct XcdBarrier { unsigned* bar; unsigned x; volatile LAS unsigned* st; };
DI XcdBarrier xcd_barrier_post(unsigned* bar, volatile LAS unsigned* st) {
    XcdBarrier b; b.bar = bar; b.x = xb_xcc_id(); b.st = st;
    if (threadIdx.x == 0) (void)xb_add(&bar[XB_XCNT(b.x)], 1u);
    return b;
}
DI void xcd_barrier_complete(unsigned* bar, unsigned x, unsigned& nloc, unsigned& nx) {
    const unsigned G = gridDim.x * gridDim.y * gridDim.z;
    unsigned sum, cnt, mine, sp = 0u;
    for (;;) {
        sum = 0u; cnt = 0u; mine = 0u;
#pragma unroll
        for (unsigned j = 0; j < 16; ++j) { const unsigned c = xb_ld(&bar[XB_XCNT(j)]); sum += c; cnt += (c > 0u) ? 1u : 0u; mine = (j == x) ? c : mine; }
        if (sum == G) break;
        __builtin_amdgcn_s_sleep(1);
        if ((++sp & 255u) == 0u) { if (xb_ld(&bar[XB_TMO])) break; if (sp > XB_SPIN_CAP) { atomicAdd(&bar[XB_TMO], 1u); break; } }
    }
    nloc = mine > 0u ? mine : 1u; nx = cnt > 0u ? cnt : 1u;
}
DI void xcd_barrier(const XcdBarrier& b) {
    asm volatile("s_waitcnt vmcnt(0)" ::: "memory");
    __syncthreads();
    if (threadIdx.x == 0) {
        unsigned* bar = b.bar;
        __builtin_amdgcn_s_waitcnt(0);
        unsigned nloc = b.st[0], nx = b.st[1];
        if (nloc == 0u) { xcd_barrier_complete(bar, b.x, nloc, nx); b.st[0] = nloc; b.st[1] = nx; }
        const unsigned old = xb_add(&bar[XB_XSUB(b.x)], 1u);
        const unsigned gen = old / nloc;
        if (old + 1u == (gen + 1u) * nloc) {
            __builtin_amdgcn_fence(__ATOMIC_RELEASE, "agent");
            asm volatile("s_waitcnt vmcnt(0)" ::: "memory");
            const unsigned og = xb_add(&bar[XB_TOP], 1u);
            const unsigned tg = og / nx;
            if (og + 1u == (tg + 1u) * nx) xb_add(&bar[XB_TOPGEN], 1u);
            else XB_SPIN(xb_ld(&bar[XB_TOPGEN]) == tg, bar);
            __builtin_amdgcn_fence(__ATOMIC_ACQUIRE, "agent");
            xb_add(&bar[XB_XGEN(b.x)], 1u);
            asm volatile("s_waitcnt vmcnt(0)" ::: "memory");
        } else {
            XB_SPIN(xb_ld(&bar[XB_XGEN(b.x)]) == gen, bar);
            __builtin_amdgcn_fence(__ATOMIC_ACQUIRE, "agent");
            asm volatile("s_waitcnt vmcnt(0)" ::: "memory");
        }
    }
    __syncthreads();
}

namespace pg8 {
constexpr int BM = 256, BK = 64, HALF = 128, HTB = HALF * BK * 2, STAGE_BYTES = 8 * HTB, NXCD = 8, WGM = 8;
__host__ __device__ __forceinline__ int lds_byte(int r, int c) { const int st = (r >> 4) * 2 + (c >> 5), rr = r & 15, cc = c & 31, ob = rr * 64 + cc * 2; return st * 1024 + (ob ^ (((ob >> 9) & 1) << 5)); }
__host__ __device__ __forceinline__ void stage_rc(int b, int& R, int& C) { const int st = b / 1024, sb = b % 1024, swz = sb ^ (((sb >> 9) & 1) << 5); R = (st >> 1) * 16 + swz / 64; C = (st & 1) * 32 + (swz % 64) / 2; }
__host__ __device__ __forceinline__ int perm32(int rho) { const int n = rho >> 4, i = rho & 15; return 8 * (i >> 2) + 4 * n + (i & 3); }
struct Unit { int pm, pn; };
struct Gemm { const bf16_t* A; const bf16_t* Bt; int lda, K; const int* gidx; int sc_w, sc_a; };

struct Order {
    int nM, nN, nwg, G, c;
    DI void init(int nM_, int nN_, int G_, int c_) { nM = nM_; nN = nN_; nwg = nM * nN; G = G_; c = c_; }
    DI bool next(int i, Unit& u) const {
        const long L = (long)i * G + c; if (L >= nwg) return false;
        int wgid = (int)L; { const int q = nwg / NXCD, r = nwg % NXCD, xcd = wgid % NXCD, off = wgid / NXCD; wgid = (xcd < r ? xcd * (q + 1) : r * (q + 1) + (xcd - r) * q) + off; }
        const int nig = WGM * nN, gid = wgid / nig, fm = gid * WGM, gsz = (nM - fm) < WGM ? (nM - fm) : WGM;
        u.pm = fm + ((wgid % nig) % gsz); u.pn = (wgid % nig) / gsz; return true;
    }
};
struct SchedPlain : Order { DI size_t a_off(const Unit&) const { return 0; } DI size_t b_off(const Unit&) const { return 0; } };
struct SchedLruGate : Order { DI size_t a_off(const Unit& u) const { return (size_t)(u.pn >> 1) * 256; } DI size_t b_off(const Unit&) const { return 0; } };
struct SchedMoe : Order { int ts1, ts2, ts3, ts4, ts5, ts6, ts7; size_t estride;
    DI size_t a_off(const Unit&) const { return 0; }
    DI size_t b_off(const Unit& u) const { const int e = (u.pm >= ts1) + (u.pm >= ts2) + (u.pm >= ts3) + (u.pm >= ts4) + (u.pm >= ts5) + (u.pm >= ts6) + (u.pm >= ts7); return (size_t)e * estride; } };

DI unsigned cvt_pk_bf16(float lo, float hi) { unsigned r; asm volatile("v_cvt_pk_bf16_f32 %0, %1, %2" : "=v"(r) : "v"(lo), "v"(hi)); return r; }
DI u32x4 pack8(const f32x4& v0, const f32x4& v1) { u32x4 w; w.x = cvt_pk_bf16(v0[0], v0[1]); w.y = cvt_pk_bf16(v0[2], v0[3]); w.z = cvt_pk_bf16(v1[0], v1[1]); w.w = cvt_pk_bf16(v1[2], v1[3]); return w; }

typedef f32x4 Acc[2][2][4][2];

struct EpiMlstmIn { static constexpr bool PERM = true;
    bf16_t *Q, *K, *V, *O; float* gates; const float* gate_b;
    DI void operator()(const Acc& acc, const Unit& u, int wr, int wc, int fr, int fq) const {
        const int row0 = u.pm * BM + wr * 64 + fr;
        if (u.pn < 12) {
            bf16_t* base; int ldc, colt; float sc = 1.f; bool act = false;
            if (u.pn < 2) { base = Q; ldc = 512; colt = u.pn * 256; sc = 0.125f; }
            else if (u.pn < 4) { base = K; ldc = 512; colt = (u.pn - 2) * 256; }
            else if (u.pn < 8) { base = V; ldc = 1024; colt = (u.pn - 4) * 256; }
            else { base = O; ldc = 1024; colt = (u.pn - 8) * 256; act = true; }
            const int col0 = colt + wc * 32 + 8 * fq;
#pragma unroll
            for (int ai = 0; ai < 2; ++ai)
#pragma unroll
                for (int m = 0; m < 4; ++m) { bf16_t* rowp = base + (size_t)(row0 + ai * HALF + m * 16) * ldc + col0;
#pragma unroll
                    for (int bj = 0; bj < 2; ++bj) { f32x4 v0 = acc[ai][bj][m][0], v1 = acc[ai][bj][m][1];
                        if (act) {
#pragma unroll
                            for (int j = 0; j < 4; ++j) { v0[j] = sigmoid_f(v0[j]); v1[j] = sigmoid_f(v1[j]); } }
                        v0 = v0 * sc; v1 = v1 * sc;
                        *(u32x4*)(rowp + bj * HALF) = pack8(v0, v1); } }
        }
    }
};
template <bool SB> struct EpiResidT { static constexpr bool PERM = true;
    const float* src; bf16_t* xs; const float* gmod; const bf16_t* m1;
    const float* ca; bf16_t* xa; float* ssq; LAS unsigned char* lds;
    DI void operator()(const Acc& acc, const Unit& u, int wr, int wc, int fr_, int fq_) const {
        unsigned ones = ~0u; asm volatile("" : "+s"(ones)); const int ln = (int)__builtin_amdgcn_mbcnt_hi(ones, __builtin_amdgcn_mbcnt_lo(ones, 0u)); const int fr = ln & 15, fq = ln >> 4; (void)fr_; (void)fq_;
        const int row0 = u.pm * BM + wr * 64 + fr, col0 = u.pn * BM + wc * 32 + 8 * fq;
        const int tid = (wr * 4 + wc) * 64 + ln;
        if (tid < 256) *(LAS float*)(lds + STAGE_BYTES + 6144 + tid * 4) = gmod[(size_t)(u.pm >> 4) * 6144 + u.pn * BM + tid];
        else *(LAS float*)(lds + STAGE_BYTES + 7168 + (tid - 256) * 4) = ca[(size_t)(u.pm >> 4) * D + u.pn * BM + (tid - 256)];
        asm volatile("s_waitcnt vmcnt(0) lgkmcnt(0)" ::: "memory"); __builtin_amdgcn_s_barrier(); asm volatile("" ::: "memory");
        const LAS float* GS = (const LAS float*)(lds + STAGE_BYTES + 6144) + wc * 32 + 8 * fq; const LAS float* CS = (const LAS float*)(lds + STAGE_BYTES + 7168) + wc * 32 + 8 * fq;
#pragma unroll
        for (int am = 0; am < 8; ++am) { const int ai = am >> 2, m = am & 3;
            const int row = row0 + ai * HALF + m * 16; const size_t off = (size_t)row * D + col0; float ss = 0.f;
            f32x4 sv[2][2]; u32x4 sw[2], mw[2];
#pragma unroll
            for (int bj = 0; bj < 2; ++bj) {
                if constexpr (SB) sw[bj] = *(const u32x4*)(xs + off + bj * HALF);
                else { sv[bj][0] = *(const f32x4*)(src + off + bj * HALF); sv[bj][1] = *(const f32x4*)(src + off + bj * HALF + 4); }
                mw[bj] = *(const u32x4*)(m1 + off + bj * HALF); }
#pragma unroll
            for (int bj = 0; bj < 2; ++bj) { f32x4 y[2], xo[2];
#pragma unroll
                for (int n = 0; n < 2; ++n) { const unsigned w0 = mw[bj][2 * n], w1 = mw[bj][2 * n + 1]; const f32x4 mv = (f32x4){bflo(w0), bfhi(w0), bflo(w1), bfhi(w1)};
                    f32x4 s; if constexpr (SB) { const unsigned a0 = sw[bj][2 * n], a1 = sw[bj][2 * n + 1]; s = (f32x4){bflo(a0), bfhi(a0), bflo(a1), bfhi(a1)}; } else s = sv[bj][n];
                    const f32x4 x = (s + mv) + *(const LAS f32x4*)(GS + bj * HALF + n * 4) * acc[ai][bj][m][n];
                    xo[n] = x; ss += (x[0] * x[0] + x[1] * x[1]) + (x[2] * x[2] + x[3] * x[3]); y[n] = x * *(const LAS f32x4*)(CS + bj * HALF + n * 4); }
                *(u32x4*)(xs + off + bj * HALF) = pack8(xo[0], xo[1]);
                *(u32x4*)(xa + off + bj * HALF) = pack8(y[0], y[1]); }
            ss += __shfl_xor(ss, 16); ss += __shfl_xor(ss, 32);
            if (fq == 0) *(LAS float*)(lds + STAGE_BYTES + 2048 + ((wr * 64 + ai * HALF + m * 16 + fr) * 4 + wc) * 4) = ss;
        }
        asm volatile("s_waitcnt lgkmcnt(0)" ::: "memory"); __builtin_amdgcn_s_barrier(); asm volatile("" ::: "memory");
        if (tid < 256) { const f32x4 t = *(const LAS f32x4*)(lds + STAGE_BYTES + 2048 + tid * 16); ssq[(size_t)(u.pm * BM + tid) * 4 + u.pn] = (t[0] + t[1]) + (t[2] + t[3]); }
    }
};
struct EpiMix { static constexpr bool PERM = true;
    bf16_t* M; const float* gmod;
    DI void operator()(const Acc& acc, const Unit& u, int wr, int wc, int fr, int fq) const {
        const int row0 = u.pm * BM + wr * 64 + fr, col0 = u.pn * BM + wc * 32 + 8 * fq;
        const float* gv = gmod + (size_t)(u.pm >> 4) * 6144 + col0;
        f32x4 g4[2][2];
#pragma unroll
        for (int bj = 0; bj < 2; ++bj)
#pragma unroll
            for (int n = 0; n < 2; ++n) g4[bj][n] = *(const f32x4*)(gv + bj * HALF + n * 4);
#pragma unroll
        for (int ai = 0; ai < 2; ++ai)
#pragma unroll
            for (int m = 0; m < 4; ++m) { bf16_t* rowp = M + (size_t)(row0 + ai * HALF + m * 16) * D + col0;
#pragma unroll
                for (int bj = 0; bj < 2; ++bj) *(u32x4*)(rowp + bj * HALF) = pack8(acc[ai][bj][m][0] * g4[bj][0], acc[ai][bj][m][1] * g4[bj][1]); }
    }
};
constexpr float ACT_SCALE = 4.f, HN_SCALE = 4.f, W13_SCALE = 32.f, W2_SCALE = 64.f;
constexpr int E8_ACT = 0x7d7d7d7d, E8_HN = 0x7d7d7d7d, E8_W13 = 0x7a7a7a7a, E8_W2 = 0x79797979;
DI unsigned pk4_fp8(float a, float b, float c, float d) {
    a = __builtin_amdgcn_fmed3f(a, -448.f, 448.f); b = __builtin_amdgcn_fmed3f(b, -448.f, 448.f); c = __builtin_amdgcn_fmed3f(c, -448.f, 448.f); d = __builtin_amdgcn_fmed3f(d, -448.f, 448.f);
    int w = 0; w = __builtin_amdgcn_cvt_pk_fp8_f32(a, b, w, false); w = __builtin_amdgcn_cvt_pk_fp8_f32(c, d, w, true); return (unsigned)w; }
template <bool F8> struct EpiSwigluT { static constexpr bool PERM = true;
    unsigned char* O;
    DI void operator()(const Acc& acc, const Unit& u, int wr, int wc, int fr, int fq) const {
        const int row0 = u.pm * BM + wr * 64 + fr, col0 = u.pn * HALF + wc * 32 + 8 * fq;
#pragma unroll
        for (int ai = 0; ai < 2; ++ai)
#pragma unroll
            for (int m = 0; m < 4; ++m) { f32x4 v0, v1;
#pragma unroll
                for (int j = 0; j < 4; ++j) { const float a0 = acc[ai][0][m][0][j], a1 = acc[ai][0][m][1][j];
                    if constexpr (F8) {
                        v0[j] = a0 * __builtin_amdgcn_rcpf(__builtin_fmaf(__builtin_amdgcn_exp2f(-a0), 1.f / ACT_SCALE, 1.f / ACT_SCALE)) * acc[ai][1][m][0][j];
                        v1[j] = a1 * __builtin_amdgcn_rcpf(__builtin_fmaf(__builtin_amdgcn_exp2f(-a1), 1.f / ACT_SCALE, 1.f / ACT_SCALE)) * acc[ai][1][m][1][j]; }
                    else { v0[j] = a0 * sigmoid_f(a0) * acc[ai][1][m][0][j]; v1[j] = a1 * sigmoid_f(a1) * acc[ai][1][m][1][j]; } }
                if constexpr (F8) { u32x2 w; w.x = pk4_fp8(v0[0], v0[1], v0[2], v0[3]); w.y = pk4_fp8(v1[0], v1[1], v1[2], v1[3]);
                    *(u32x2*)(O + (size_t)(row0 + ai * HALF + m * 16) * DFF + col0) = w; }
                else *(u32x4*)((bf16_t*)O + (size_t)(row0 + ai * HALF + m * 16) * DFF + col0) = pack8(v0, v1); }
    }
};
typedef EpiSwigluT<true> EpiSwiglu;
template <int K> DI float dpp_ror(float v) { const int x = __builtin_bit_cast(int, v); return __builtin_bit_cast(float, __builtin_amdgcn_update_dpp(x, x, 0x120 + K, 0xf, 0xf, true)); }
struct EpiLruIn { static constexpr bool PERM = true;
    bf16_t *GB, *XC, *XRH; const float* cw; const float* cb; LAS unsigned char* lds;
    const float* ssq; const float* biasp;
    DI void operator()(const Acc& acc, const Unit& u, int wr, int wc, int fr_, int fq_) const {
        unsigned ones = ~0u; asm volatile("" : "+s"(ones)); const int ln = (int)__builtin_amdgcn_mbcnt_hi(ones, __builtin_amdgcn_mbcnt_lo(ones, 0u)); const int fr = ln & 15, fq = ln >> 4; (void)fr_; (void)fq_;
        const int row0 = u.pm * BM + wr * 64 + fr; const bool isg = u.pn < 4; const int tid = (wr * 4 + wc) * 64 + ln;
        LAS float* RS = (LAS float*)(lds + STAGE_BYTES + 6144); LAS float* BS = (LAS float*)(lds + STAGE_BYTES + 7168); LAS float* TB = (LAS float*)(lds + STAGE_BYTES + 8192);
        if (tid < 256) { const f32x4 t = *(const f32x4*)(ssq + (size_t)(u.pm * BM + tid) * 4); RS[tid] = __builtin_amdgcn_rsqf(((t[0] + t[1]) + (t[2] + t[3])) * (1.f / D) + RMS_EPS); }
        else { const float* bp = biasp + (size_t)(u.pm >> 4) * 2048 + u.pn * BM + (tid - 256); float s = 0.f;
#pragma unroll
            for (int ks = 0; ks < 8; ++ks) s += bp[(size_t)ks * 16 * 2048];
            BS[tid - 256] = s; }
        const int c0 = (u.pn - 4) * 256;
        if (!isg) for (int idx = tid; idx < 5 * 256; idx += 512) TB[idx] = (idx < 1024) ? cw[(size_t)(idx >> 8) * D + c0 + (idx & 255)] : cb[c0 + idx - 1024];
        asm volatile("s_waitcnt vmcnt(0) lgkmcnt(0)" ::: "memory"); __builtin_amdgcn_s_barrier(); asm volatile("" ::: "memory");
        const int cl = wc * 32 + 8 * fq;
        if (isg) {
            const int col0 = u.pn * 256 + cl;
#pragma unroll
            for (int ai = 0; ai < 2; ++ai)
#pragma unroll
                for (int m = 0; m < 4; ++m) { bf16_t* rowp = GB + (size_t)(row0 + ai * HALF + m * 16) * D + col0; const float r = RS[wr * 64 + fr + ai * HALF + m * 16];
#pragma unroll
                    for (int bj = 0; bj < 2; ++bj) { f32x4 v0 = acc[ai][bj][m][0] * r + *(const LAS f32x4*)(BS + cl + bj * HALF), v1 = acc[ai][bj][m][1] * r + *(const LAS f32x4*)(BS + cl + bj * HALF + 4);
#pragma unroll
                        for (int j = 0; j < 4; ++j) { float x = v0[j]; float z = 1.5957691216f * (x + 0.044715f * x * x * x); v0[j] = x * sigmoid_f(z);
                            x = v1[j]; z = 1.5957691216f * (x + 0.044715f * x * x * x); v1[j] = x * sigmoid_f(z); }
                        *(u32x4*)(rowp + bj * HALF) = pack8(v0, v1); }
                    asm volatile("" ::: "memory"); }
        } else {
            const int col0 = c0 + cl;
#pragma unroll
            for (int ai = 0; ai < 2; ++ai)
#pragma unroll
                for (int m = 0; m < 4; ++m) { const int row = row0 + ai * HALF + m * 16; const float r = RS[wr * 64 + fr + ai * HALF + m * 16], rp = (m > 0) ? RS[wr * 64 + fr + ai * HALF + (m > 0 ? m - 1 : 0) * 16] : 0.f;
#pragma unroll
                    for (int bj = 0; bj < 2; ++bj) { f32x4 o[2], xs[2];
#pragma unroll
                        for (int n = 0; n < 2; ++n) { const LAS float* tp = TB + cl + bj * HALF + 4 * n; const f32x4 bq = *(const LAS f32x4*)(BS + cl + bj * HALF + 4 * n);
                            const f32x4 w0 = *(const LAS f32x4*)(tp), w1 = *(const LAS f32x4*)(tp + 256), w2 = *(const LAS f32x4*)(tp + 512), w3 = *(const LAS f32x4*)(tp + 768), b4 = *(const LAS f32x4*)(tp + 1024);
#pragma unroll
                            for (int j = 0; j < 4; ++j) { const float x0 = acc[ai][bj][m][n][j] * r + bq[j]; const float xp = (m > 0) ? acc[ai][bj][m > 0 ? m - 1 : 0][n][j] * rp + bq[j] : 0.f;
                                const float c1 = dpp_ror<1>(x0), c2 = dpp_ror<2>(x0), c3 = dpp_ror<3>(x0), p1 = dpp_ror<1>(xp), p2 = dpp_ror<2>(xp), p3 = dpp_ror<3>(xp);
                                const float x1 = (fr >= 1) ? c1 : p1, x2 = (fr >= 2) ? c2 : p2, x3 = (fr >= 3) ? c3 : p3;
                                xs[n][j] = x0; o[n][j] = b4[j] + w0[j] * x3 + w1[j] * x2 + w2[j] * x1 + w3[j] * x0; }
                            asm volatile("" ::: "memory"); }
                        *(u32x4*)(XC + (size_t)row * D + col0 + bj * HALF) = pack8(o[0], o[1]);
                        if (m == 0 && fr < 3) *(u32x4*)(XRH + ((size_t)(row >> 6) * 6 + fr) * D + col0 + bj * HALF) = pack8(xs[0], xs[1]);
                        if (m == 3 && fr >= 13) *(u32x4*)(XRH + ((size_t)(row >> 6) * 6 + 3 + (fr - 13)) * D + col0 + bj * HALF) = pack8(xs[0], xs[1]);
                        __builtin_amdgcn_sched_barrier(0); }
                    asm volatile("" ::: "memory"); }
        }
    }
};
template <int K> DI float dpp_shr(float v) { const int x = __builtin_bit_cast(int, v); return __builtin_bit_cast(float, __builtin_amdgcn_update_dpp(x, x, 0x110 + K, 0xf, 0xf, true)); }
struct EpiLruGate { static constexpr bool PERM = true;
    const bf16_t* XC; bf16_t *LA, *U; const float* gate_b; const float* sp; float* car64;
    DI void operator()(const Acc& acc, const Unit& u, int wr, int wc, int fr, int fq) const {
        const int row0 = u.pm * BM + wr * 64 + fr, ch0 = u.pn * HALF + wc * 32 + 8 * fq;
        const int hd = u.pn >> 1, o0 = (u.pn & 1) * HALF + wc * 32 + 8 * fq;
        u32x4 xw[2][4];
#pragma unroll
        for (int ai = 0; ai < 2; ++ai)
#pragma unroll
            for (int m = 0; m < 4; ++m) xw[ai][m] = *(const u32x4*)(XC + (size_t)(row0 + ai * HALF + m * 16) * D + ch0);
#pragma unroll
        for (int n = 0; n < 2; ++n) {
            const f32x4 bx = *(const f32x4*)(gate_b + hd * 512 + o0 + 4 * n), ba = *(const f32x4*)(gate_b + hd * 512 + 256 + o0 + 4 * n), s4 = *(const f32x4*)(sp + ch0 + 4 * n);
#pragma unroll
            for (int ai = 0; ai < 2; ++ai) {
                float Ab[4] = {1.f, 1.f, 1.f, 1.f}, Hb[4] = {0.f, 0.f, 0.f, 0.f};
#pragma unroll
                for (int m = 0; m < 4; ++m) { const size_t off = (size_t)(row0 + ai * HALF + m * 16) * D + ch0 + 4 * n;
                    float la[4], uu[4];
#pragma unroll
                    for (int j = 0; j < 4; ++j) { const unsigned w = xw[ai][m][2 * n + (j >> 1)]; const float xc = (j & 1) ? bfhi(w) : bflo(w);
                        const float ig = sigmoid_f(acc[ai][0][m][n][j] + bx[j]), rg = sigmoid_f(acc[ai][1][m][n][j] + ba[j]);
                        const float l = -8.f * rg * s4[j]; const float av = __expf(l);
                        la[j] = l; uu[j] = xc * ig * __builtin_amdgcn_sqrtf(1.f - av * av); }
                    u32x2 lw, uw; lw.x = cvt_pk_bf16(la[0], la[1]); lw.y = cvt_pk_bf16(la[2], la[3]); uw.x = cvt_pk_bf16(uu[0], uu[1]); uw.y = cvt_pk_bf16(uu[2], uu[3]);
                    *(u32x2*)(LA + off) = lw; *(u32x2*)(U + off) = uw;
#pragma unroll
                    for (int j = 0; j < 4; ++j) { const unsigned lq = (j < 2) ? lw.x : lw.y, uq = (j < 2) ? uw.x : uw.y;
                        float A = __expf((j & 1) ? bfhi(lq) : bflo(lq)), H = (j & 1) ? bfhi(uq) : bflo(uq);
                        { const float Al = dpp_shr<1>(A), Hl = dpp_shr<1>(H); H = A * Hl + H; A = Al * A; }
                        { const float Al = dpp_shr<2>(A), Hl = dpp_shr<2>(H); H = A * Hl + H; A = Al * A; }
                        { const float Al = dpp_shr<4>(A), Hl = dpp_shr<4>(H); H = A * Hl + H; A = Al * A; }
                        { const float Al = dpp_shr<8>(A), Hl = dpp_shr<8>(H); H = A * Hl + H; A = Al * A; }
                        Hb[j] = A * Hb[j] + H; Ab[j] = Ab[j] * A; } }
                if (fr == 15) { float* cp = car64 + ((size_t)(u.pm * 4 + 2 * ai + wr) * D + ch0 + 4 * n) * 2;
                    *(f32x4*)(cp) = (f32x4){Ab[0], Hb[0], Ab[1], Hb[1]}; *(f32x4*)(cp + 4) = (f32x4){Ab[2], Hb[2], Ab[3], Hb[3]}; }
            }
        }
    }
};
struct EpiBf16 { static constexpr bool PERM = true;
    bf16_t* O; int ldc;
    DI void operator()(const Acc& acc, const Unit& u, int wr, int wc, int fr, int fq) const {
        const int row0 = u.pm * BM + wr * 64 + fr, col0 = u.pn * BM + wc * 32 + 8 * fq;
#pragma unroll
        for (int ai = 0; ai < 2; ++ai)
#pragma unroll
            for (int m = 0; m < 4; ++m) { bf16_t* rowp = O + (size_t)(row0 + ai * HALF + m * 16) * ldc + col0;
#pragma unroll
                for (int bj = 0; bj < 2; ++bj) *(u32x4*)(rowp + bj * HALF) = pack8(acc[ai][bj][m][0], acc[ai][bj][m][1]); }
    }
};

typedef int i32x4 __attribute__((ext_vector_type(4)));
typedef int i32x8 __attribute__((ext_vector_type(8)));
template <class Epi, class Sched, bool GATHER, bool FP8 = false>
DI void gemm_phase(LAS unsigned char* lds, const int tid, const Gemm g, const Sched& S, const Epi& E) {
    const int wid = __builtin_amdgcn_readfirstlane(tid >> 6), lane = tid & 63, wr = wid >> 2, wc = wid & 3, fr = lane & 15, fq = lane >> 4;
    const int K = g.K, lda = g.lda, nt = K / BK;
    unsigned voffA[2], voffB[2]; int RA[2]; unsigned CA2[2];
#pragma unroll
    for (int i = 0; i < 2; ++i) { int R, C; stage_rc(tid * 16 + i * 8192, R, C); const int Rb = Epi::PERM ? ((R & ~31) + perm32(R & 31)) : R;
        voffA[i] = (unsigned)(R * lda + C) * 2u; voffB[i] = (unsigned)(Rb * K + C) * 2u; RA[i] = R; CA2[i] = (unsigned)C * 2u; }
    const size_t kstep = (size_t)(BK * 2);
    const size_t hstepA = GATHER ? 0 : (size_t)HALF * lda * 2, hstepB = (size_t)HALF * K * 2;
    const size_t tstepA = GATHER ? 0 : 2 * hstepA, tstepB = 2 * hstepB;
    const unsigned ldsw = (unsigned)wid * 1024u;
    const int aoff = lds_byte(wr * 64 + fr, fq * 8), boff = lds_byte(wc * 32 + fr, fq * 8);
    unsigned vc[2][2];
#define PG8_SA(b, h) (((b) * 2 + (h)) * HTB)
#define PG8_SB(b, h) ((4 + (b) * 2 + (h)) * HTB)
#define PG8_STAGE(bufoff, gbase, voff) do { _Pragma("unroll") for (int _i = 0; _i < 2; ++_i) \
        __builtin_amdgcn_global_load_lds((const unsigned*)((const char*)(gbase) + (voff)[_i]), (LAS unsigned*)(lds + (bufoff) + ldsw + _i * 8192), 16, 0, 0); } while (0)
#define PG8_STAGE_A(bufoff, kptr, h, VV) do { if constexpr (GATHER) { PG8_STAGE(bufoff, kptr, (VV)[h]); } else { PG8_STAGE(bufoff, (kptr) + (h) * hstepA, voffA); } } while (0)
#define PG8_LDA(dst, b, h) do { _Pragma("unroll") for (int m = 0; m < 4; ++m) _Pragma("unroll") for (int k = 0; k < 2; ++k) dst[m][k] = *(const LAS bf16x8*)(lds + PG8_SA(b, h) + aoff + m * 2048 + k * 1024); } while (0)
#define PG8_LDB(dst, b, h) do { _Pragma("unroll") for (int n = 0; n < 2; ++n) _Pragma("unroll") for (int k = 0; k < 2; ++k) dst[n][k] = *(const LAS bf16x8*)(lds + PG8_SB(b, h) + boff + n * 2048 + k * 1024); } while (0)
#define PG8_CAT(f) __builtin_shufflevector(__builtin_bit_cast(i32x4, (f)[0]), __builtin_bit_cast(i32x4, (f)[1]), 0, 1, 2, 3, 4, 5, 6, 7)
#define PG8_MMA(ai, bj, At, Bt) do { __builtin_amdgcn_s_setprio(1); _Pragma("unroll") for (int m = 0; m < 4; ++m) _Pragma("unroll") for (int n = 0; n < 2; ++n) { \
        if constexpr (FP8) { const i32x8 _b = PG8_CAT(Bt[n]), _a = PG8_CAT(At[m]); asm volatile("v_mfma_scale_f32_16x16x128_f8f6f4 %0, %1, %2, %0, %3, %4 op_sel_hi:[0,0,0]" : "+v"(acc[ai][bj][m][n]) : "v"(_b), "v"(_a), "v"(scw), "v"(sca)); } \
        else { _Pragma("unroll") for (int k = 0; k < 2; ++k) acc[ai][bj][m][n] = __builtin_amdgcn_mfma_f32_16x16x32_bf16(Bt[n][k], At[m][k], acc[ai][bj][m][n], 0, 0, 0); } } __builtin_amdgcn_s_setprio(0); } while (0)
#define PG8_WAIT_V(n) asm volatile("s_waitcnt vmcnt(" #n ")" ::: "memory")
#define PG8_WAIT_L(n) asm volatile("s_waitcnt lgkmcnt(" #n ")" ::: "memory")
#define PG8_BAR __builtin_amdgcn_s_barrier()
#define PG8_SCHED __builtin_amdgcn_sched_barrier(0)
#define PG8_GIDX(VV, U) do { if constexpr (GATHER) { _Pragma("unroll") for (int _h = 0; _h < 2; ++_h) _Pragma("unroll") for (int _i = 0; _i < 2; ++_i) { \
        const int _tok = g.gidx[(U).pm * BM + _h * HALF + RA[_i]]; (VV)[_h][_i] = (unsigned)_tok * (unsigned)(lda * 2) + CA2[_i]; } } } while (0)
#define PG8_GIDX_LDS(VV, BUF) do { if constexpr (GATHER) { _Pragma("unroll") for (int _h = 0; _h < 2; ++_h) _Pragma("unroll") for (int _i = 0; _i < 2; ++_i) { \
        const int _tok = *(const LAS int*)(lds + STAGE_BYTES + (BUF) * 1024 + (_h * HALF + RA[_i]) * 4); (VV)[_h][_i] = (unsigned)_tok * (unsigned)(lda * 2) + CA2[_i]; } } } while (0)
    Unit cur, nxt; int ui = 0;
    if (!S.next(0, cur)) return;
    int scw = 0, sca = 0; if constexpr (FP8) { scw = g.sc_w; sca = g.sc_a; asm volatile("" : "+v"(scw), "+v"(sca)); }
    Acc acc;
#pragma unroll
    for (int a = 0; a < 2; ++a)
#pragma unroll
        for (int b = 0; b < 2; ++b)
#pragma unroll
            for (int m = 0; m < 4; ++m)
#pragma unroll
                for (int n = 0; n < 2; ++n) acc[a][b][m][n] = (f32x4){0.f, 0.f, 0.f, 0.f};
    bf16x8 At[4][2], B0[2][2], B1[2][2];
    const char* cA = (const char*)(g.A + S.a_off(cur)) + (size_t)cur.pm * tstepA; const char* cB = (const char*)(g.Bt + S.b_off(cur)) + (size_t)cur.pn * tstepB;
    vc[0][0] = vc[0][1] = vc[1][0] = vc[1][1] = 0u;
    PG8_GIDX(vc, cur);
    PG8_STAGE(PG8_SB(0, 0), cB, voffB); PG8_STAGE(PG8_SB(0, 1), cB + hstepB, voffB); PG8_STAGE_A(PG8_SA(0, 0), cA, 0, vc); PG8_STAGE_A(PG8_SA(0, 1), cA, 1, vc);
    if (wr == 1) PG8_BAR;
    PG8_WAIT_V(2); PG8_BAR;
    PG8_STAGE(PG8_SB(1, 0), cB + kstep, voffB); PG8_STAGE_A(PG8_SA(1, 0), cA + kstep, 0, vc); PG8_STAGE(PG8_SB(1, 1), cB + hstepB + kstep, voffB);
    PG8_WAIT_V(6); PG8_BAR;
    for (;;) {
        const bool has_next = S.next(ui + 1, nxt);
        const char* nA = has_next ? (const char*)(g.A + S.a_off(nxt)) + (size_t)nxt.pm * tstepA : cA; const char* nB = has_next ? (const char*)(g.Bt + S.b_off(nxt)) + (size_t)nxt.pn * tstepB : cB;
        if constexpr (GATHER) { if (has_next && wid == 0)
            __builtin_amdgcn_global_load_lds((const unsigned*)(g.gidx + (size_t)nxt.pm * BM + lane * 4), (LAS unsigned*)(lds + STAGE_BYTES + (ui & 1) * 1024), 16, 0, 0); }
#pragma nounroll
        for (int t = 0; t < nt; t += 2) {
            const bool last = (t == nt - 2);
            const char* a1 = cA + (size_t)(t + 1) * kstep;
            const char* a2 = last ? nA : cA + (size_t)(t + 2) * kstep; const char* b2 = last ? nB : cB + (size_t)(t + 2) * kstep;
            const char* a3 = a2 + kstep; const char* b3 = b2 + kstep;
            unsigned v2[2][2];
#pragma unroll
            for (int h = 0; h < 2; ++h)
#pragma unroll
                for (int i = 0; i < 2; ++i) v2[h][i] = vc[h][i];
            if (last && has_next) { PG8_GIDX_LDS(v2, ui & 1); }
            PG8_LDB(B0, 0, 0); PG8_LDB(B1, 0, 1); PG8_SCHED; PG8_LDA(At, 0, 0); PG8_STAGE_A(PG8_SA(1, 1), a1, 1, vc);
            PG8_WAIT_V(8); PG8_WAIT_L(0); PG8_BAR; PG8_MMA(0, 0, At, B0); PG8_MMA(0, 1, At, B1); PG8_BAR; PG8_SCHED;
            PG8_LDA(At, 0, 1); PG8_STAGE(PG8_SB(0, 0), b2, voffB); PG8_STAGE(PG8_SB(0, 1), b2 + hstepB, voffB); PG8_STAGE_A(PG8_SA(0, 0), a2, 0, v2);
            PG8_WAIT_V(8); PG8_WAIT_L(0); PG8_BAR; PG8_MMA(1, 0, At, B0); PG8_MMA(1, 1, At, B1); PG8_BAR; PG8_SCHED;
            PG8_LDB(B0, 1, 0); PG8_LDB(B1, 1, 1); PG8_SCHED; PG8_LDA(At, 1, 0); PG8_STAGE_A(PG8_SA(0, 1), a2, 1, v2);
            PG8_WAIT_V(8); PG8_WAIT_L(0); PG8_BAR; PG8_MMA(0, 0, At, B0); PG8_MMA(0, 1, At, B1); PG8_BAR; PG8_SCHED;
            PG8_LDA(At, 1, 1); PG8_STAGE(PG8_SB(1, 0), b3, voffB); PG8_STAGE(PG8_SB(1, 1), b3 + hstepB, voffB); PG8_STAGE_A(PG8_SA(1, 0), a3, 0, v2);
            PG8_WAIT_V(8); PG8_WAIT_L(0); PG8_BAR; PG8_MMA(1, 0, At, B0); PG8_MMA(1, 1, At, B1); PG8_BAR; PG8_SCHED;
            if constexpr (GATHER) { if (last) {
#pragma unroll
                for (int h = 0; h < 2; ++h)
#pragma unroll
                    for (int i = 0; i < 2; ++i) vc[h][i] = v2[h][i]; } }
        }
        if (wr == 0) PG8_BAR;
        if constexpr (FP8) asm volatile("s_nop 15\n\ts_nop 15\n\ts_nop 15\n\ts_nop 15\n\ts_nop 15" ::: "memory");
        E(acc, cur, wr, wc, fr, fq);
        if (!has_next) break;
#pragma unroll
        for (int a = 0; a < 2; ++a)
#pragma unroll
            for (int b = 0; b < 2; ++b)
#pragma unroll
                for (int m = 0; m < 4; ++m)
#pragma unroll
                    for (int n = 0; n < 2; ++n) acc[a][b][m][n] = (f32x4){0.f, 0.f, 0.f, 0.f};
        cur = nxt; cA = nA; cB = nB; ++ui;
        if (wr == 1) PG8_BAR;
    }
    PG8_WAIT_V(0);
    PG8_BAR;
#undef PG8_SA
#undef PG8_SB
#undef PG8_STAGE
#undef PG8_STAGE_A
#undef PG8_LDA
#undef PG8_LDB
#undef PG8_MMA
#undef PG8_CAT
#undef PG8_WAIT_V
#undef PG8_WAIT_L
#undef PG8_BAR
#undef PG8_SCHED
#undef PG8_GIDX
#undef PG8_GIDX_LDS
}
}

struct Args { const float* in[N_IN]; float* out; unsigned char* ws; int ph_lo, ph_hi; };
static_assert(sizeof(Args) == (N_IN + 2) * 8 + 8, "Args has no padding");

typedef const Args __attribute__((address_space(4))) CArgs;
DI const CArgs* kargs() { const CArgs* p = (const CArgs*)__builtin_amdgcn_kernarg_segment_ptr(); asm volatile("" : "+s"(p)); return p; }
struct Frame { LAS unsigned char* lds; int tid, lane, wave, vcu, G; };
extern __shared__ __attribute__((aligned(16))) unsigned char lds_raw[];
DI Frame make_frame(int wv) { Frame F; F.lds = (LAS unsigned char*)lds_raw; unsigned ones = ~0u; asm volatile("" : "+s"(ones)); int t = wv * 64 + (int)__builtin_amdgcn_mbcnt_hi(ones, __builtin_amdgcn_mbcnt_lo(ones, 0u)); asm volatile("" : "+v"(t)); F.tid = t; F.lane = t & 63; F.wave = __builtin_amdgcn_readfirstlane(t >> 6);
    F.G = gridDim.x; { int bx = blockIdx.x; asm volatile("" : "+s"(bx)); F.vcu = (F.G % 8 == 0) ? (bx % 8) * (F.G / 8) + bx / 8 : bx; } return F; }

struct TrItem { const float* W; bf16_t* WT; int K, N, half, item; float f8scale; };
DI void tr_load(const TrItem& q, int lane, float (&v)[32]) {
    const int nblk = (q.N + 31) >> 5, kb = q.item / nblk, nb = q.item - kb * nblk, k0 = 64 * kb, n0 = 32 * nb;
    const int n = n0 + (lane & 31); const bool ok = n < q.N; const int nc = ok ? n : q.N - 1;
    const float* p = q.W + (size_t)(k0 + (lane >> 5)) * q.N + nc; const size_t rs = (size_t)2 * q.N;
#pragma unroll
    for (int i = 0; i < 32; ++i) v[i] = __builtin_nontemporal_load(p + (size_t)i * rs);
    if (!ok) {
#pragma unroll
        for (int i = 0; i < 32; ++i) v[i] = 0.f; }
}
DI void tr_store(const TrItem& q, int lane, const float (&v)[32], LAS float* scr) {
    const int nblk = (q.N + 31) >> 5, kb = q.item / nblk, nb = q.item - kb * nblk, k0 = 64 * kb, n0 = 32 * nb;
#pragma unroll
    for (int i = 0; i < 32; ++i) { const int kk = 2 * i + (lane >> 5); scr[kk * 33 + (lane & 31)] = v[i]; }
    LDS_WAIT(); asm volatile("" ::: "memory");
    const int c = lane & 7;
#pragma unroll
    for (int j = 0; j < 4; ++j) { const int nl = (lane >> 3) + 8 * j; const LAS float* s = scr + (8 * c) * 33 + nl;
        u32x4 o; o.x = pk2(s[0 * 33], s[1 * 33]); o.y = pk2(s[2 * 33], s[3 * 33]); o.z = pk2(s[4 * 33], s[5 * 33]); o.w = pk2(s[6 * 33], s[7 * 33]);
        const int n = n0 + nl; int rho = n;
        if (q.half) { const int nn = (n < q.half) ? n : n - q.half; rho = ((nn >> 7) << 8) + (nn & 127) + ((n < q.half) ? 0 : 128); }
        if (q.f8scale != 0.f) { const float f = q.f8scale * (q.half ? ((n < q.half) ? 1.44269504f : 0.693147181f) : 1.f); u32x2 o8;     o8.x = pg8::pk4_fp8(s[0 * 33] * f, s[1 * 33] * f, s[2 * 33] * f, s[3 * 33] * f); o8.y = pg8::pk4_fp8(s[4 * 33] * f, s[5 * 33] * f, s[6 * 33] * f, s[7 * 33] * f);
            *(u32x2*)((unsigned char*)q.WT + (size_t)rho * q.K + k0 + 8 * c) = o8; }
        else *(u32x4*)(q.WT + (size_t)rho * q.K + k0 + 8 * c) = o; }
    LDS_WAIT(); asm volatile("" ::: "memory");
}
constexpr int CI0 = 16 * 97, CI1 = 512, CI2 = 3584, CI3 = 1792, CI4 = 1024, CI5 = 256, CI6 = 512, CI7 = 8 * 3584, CI8 = 8 * 1792, CI_PER_J = CI0 + CI1 + CI2 + CI3 + CI4 + CI5 + CI6 + CI7 + CI8;
constexpr int N_MODIT = 4 * 24 * 8;
constexpr int CI_A_FWD = CI0 + CI1 + CI2 + CI3 + CI4 + CI5 + CI6;
DI TrItem conv_desc(const CArgs* a, int it) {
    const int j = it / CI_PER_J; int r = it - j * CI_PER_J;
    bf16_t* wb = (bf16_t*)(a->ws + WS_W) + (size_t)j * W_PER_J;
    if (r < CI0) return TrItem{a->in[I_MLWIN] + (size_t)j * D * MLP, wb + W_WIN, D, MLP, 0, r, 0.f}; r -= CI0;
    if (r < CI1) return TrItem{a->in[I_MLWOUT] + (size_t)j * D * D, wb + W_WOUT, D, D, 0, r, 0.f}; r -= CI1;
    if (r < CI2) return TrItem{a->in[I_FW13] + (size_t)j * D * 2 * DFF, wb + W_W13, D, 2 * DFF, DFF, r, DENSE_FP8_AT(j) ? pg8::W13_SCALE : 0.f}; r -= CI2;
    if (r < CI3) return TrItem{a->in[I_FW2] + (size_t)j * DFF * D, wb + W_W2, DFF, D, 0, r, DENSE_FP8_AT(j) ? pg8::W2_SCALE : 0.f}; r -= CI3;
    if (r < CI4) return TrItem{a->in[I_LWIN] + (size_t)j * D * 2 * D, wb + W_LIN, D, 2 * D, 0, r, 0.f}; r -= CI4;
    if (r < CI5) { const int hd = r >> 6; return TrItem{a->in[I_LGW] + (size_t)(j * 4 + hd) * 256 * 512, wb + W_GW + (size_t)hd * 512 * 256, 256, 512, 256, r & 63, 0.f}; } r -= CI5;
    if (r < CI6) return TrItem{a->in[I_LWOUT] + (size_t)j * D * D, wb + W_LOUT, D, D, 0, r, 0.f}; r -= CI6;
    if (r < CI7) { const int e = r / 3584; return TrItem{a->in[I_MW13] + (size_t)(j * NE + e) * D * 2 * DFF, wb + W_MW13 + (size_t)e * DFF * D, D, 2 * DFF, DFF, r - e * 3584, pg8::W13_SCALE}; } r -= CI7;
    { const int e = r / 1792; return TrItem{a->in[I_MW2] + (size_t)(j * NE + e) * DFF * D, wb + W_MW2 + (size_t)e * (D * DFF / 2), DFF, D, 0, r - e * 1792, pg8::W2_SCALE}; }
}
DI void conv_stream(const CArgs* a, int first, int step, int end, LAS float* scr, int lane) {
    if (first >= end) return;
    float va[32], vb[32];
    TrItem qa = conv_desc(a, first), qb = qa;
    tr_load(qa, lane, va);
    for (int it = first; it < end; it += 2 * step) {
        const bool hb = it + step < end;
        if (hb) { qb = conv_desc(a, it + step); tr_load(qb, lane, vb); }
        tr_store(qa, lane, va, scr);
        if (!hb) break;
        const bool ha = it + 2 * step < end;
        if (ha) { qa = conv_desc(a, it + 2 * step); tr_load(qa, lane, va); }
        tr_store(qb, lane, vb, scr);
        if (!ha) break;
    }
}
DI void mod_item(const CArgs* a, int it, const LAS float* cact, int lane) {
    const int i = it / 192, rem = it - i * 192, cg = rem >> 3, ks = rem & 7;
    const float* w = a->in[I_ADAW] + ((size_t)i * D + ks * 128) * 6144 + cg * 256 + lane * 4;
    f32x4 acc[16];
#pragma unroll
    for (int b = 0; b < 16; ++b) acc[b] = (f32x4){0.f, 0.f, 0.f, 0.f};
#pragma unroll 4
    for (int k = 0; k < 128; ++k) { const f32x4 w4 = *(const f32x4*)(w + (size_t)k * 6144);
#pragma unroll
        for (int b = 0; b < 16; ++b) acc[b] += w4 * cact[b * D + ks * 128 + k]; }
    float* o = (float*)(a->ws + WS_MODP) + ((size_t)(ks * 4 + i) * 16) * 6144 + cg * 256 + lane * 4;
#pragma unroll
    for (int b = 0; b < 16; ++b) *(f32x4*)(o + (size_t)b * 6144) = acc[b];
}
DI void mod_item_full(const CArgs* a, int it, const LAS float* cact, int lane) {
    const int i = it / 24, cg = it - i * 24;
    const float* w = a->in[I_ADAW] + (size_t)i * D * 6144 + cg * 256 + lane * 4;
    f32x4 acc[16];
#pragma unroll
    for (int b = 0; b < 16; ++b) acc[b] = (f32x4){0.f, 0.f, 0.f, 0.f};
    for (int k0 = 0; k0 < D; k0 += 16) { f32x4 w4[16];
#pragma unroll
        for (int kk = 0; kk < 16; ++kk) w4[kk] = __builtin_nontemporal_load((const f32x4*)(w + (size_t)(k0 + kk) * 6144));
#pragma unroll
        for (int kk = 0; kk < 16; ++kk)
#pragma unroll
            for (int b = 0; b < 16; ++b) acc[b] += w4[kk] * cact[b * D + k0 + kk]; }
    const f32x4 bias = *(const f32x4*)(a->in[I_ADAB] + (size_t)i * 6144 + cg * 256 + lane * 4);
    float* o = (float*)(a->ws + WS_MOD) + ((size_t)i * 16) * 6144 + cg * 256 + lane * 4;
#pragma unroll
    for (int b = 0; b < 16; ++b) *(f32x4*)(o + (size_t)b * 6144) = acc[b] + bias;
}
DI void ph_prologue_a(int wv) {
    const CArgs* a = kargs(); const Frame F = make_frame(wv);
    LAS float* cact = (LAS float*)(F.lds + 8 * 8448);
    LAS float* scr = (LAS float*)(F.lds + F.wave * 8448);
    for (int idx = F.tid; idx < 16 * D; idx += NTHR) { const float c = a->in[I_C][idx]; cact[idx] = c * sigmoid_f(c); }
    __syncthreads();
    const int gw = F.vcu * NWAVES + F.wave, NGW = F.G * NWAVES;
    for (int it = gw; it < 64; it += NGW) mod_item(a, it, cact, F.lane);
    {
        float va[32];
        for (int r = gw; r < CI0; r += NGW) { const TrItem q = conv_desc(a, r); tr_load(q, F.lane, va); tr_store(q, F.lane, va, scr); }
    }
    for (int idx = F.vcu * NTHR + F.tid; idx < 2 * 28672; idx += F.G * NTHR) { const int j = idx / 28672, o = idx - j * 28672;
        ((u32x4*)((bf16_t*)(a->ws + WS_W) + (size_t)j * W_PER_J + W_WIN + (size_t)3104 * D))[o] = (u32x4){0u, 0u, 0u, 0u}; }
}
DI void ph_prologue_b(int wv) {
    const CArgs* a = kargs(); const Frame F = make_frame(wv);
    const f32x4* P = (const f32x4*)(a->ws + WS_MODP); f32x4* M = (f32x4*)(a->ws + WS_MOD); const f32x4* B4 = (const f32x4*)a->in[I_ADAB];
    for (int idx = F.vcu * NTHR + F.tid; idx < 4 * 16 * 1536; idx += F.G * NTHR) { const int i = idx / (16 * 1536), n4 = idx % 1536;
        f32x4 s = B4[i * 1536 + n4];
#pragma unroll
        for (int ks = 0; ks < 8; ++ks) s += P[(size_t)ks * (4 * 16 * 1536) + idx];
        M[idx] = s; }
    for (int idx = F.vcu * NTHR + F.tid; idx < 2 * D; idx += F.G * NTHR) ((float*)(a->ws + WS_SP))[idx] = log1p_exp_neg(a->in[I_LAP][idx]);
}

template <bool SB> DI void ld_src(const float* src, const bf16_t* xsb, int r, int lane, u32x4 (&raw)[4]) {
    if constexpr (SB) { const u32x2* xr = (const u32x2*)(xsb + (size_t)r * D) + lane;
#pragma unroll
        for (int j = 0; j < 4; ++j) { const u32x2 t = __builtin_nontemporal_load(xr + 64 * j); raw[j].x = t.x; raw[j].y = t.y; } }
    else { const u32x4* xr = (const u32x4*)(src + (size_t)r * D) + lane;
#pragma unroll
        for (int j = 0; j < 4; ++j) raw[j] = __builtin_nontemporal_load(xr + 64 * j); }
}
template <int MODE, bool SB>
DI void row_pass(int wv, int srcsel, int ngsel, int layer, int sub, int jl, int addm) {
    const CArgs* a = kargs(); const Frame F = make_frame(wv); asm volatile("" : "+s"(layer), "+s"(jl));
    (void)srcsel; const float* src = a->in[I_X]; bf16_t* XSB = (bf16_t*)(a->ws + WS_R + R_XSB); const float* ngain = ngsel < 0 ? a->in[I_FNG] : a->in[I_NORMG] + (size_t)ngsel * D;
    float* XS = a->out; bf16_t* HN = (bf16_t*)(a->ws + WS_HN); const bf16_t* M1 = (const bf16_t*)(a->ws + WS_R + R_M1); asm volatile("" : "+s"(addm));
    const int gw = F.vcu * NWAVES + F.wave, lane = F.lane;
    LAS float* rw = (LAS float*)F.lds;
    if (MODE == 1) { const float* RW = a->in[I_RW] + (size_t)jl * D * NE; for (int idx = F.tid; idx < D * NE; idx += NTHR) { const int d = idx >> 3, e = idx & 7;
            rw[((((d >> 8) * 4 + (d & 3)) * 2 + (e >> 2)) * 64 + ((d & 255) >> 2)) * 4 + (e & 3)] = RW[idx]; }
        __syncthreads(); }
    int cnt0 = 0, cnt1 = 0, cnt2 = 0, cnt3 = 0, cnt4 = 0, cnt5 = 0, cnt6 = 0, cnt7 = 0;
    float rb[8];
    if (MODE == 1) {
#pragma unroll
        for (int e = 0; e < 8; ++e) rb[e] = a->in[I_RB][jl * NE + e]; }
    for (int blk = gw; blk < T / 32; blk += F.G * NWAVES) {
        const int r0 = blk * 32, b = r0 >> 12;
        const float* mod = (const float*)(a->ws + WS_MOD) + ((size_t)layer * 16 + b) * 6144;
        f32x4 CA[4], CB[4], G2[4];
#pragma unroll
        for (int j = 0; j < 4; ++j) { const int c = 256 * j + 4 * lane; const f32x4 g = *(const f32x4*)(ngain + c);
            if (MODE == 3) { CA[j] = g; CB[j] = (f32x4){0.f, 0.f, 0.f, 0.f}; }
            else if (MODE == 0 && layer == 0 && sub == 0) {
                f32x4 sh = *(const f32x4*)(a->in[I_ADAB] + c), sc = *(const f32x4*)(a->in[I_ADAB] + 1024 + c);
#pragma unroll
                for (int ks = 0; ks < 8; ++ks) { const float* pp = (const float*)(a->ws + WS_MODP) + ((size_t)(ks * 4) * 16 + b) * 6144; sh += *(const f32x4*)(pp + c); sc += *(const f32x4*)(pp + 1024 + c); }
                CA[j] = g * (sc + 1.f); CB[j] = sh; }
            else { const f32x4 sh = *(const f32x4*)(mod + sub * 3072 + c), sc = *(const f32x4*)(mod + sub * 3072 + 1024 + c); CA[j] = g * (sc + 1.f); CB[j] = sh; }
            if (MODE >= 2) G2[j] = *(const f32x4*)((const float*)(a->ws + WS_MOD) + ((size_t)(layer - (MODE == 2 ? 1 : 0)) * 16 + b) * 6144 + 5120 + c); }
        u32x4 vA[4], vB[4]; u32x2 mA[4], mB[4], yA0[4], yA1[4]; i32x2 slA = (i32x2){0, 0}, slB = (i32x2){0, 0}; f32x2 twA = (f32x2){0.f, 0.f}, twB = (f32x2){0.f, 0.f};
#pragma unroll
        for (int j = 0; j < 4; ++j) { mA[j] = mB[j] = yA0[j] = yA1[j] = (u32x2){0u, 0u}; vA[j] = vB[j] = (u32x4){0u, 0u, 0u, 0u}; }
        const bf16_t* YS = (const bf16_t*)(a->ws + WS_R + R_YS);
#define RP_LD_SL(r, SL, TW) { if (MODE >= 2) { SL = ((const i32x2*)(a->ws + WS_TOKSLOT))[r]; TW = ((const f32x2*)(a->ws + WS_TOPW))[r]; } }
#define RP_LD_YS(SL) { if (MODE >= 2) { const u32x2* y0 = (const u32x2*)(YS + (size_t)(SL).x * D) + lane; const u32x2* y1 = (const u32x2*)(YS + (size_t)(SL).y * D) + lane; \
            _Pragma("unroll") for (int j = 0; j < 4; ++j) { yA0[j] = y0[64 * j]; yA1[j] = y1[64 * j]; } } }
#define RP_LD_VM(r, V, M) { ld_src<SB>(src, XSB, r, lane, V); if (addm) { const u32x2* mr = (const u32x2*)(M1 + (size_t)(r) * D) + lane; \
            _Pragma("unroll") for (int j = 0; j < 4; ++j) M[j] = __builtin_nontemporal_load(mr + 64 * j); } }
        RP_LD_SL(r0, slA, twA); RP_LD_SL(r0 + 1, slB, twB); RP_LD_YS(slA); RP_LD_VM(r0, vA, mA); RP_LD_VM(r0 + 1, vB, mB);
        for (int rr = 0; rr < 32; ++rr) {
            const int row = r0 + rr;
            f32x4 v[4]; u32x2 yc0[4], yc1[4];
#pragma unroll
            for (int j = 0; j < 4; ++j) { const u32x4 rw_ = vA[j]; if constexpr (SB) v[j] = (f32x4){bflo(rw_.x), bfhi(rw_.x), bflo(rw_.y), bfhi(rw_.y)}; else v[j] = __builtin_bit_cast(f32x4, rw_);
                const u32x2 mw = mA[j]; v[j] += (f32x4){bflo(mw.x), bfhi(mw.x), bflo(mw.y), bfhi(mw.y)};
                yc0[j] = yA0[j]; yc1[j] = yA1[j]; }
            const f32x2 tw = twA;
            {
#pragma unroll
                for (int j = 0; j < 4; ++j) { vA[j] = vB[j]; mA[j] = mB[j]; }
                slA = slB; twA = twB;
                const int r2 = r0 + ((rr + 2 < 32) ? rr + 2 : 31);
                RP_LD_SL(r2, slB, twB); RP_LD_YS(slA); RP_LD_VM(r2, vB, mB);
            }
            if (MODE >= 2) {
#pragma unroll
                for (int j = 0; j < 4; ++j) { const u32x2 p = yc0[j], q = yc1[j];
                    f32x4 m; m[0] = tw.x * bflo(p.x) + tw.y * bflo(q.x); m[1] = tw.x * bfhi(p.x) + tw.y * bfhi(q.x); m[2] = tw.x * bflo(p.y) + tw.y * bflo(q.y); m[3] = tw.x * bfhi(p.y) + tw.y * bfhi(q.y);
                    v[j] += G2[j] * m; }
                if (MODE == 2) {
#pragma unroll
                    for (int j = 0; j < 4; ++j) { u32x2 w; w.x = pk2(v[j][0], v[j][1]); w.y = pk2(v[j][2], v[j][3]); ((u32x2*)(XSB + (size_t)row * D) + lane)[64 * j] = w; } }
            }
#undef RP_LD_SL
#undef RP_LD_YS
#undef RP_LD_VM
            float ss = 0.f;
#pragma unroll
            for (int j = 0; j < 4; ++j) ss += (v[j][0] * v[j][0] + v[j][1] * v[j][1]) + (v[j][2] * v[j][2] + v[j][3] * v[j][3]);
            const float rstd = __builtin_amdgcn_rsqf(wave_sum(ss) * (1.f / D) + RMS_EPS);
            f32x4 y[4];
#pragma unroll
            for (int j = 0; j < 4; ++j) y[j] = v[j] * rstd * CA[j] + CB[j];
            if (MODE == 3) {
#pragma unroll
                for (int j = 0; j < 4; ++j) ((f32x4*)(XS + (size_t)row * D) + lane)[64 * j] = y[j];
            } else if ((MODE == 0 && sub == 1 && DENSE_FP8_AT(jl)) || MODE == 1) {
                unsigned* o4 = (unsigned*)((unsigned char*)HN + (size_t)row * D) + lane;
#pragma unroll
                for (int j = 0; j < 4; ++j) o4[64 * j] = pg8::pk4_fp8(y[j][0] * pg8::HN_SCALE, y[j][1] * pg8::HN_SCALE, y[j][2] * pg8::HN_SCALE, y[j][3] * pg8::HN_SCALE);
            } else {
                u32x2* o8 = (u32x2*)(HN + (size_t)row * D) + lane;
#pragma unroll
                for (int j = 0; j < 4; ++j) { u32x2 w; w.x = pk2(y[j][0], y[j][1]); w.y = pk2(y[j][2], y[j][3]); o8[64 * j] = w; }
            }
            if (MODE == 1) {
                float lg[8];
#pragma unroll
                for (int e = 0; e < 8; ++e) lg[e] = 0.f;
#pragma unroll
                for (int j = 0; j < 4; ++j)
#pragma unroll
                    for (int q = 0; q < 4; ++q) { const LAS float* wp = rw + (((j * 4 + q) * 2) * 64 + lane) * 4; const f32x4 w0 = *(const LAS f32x4*)(wp), w1 = *(const LAS f32x4*)(wp + 256); const float yv = y[j][q];
                        lg[0] += yv * w0[0]; lg[1] += yv * w0[1]; lg[2] += yv * w0[2]; lg[3] += yv * w0[3]; lg[4] += yv * w1[0]; lg[5] += yv * w1[1]; lg[6] += yv * w1[2]; lg[7] += yv * w1[3];
                        if (q == 3) asm volatile("" ::: "memory"); }
#pragma unroll
                for (int e = 0; e < 8; ++e) lg[e] = wave_sum(lg[e]) + rb[e];
                int e0 = 0; float l0 = lg[0];
#pragma unroll
                for (int e = 1; e < 8; ++e) if (lg[e] > l0) { l0 = lg[e]; e0 = e; }
                int e1 = -1; float l1 = -3.0e38f;
#pragma unroll
                for (int e = 0; e < 8; ++e) if (e != e0 && lg[e] > l1) { l1 = lg[e]; e1 = e; }
                const float w0 = __builtin_amdgcn_rcpf(1.f + __expf(l1 - l0)), w1 = 1.f - w0;
                if (lane == 0) { ((int*)(a->ws + WS_TOPE))[row] = e0 | (e1 << 8); ((f32x2*)(a->ws + WS_TOPW))[row] = (f32x2){w0, w1}; }
                cnt0 += (e0 == 0) + (e1 == 0); cnt1 += (e0 == 1) + (e1 == 1); cnt2 += (e0 == 2) + (e1 == 2); cnt3 += (e0 == 3) + (e1 == 3);
                cnt4 += (e0 == 4) + (e1 == 4); cnt5 += (e0 == 5) + (e1 == 5); cnt6 += (e0 == 6) + (e1 == 6); cnt7 += (e0 == 7) + (e1 == 7);
            }
        }
        if (MODE == 1) {
            const int cv = lane == 0 ? cnt0 : lane == 1 ? cnt1 : lane == 2 ? cnt2 : lane == 3 ? cnt3 : lane == 4 ? cnt4 : lane == 5 ? cnt5 : lane == 6 ? cnt6 : cnt7;
            if (lane < 8) ((int*)(a->ws + WS_HIST))[blk * 8 + lane] = cv;
            cnt0 = cnt1 = cnt2 = cnt3 = cnt4 = cnt5 = cnt6 = cnt7 = 0;
        }
    }
}

DI void ph_lru_tables(int wv, int jl) {
    const CArgs* a = kargs(); const Frame F = make_frame(wv); asm volatile("" : "+s"(jl));
    const float* MODL = (const float*)(a->ws + WS_MOD) + (size_t)(2 * jl + 1) * 16 * 6144;
    for (int idx = F.vcu * NTHR + F.tid; idx < 16 * D; idx += F.G * NTHR) { const int col = idx & (D - 1), b = idx >> 10;
        ((float*)(a->ws + WS_CA1))[(size_t)jl * 16 * D + idx] = a->in[I_NORMG][(size_t)((2 * jl + 1) * 2) * D + col] * (1.f + MODL[(size_t)b * 6144 + 1024 + col]); }
    LAS float* shl = (LAS float*)(F.lds + F.wave * 8192);
    for (int it = F.vcu * NWAVES + F.wave; it < 64; it += F.G * NWAVES) { const int ks = it & 7, cg = it >> 3, lane = F.lane;
        const float* W = a->in[I_LWIN] + (size_t)jl * D * 2 * D + (size_t)(ks * 128) * (2 * D) + cg * 256 + lane * 4;
        for (int idx = lane; idx < 16 * 128; idx += 64) shl[idx] = MODL[(size_t)(idx >> 7) * 6144 + ks * 128 + (idx & 127)];
        LDS_WAIT(); asm volatile("" ::: "memory");
        f32x4 acc[16];
#pragma unroll
        for (int b = 0; b < 16; ++b) acc[b] = (f32x4){0.f, 0.f, 0.f, 0.f};
        for (int k0 = 0; k0 < 128; k0 += 16) { f32x4 w4[16];
#pragma unroll
            for (int kk = 0; kk < 16; ++kk) w4[kk] = *(const f32x4*)(W + (size_t)(k0 + kk) * (2 * D));
#pragma unroll
            for (int kk = 0; kk < 16; ++kk)
#pragma unroll
                for (int b = 0; b < 16; ++b) acc[b] += w4[kk] * shl[b * 128 + k0 + kk]; }
        float* o = (float*)(a->ws + WS_BIASP) + ((size_t)(jl * 8 + ks) * 16) * 2048 + cg * 256 + lane * 4;
#pragma unroll
        for (int b = 0; b < 16; ++b) *(f32x4*)(o + (size_t)b * 2048) = acc[b];
        LDS_WAIT(); asm volatile("" ::: "memory"); }
}
DI void ph_slots(int wv) {
    const CArgs* a = kargs(); const Frame F = make_frame(wv);
    LAS int* H = (LAS int*)F.lds;
    const int* HIST = (const int*)(a->ws + WS_HIST);
    for (int idx = F.tid; idx < 2048 * 8; idx += NTHR) H[idx] = HIST[idx];
    __syncthreads();
    const int lane = F.lane;
    int* SLOTTOK = (int*)(a->ws + WS_SLOTTOK); i32x2* TOKSLOT = (i32x2*)(a->ws + WS_TOKSLOT); const int* TOPE = (const int*)(a->ws + WS_TOPE);
    for (int blk = F.vcu * NWAVES + F.wave; blk < T / 32; blk += F.G * NWAVES) {
        int tot[8], pre[8];
#pragma unroll
        for (int e = 0; e < 8; ++e) { tot[e] = 0; pre[e] = 0; }
#pragma unroll 2
        for (int bb = lane; bb < 2048; bb += 64) { const LAS int* hp = H + ((bb * 8) ^ ((bb >> 2) & 4) * 0);
            typedef int i32x4 __attribute__((ext_vector_type(4)));
            const i32x4 h0 = *(const LAS i32x4*)(hp), h1 = *(const LAS i32x4*)(hp + 4); const bool lt = bb < blk;
            tot[0] += h0[0]; tot[1] += h0[1]; tot[2] += h0[2]; tot[3] += h0[3]; tot[4] += h1[0]; tot[5] += h1[1]; tot[6] += h1[2]; tot[7] += h1[3];
            pre[0] += lt ? h0[0] : 0; pre[1] += lt ? h0[1] : 0; pre[2] += lt ? h0[2] : 0; pre[3] += lt ? h0[3] : 0; pre[4] += lt ? h1[0] : 0; pre[5] += lt ? h1[1] : 0; pre[6] += lt ? h1[2] : 0; pre[7] += lt ? h1[3] : 0;
            asm volatile("" ::: "memory"); }
#pragma unroll
        for (int e = 0; e < 8; ++e) { tot[e] = wave_sum_i(tot[e]); pre[e] = wave_sum_i(pre[e]); }
        int sb[8]; int ts = 0;
#pragma unroll
        for (int e = 0; e < 8; ++e) { sb[e] = ts * 256; ts += (tot[e] + 255) >> 8; }
        const int row = blk * 32 + (lane & 31);
        int e0 = 255, e1 = 255;
        if (lane < 32) { const int pe = TOPE[row]; e0 = pe & 255; e1 = (pe >> 8) & 255; }
        int s0 = 0, s1 = 0;
        const unsigned long long below = (1ull << lane) - 1ull;
#pragma unroll
        for (int e = 0; e < 8; ++e) { const unsigned long long m = __ballot(e0 == e || e1 == e); const int rank = __popcll(m & below);
            if (e0 == e) s0 = sb[e] + pre[e] + rank; if (e1 == e) s1 = sb[e] + pre[e] + rank; }
        if (lane < 32) { SLOTTOK[s0] = row; SLOTTOK[s1] = row; TOKSLOT[row] = (i32x2){s0, s1}; }
        if (blk < 8) {
            int sbe = 0, tote = 0;
#pragma unroll
            for (int e = 0; e < 8; ++e) if (e == blk) { sbe = sb[e]; tote = tot[e]; }
            const int end = sbe + (((tote + 255) >> 8) << 8);
            for (int s = sbe + tote + lane; s < end; s += 64) SLOTTOK[s] = 0;
        }
        if (blk == 0 && lane == 0) { unsigned* META = (unsigned*)(a->ws + WS_CTL) + CW_META; int t2 = 0;
#pragma unroll
            for (int e = 0; e < 8; ++e) { META[1 + e] = (unsigned)t2; t2 += (tot[e] + 255) >> 8; }
            META[9] = (unsigned)t2; META[0] = (unsigned)t2; }
    }
}

DI bf16x8 gather8(const LAS bf16_t* p, int stride) {
    u32x4 w;
#pragma unroll
    for (int q = 0; q < 4; ++q) w[q] = (unsigned)p[(2 * q) * stride] | ((unsigned)p[(2 * q + 1) * stride] << 16);
    return __builtin_bit_cast(bf16x8, w);
}
#define CHAIN_BAR() do { asm volatile("s_waitcnt lgkmcnt(0)" ::: "memory"); __builtin_amdgcn_s_barrier(); asm volatile("" ::: "memory"); } while (0)
DI void tr_frag10(unsigned ak, unsigned av, bf16x8 (&fk)[2], bf16x8 (&fv)[4][2]) {
    u32x2 r[20];
    asm volatile("ds_read_b64_tr_b16 %0, %20\n\tds_read_b64_tr_b16 %1, %20 offset:576\n\tds_read_b64_tr_b16 %2, %20 offset:4608\n\tds_read_b64_tr_b16 %3, %20 offset:5184\n\t"
                 "ds_read_b64_tr_b16 %4, %21\n\tds_read_b64_tr_b16 %5, %21 offset:1088\n\tds_read_b64_tr_b16 %6, %21 offset:8704\n\tds_read_b64_tr_b16 %7, %21 offset:9792\n\t"
                 "ds_read_b64_tr_b16 %8, %21 offset:32\n\tds_read_b64_tr_b16 %9, %21 offset:1120\n\tds_read_b64_tr_b16 %10, %21 offset:8736\n\tds_read_b64_tr_b16 %11, %21 offset:9824\n\t"
                 "ds_read_b64_tr_b16 %12, %21 offset:64\n\tds_read_b64_tr_b16 %13, %21 offset:1152\n\tds_read_b64_tr_b16 %14, %21 offset:8768\n\tds_read_b64_tr_b16 %15, %21 offset:9856\n\t"
                 "ds_read_b64_tr_b16 %16, %21 offset:96\n\tds_read_b64_tr_b16 %17, %21 offset:1184\n\tds_read_b64_tr_b16 %18, %21 offset:8800\n\tds_read_b64_tr_b16 %19, %21 offset:9888\n\ts_waitcnt lgkmcnt(0)"
                 : "=&v"(r[0]), "=&v"(r[1]), "=&v"(r[2]), "=&v"(r[3]), "=&v"(r[4]), "=&v"(r[5]), "=&v"(r[6]), "=&v"(r[7]), "=&v"(r[8]), "=&v"(r[9]),
                   "=&v"(r[10]), "=&v"(r[11]), "=&v"(r[12]), "=&v"(r[13]), "=&v"(r[14]), "=&v"(r[15]), "=&v"(r[16]), "=&v"(r[17]), "=&v"(r[18]), "=&v"(r[19])
                 : "v"(ak), "v"(av) : "memory");
#define TRCAT(i) __builtin_bit_cast(bf16x8, (u32x4){r[i].x, r[i].y, r[(i) + 1].x, r[(i) + 1].y})
    fk[0] = TRCAT(0); fk[1] = TRCAT(2);
    fv[0][0] = TRCAT(4); fv[0][1] = TRCAT(6); fv[1][0] = TRCAT(8); fv[1][1] = TRCAT(10); fv[2][0] = TRCAT(12); fv[2][1] = TRCAT(14); fv[3][0] = TRCAT(16); fv[3][1] = TRCAT(18);
#undef TRCAT
}
DI void tr_frag2(unsigned a0, unsigned rs, bf16x8& f0, bf16x8& f1) {
    u32x2 r0, r1, r2, r3; const unsigned a1 = a0 + 4u * rs, a2 = a0 + 32u * rs, a3 = a0 + 36u * rs;
    asm volatile("ds_read_b64_tr_b16 %0, %4\n\tds_read_b64_tr_b16 %1, %5\n\tds_read_b64_tr_b16 %2, %6\n\tds_read_b64_tr_b16 %3, %7\n\ts_waitcnt lgkmcnt(0)"
                 : "=&v"(r0), "=&v"(r1), "=&v"(r2), "=&v"(r3) : "v"(a0), "v"(a1), "v"(a2), "v"(a3) : "memory");
    u32x4 w0, w1; w0.x = r0.x; w0.y = r0.y; w0.z = r1.x; w0.w = r1.y; w1.x = r2.x; w1.y = r2.y; w1.z = r3.x; w1.w = r3.y;
    f0 = __builtin_bit_cast(bf16x8, w0); f1 = __builtin_bit_cast(bf16x8, w1);
}
DI void ph_moe_convert(int wv, int jl) {
    const CArgs* a = kargs(); const Frame F = make_frame(wv); asm volatile("" : "+s"(jl));
    LAS float* scr = (LAS float*)(F.lds + F.wave * 8448);
    const int nw = ((int)gridDim.x - BATCH * ML_H) * NWAVES;
    const int cw0 = ((int)blockIdx.x - BATCH * ML_H) * NWAVES + F.wave;
    if (jl == 0) {
        LAS float* cact = (LAS float*)(F.lds + 8 * 8448);
        for (int idx = F.tid; idx < 16 * D; idx += NTHR) { const float c = a->in[I_C][idx]; cact[idx] = c * sigmoid_f(c); }
        __syncthreads();
        if (F.wave == 0 && (int)blockIdx.x - BATCH * ML_H < 96) mod_item_full(a, (int)blockIdx.x - BATCH * ML_H, cact, F.lane);
        for (int idx = cw0 * 64 + F.lane; idx < 2 * D; idx += nw * 64) ((float*)(a->ws + WS_SP))[idx] = log1p_exp_neg(a->in[I_LAP][idx]);
    }
    const int first = jl == 0 ? CI0 : CI_PER_J + CI0, end = jl == 0 ? CI_PER_J + CI0 : 2 * CI_PER_J;
    if (jl == 0) { if (F.wave != 0) conv_stream(a, first + ((int)blockIdx.x - BATCH * ML_H) * (NWAVES - 1) + F.wave - 1, ((int)gridDim.x - BATCH * ML_H) * (NWAVES - 1), end, scr, F.lane); }
    else conv_stream(a, first + cw0, nw, end, scr, F.lane);
}
DI float dpp_f(float v, int ctrl_sel) {
    const int x = __builtin_bit_cast(int, v); int r;
    if (ctrl_sel == 0) r = __builtin_amdgcn_update_dpp(x, x, 0xB1, 0xf, 0xf, true); else if (ctrl_sel == 1) r = __builtin_amdgcn_update_dpp(x, x, 0x4E, 0xf, 0xf, true);
    else if (ctrl_sel == 2) r = __builtin_amdgcn_update_dpp(x, x, 0x141, 0xf, 0xf, true); else r = __builtin_amdgcn_update_dpp(x, x, 0x140, 0xf, 0xf, true);
    return __builtin_bit_cast(float, r); }
DI float row16_sum(float p) { p += dpp_f(p, 0); p += dpp_f(p, 1); p += dpp_f(p, 2); p += dpp_f(p, 3); return p; }
DI unsigned cvtpk(float lo, float hi) { unsigned r; asm("v_cvt_pk_bf16_f32 %0, %1, %2" : "=v"(r) : "v"(lo), "v"(hi)); return r; }
DI void ph_mlstm(int wv, int jl) {
    const CArgs* a = kargs(); const Frame F = make_frame(wv); asm volatile("" : "+s"(jl));
    const int chain = blockIdx.x, b = chain >> 3, h = chain & 7;
    const int tid = F.tid, lane = F.lane, w = F.wave, fr = lane & 15, fq = lane >> 4;
    LAS bf16_t* Qs = (LAS bf16_t*)(F.lds);
    LAS bf16_t* Ks = (LAS bf16_t*)(F.lds + 9216);
    LAS bf16_t* Vs = (LAS bf16_t*)(F.lds + 18432);
    LAS bf16_t* Sp = (LAS bf16_t*)(F.lds + 35840);
    LAS bf16_t* CT = (LAS bf16_t*)(F.lds + 45056);
    LAS bf16_t* Hs = (LAS bf16_t*)(F.lds + 63488);
    LAS float* nvec = (LAS float*)(F.lds + 80896);
    LAS float* rss = nvec + 64;
    LAS float* npart = nvec + 192;
    LAS float* GA = (LAS float*)(F.lds + 86016);
    LAS float* GB = GA + 4096;
    LAS float* GP = GA + 8192;
    LAS float* MR = GA + 12288;
    const bf16_t* Qg = (const bf16_t*)(a->ws + WS_R + R_Q) + (size_t)b * SEQ * 512 + h * 64;
    const bf16_t* Kg = (const bf16_t*)(a->ws + WS_R + R_K) + (size_t)b * SEQ * 512 + h * 64;
    const bf16_t* Vg = (const bf16_t*)(a->ws + WS_R + R_V) + (size_t)b * SEQ * 1024 + h * 128;
    const bf16_t* Og = (const bf16_t*)(a->ws + WS_R + R_O) + (size_t)b * SEQ * 1024 + h * 128;
    bf16_t* Hg = (bf16_t*)(a->ws + WS_R + R_HS) + (size_t)b * SEQ * 1024 + h * 128;
    const float* Gg = (const float*)(a->ws + WS_GATES) + (size_t)b * SEQ * 16 + h;
    const int qrow = tid >> 3, qch = tid & 7;
    u32x4 qreg, kreg, vreg[2], oreg[2], qN, kN, vN[2];
    qreg = *(const u32x4*)(Qg + (size_t)qrow * 512 + qch * 8); kreg = *(const u32x4*)(Kg + (size_t)qrow * 512 + qch * 8);
    qN = *(const u32x4*)(Qg + (size_t)(CHK + qrow) * 512 + qch * 8); kN = *(const u32x4*)(Kg + (size_t)(CHK + qrow) * 512 + qch * 8);
#pragma unroll
    for (int i = 0; i < 2; ++i) { const int id = tid + 512 * i; vreg[i] = *(const u32x4*)(Vg + (size_t)(id >> 4) * 1024 + (id & 15) * 8); oreg[i] = (u32x4){0u, 0u, 0u, 0u};
        vN[i] = *(const u32x4*)(Vg + (size_t)(CHK + (id >> 4)) * 1024 + (id & 15) * 8); }
    for (int idx = tid; idx < 128 * 72 / 2; idx += NTHR) ((LAS unsigned*)CT)[idx] = 0u;
    if (tid < 64) nvec[tid] = 0.f;
    for (int cc = 0; cc < 8; ++cc) { const int c = 8 * w + cc; const float gi = Gg[(size_t)(c * CHK + lane) * 16], gf = Gg[(size_t)(c * CHK + lane) * 16 + 8];
        float bsum = gf;
#pragma unroll
        for (int o = 1; o < 64; o <<= 1) { const float t = __shfl_up(bsum, o); if (lane >= o) bsum += t; }
        const float av = gi - bsum; float pm = av;
#pragma unroll
        for (int o = 1; o < 64; o <<= 1) { const float t = __shfl_up(pm, o); if (lane >= o) pm = fmaxf(pm, t); }
        GA[c * 64 + lane] = av; GB[c * 64 + lane] = bsum; GP[c * 64 + lane] = pm; }
    __syncthreads();
    if (tid == 0) { float m = 0.f; MR[0] = 0.f; for (int c = 0; c < 64; ++c) { m = GB[c * 64 + 63] + fmaxf(m, GP[c * 64 + 63]); MR[c + 1] = m; } }
    const int ti = w >> 1, vi0 = 4 * (w & 1);
    const int trq = (lane & 15) >> 2, trp = lane & 3;
    const unsigned vs_tr = (unsigned)(size_t)Vs + (unsigned)(((8 * fq + trq) * 136 + 16 * vi0 + 4 * trp) * 2);
    const unsigned ks_tr = (unsigned)(size_t)Ks + (unsigned)(((8 * fq + trq) * 72 + 16 * ti + 4 * trp) * 2);
    float hg[4];
#pragma unroll
    for (int x = 0; x < 4; ++x) hg[x] = a->in[I_MLHG][(size_t)jl * 1024 + h * 128 + 16 * (vi0 + x) + fr];
    f32x4 Cacc[4];
#pragma unroll
    for (int x = 0; x < 4; ++x) Cacc[x] = (f32x4){0.f, 0.f, 0.f, 0.f};
    __syncthreads();
    for (int c = 0; c <= SEQ / CHK; ++c) {
        const int r0 = c * CHK;
        if (c < SEQ / CHK) {
            *(LAS u32x4*)(Qs + qrow * 72 + qch * 8) = qreg; *(LAS u32x4*)(Ks + qrow * 72 + qch * 8) = kreg;
#pragma unroll
            for (int i = 0; i < 2; ++i) { const int id = tid + 512 * i; *(LAS u32x4*)(Vs + (id >> 4) * 136 + (id & 15) * 8) = vreg[i]; }
            if (w == 0 && c > 0) { const float mp = MR[c - 1]; float n = nvec[lane] * __expf(mp - fmaxf(mp, GP[(c - 1) * 64 + 63]));
#pragma unroll
                for (int sp = 0; sp < 8; ++sp) n += npart[sp * 64 + lane];
                nvec[lane] = n; }
            CHAIN_BAR();
            {
                const int si = w >> 1; const float mr = MR[c];
                bf16x8 ak[2];
#pragma unroll
                for (int kk = 0; kk < 2; ++kk) ak[kk] = *(const LAS bf16x8*)(Ks + (16 * si + fr) * 72 + 32 * kk + 8 * fq);
                const f32x4 a4 = *(const LAS f32x4*)(GA + c * 64 + 16 * si + 4 * fq);
#pragma unroll
                for (int tt = 0; tt < 2; ++tt) { const int tj = 2 * (w & 1) + tt;
                    f32x4 s4 = (f32x4){0.f, 0.f, 0.f, 0.f};
#pragma unroll
                    for (int kk = 0; kk < 2; ++kk) { const bf16x8 bq = *(const LAS bf16x8*)(Qs + (16 * tj + fr) * 72 + 32 * kk + 8 * fq); s4 = __builtin_amdgcn_mfma_f32_16x16x32_bf16(ak[kk], bq, s4, 0, 0, 0); }
                    const int t = 16 * tj + fr; const float Mt = fmaxf(mr, GP[c * 64 + t]); float vv[4];
#pragma unroll
                    for (int r = 0; r < 4; ++r) { const int s = 16 * si + 4 * fq + r; vv[r] = (s <= t) ? s4[r] * __expf(a4[r] - Mt) : 0.f; }
                    u32x2 pw; pw.x = cvtpk(vv[0], vv[1]); pw.y = cvtpk(vv[2], vv[3]);
                    *(LAS u32x2*)(Sp + t * 72 + 16 * si + 4 * fq) = pw; }
            }
            CHAIN_BAR();
        }
        else CHAIN_BAR();
        if (c > 0) {
#pragma unroll
            for (int i = 0; i < 2; ++i) { const int id = tid + 512 * i, row = id >> 4, ch = id & 15;
                const u32x4 hs = *(const LAS u32x4*)(Hs + row * 136 + ch * 8); u32x4 o;
#pragma unroll
                for (int q = 0; q < 4; ++q) o[q] = cvtpk(bflo(hs[q]) * bflo(oreg[i][q]), bfhi(hs[q]) * bfhi(oreg[i][q]));
                *(u32x4*)(Hg + (size_t)(r0 - CHK + row) * 1024 + ch * 8) = o; }
        }
        if (c == SEQ / CHK) break;
        {
            const int rn = (c + 2 < SEQ / CHK) ? r0 + 2 * CHK : r0;
            qreg = qN; kreg = kN; vreg[0] = vN[0]; vreg[1] = vN[1];
            qN = *(const u32x4*)(Qg + (size_t)(rn + qrow) * 512 + qch * 8); kN = *(const u32x4*)(Kg + (size_t)(rn + qrow) * 512 + qch * 8);
#pragma unroll
            for (int i = 0; i < 2; ++i) { const int id = tid + 512 * i; vN[i] = *(const u32x4*)(Vg + (size_t)(rn + (id >> 4)) * 1024 + (id & 15) * 8);
                oreg[i] = *(const u32x4*)(Og + (size_t)(r0 + (id >> 4)) * 1024 + (id & 15) * 8); }
        }
        float hv[4][4];
        {
            const float mr = MR[c]; const float M63 = fmaxf(mr, GP[c * 64 + 63]); const float decay = __expf(mr - M63);
            float den[4], et[4], enm[4];
            {
                const f32x4 n4 = *(const LAS f32x4*)(nvec + 4 * fr);
                const f32x4 p4 = *(const LAS f32x4*)(GP + c * 64 + 16 * ti + 4 * fq), b4 = *(const LAS f32x4*)(GB + c * 64 + 16 * ti + 4 * fq);
#pragma unroll
                for (int r = 0; r < 4; ++r) { const int t = 16 * ti + 4 * fq + r;
                    const u32x2 sp = *(const LAS u32x2*)(Sp + t * 72 + 4 * fr), qq = *(const LAS u32x2*)(Qs + t * 72 + 4 * fr);
                    const float ssum = (bflo(sp.x) + bfhi(sp.x)) + (bflo(sp.y) + bfhi(sp.y));
                    const float qn = (bflo(qq.x) * n4[0] + bfhi(qq.x) * n4[1]) + (bflo(qq.y) * n4[2] + bfhi(qq.y) * n4[3]);
                    const float Mt = fmaxf(mr, p4[r]); et[r] = __expf(mr - Mt); enm[r] = __expf(-(b4[r] + Mt));
                    float p = ssum + et[r] * qn;
                    p = row16_sum(p);
                    den[r] = __builtin_amdgcn_rcpf(fmaxf(fabsf(p), enm[r])); }
            }
            bf16x8 as_[2], aq[2], akw[2], kf[2], bVall[4][2];
            tr_frag10(ks_tr, vs_tr, kf, bVall);
#pragma unroll
            for (int kk = 0; kk < 2; ++kk) { as_[kk] = *(const LAS bf16x8*)(Sp + (16 * ti + fr) * 72 + 32 * kk + 8 * fq); aq[kk] = *(const LAS bf16x8*)(Qs + (16 * ti + fr) * 72 + 32 * kk + 8 * fq); }
            {
                const bf16x8 k0 = kf[0], k1 = kf[1];
#pragma unroll
                for (int kk = 0; kk < 2; ++kk) { const u32x4 kw = __builtin_bit_cast(u32x4, kk ? k1 : k0);
                    const f32x4 a0 = *(const LAS f32x4*)(GA + c * 64 + 32 * kk + 8 * fq), a1 = *(const LAS f32x4*)(GA + c * 64 + 32 * kk + 8 * fq + 4);
                    u32x4 pk; pk.x = cvtpk(bflo(kw.x) * __expf(a0[0] - M63), bfhi(kw.x) * __expf(a0[1] - M63)); pk.y = cvtpk(bflo(kw.y) * __expf(a0[2] - M63), bfhi(kw.y) * __expf(a0[3] - M63));
                    pk.z = cvtpk(bflo(kw.z) * __expf(a1[0] - M63), bfhi(kw.z) * __expf(a1[1] - M63)); pk.w = cvtpk(bflo(kw.w) * __expf(a1[2] - M63), bfhi(kw.w) * __expf(a1[3] - M63));
                    akw[kk] = __builtin_bit_cast(bf16x8, pk); }
            }
            float ssq[4] = {0.f, 0.f, 0.f, 0.f};
#pragma unroll
            for (int x = 0; x < 4; ++x) { const int vi = vi0 + x;
                bf16x8 bV[2], bC[2]; bV[0] = bVall[x][0]; bV[1] = bVall[x][1];
#pragma unroll
                for (int kk = 0; kk < 2; ++kk) bC[kk] = *(const LAS bf16x8*)(CT + (16 * vi + fr) * 72 + 32 * kk + 8 * fq);
                f32x4 a1 = (f32x4){0.f, 0.f, 0.f, 0.f}, a2 = (f32x4){0.f, 0.f, 0.f, 0.f};
                a1 = __builtin_amdgcn_mfma_f32_16x16x32_bf16(as_[0], bV[0], a1, 0, 0, 0); a1 = __builtin_amdgcn_mfma_f32_16x16x32_bf16(as_[1], bV[1], a1, 0, 0, 0);
                a2 = __builtin_amdgcn_mfma_f32_16x16x32_bf16(aq[0], bC[0], a2, 0, 0, 0); a2 = __builtin_amdgcn_mfma_f32_16x16x32_bf16(aq[1], bC[1], a2, 0, 0, 0);
                Cacc[x] = Cacc[x] * decay;
                Cacc[x] = __builtin_amdgcn_mfma_f32_16x16x32_bf16(akw[0], bV[0], Cacc[x], 0, 0, 0); Cacc[x] = __builtin_amdgcn_mfma_f32_16x16x32_bf16(akw[1], bV[1], Cacc[x], 0, 0, 0);
#pragma unroll
                for (int r = 0; r < 4; ++r) { const float hh = (a1[r] + et[r] * a2[r]) * den[r]; hv[x][r] = hh; ssq[r] += hh * hh; } }
#pragma unroll
            for (int r = 0; r < 4; ++r) { const float p = row16_sum(ssq[r]);
                if (fr == 0) rss[(16 * ti + 4 * fq + r) * 2 + (w & 1)] = p; }
            { float pn = 0.f; const int d = tid & 63; const f32x4 a0 = *(const LAS f32x4*)(GA + c * 64 + 8 * w), a1 = *(const LAS f32x4*)(GA + c * 64 + 8 * w + 4);
#pragma unroll
              for (int s = 0; s < 8; ++s) pn += __expf((s < 4 ? a0[s & 3] : a1[s & 3]) - M63) * bf2f(Ks[(8 * w + s) * 72 + d]);
              npart[w * 64 + d] = pn; }
        }
        CHAIN_BAR();
        {
#pragma unroll
            for (int r = 0; r < 4; ++r) { const int t = 16 * ti + 4 * fq + r; const float rstd = __builtin_amdgcn_rsqf((rss[t * 2] + rss[t * 2 + 1]) * (1.f / DV) + RMS_EPS);
#pragma unroll
                for (int x = 0; x < 4; ++x) Hs[t * 136 + 16 * (vi0 + x) + fr] = (bf16_t)f2bf(hv[x][r] * rstd * hg[x]); }
#pragma unroll
            for (int x = 0; x < 4; ++x) { u32x2 pw; pw.x = cvtpk(Cacc[x][0], Cacc[x][1]); pw.y = cvtpk(Cacc[x][2], Cacc[x][3]);
                *(LAS u32x2*)(CT + (16 * (vi0 + x) + fr) * 72 + 16 * ti + 4 * fq) = pw; }
        }
    }
}

DI void ph_conv(int wv, int jl) {
    const CArgs* a = kargs(); const Frame F = make_frame(wv); asm volatile("" : "+s"(jl));
    const bf16_t* XRH = (const bf16_t*)(a->ws + WS_R + R_XR); bf16_t* XC = (bf16_t*)(a->ws + WS_R + R_XC);
    for (int it = F.vcu * NTHR + F.tid; it < (T / 64) * 3 * 128; it += F.G * NTHR) {
        const int chg = it & 127, i = (it >> 7) % 3, blk = it / (3 * 128), c0 = chg * 8;
        const u32x4 z = (u32x4){0u, 0u, 0u, 0u}; u32x4 x[4];
#pragma unroll
        for (int j = 0; j < 4; ++j) { const int rel = i - 3 + j;
            if (rel >= 0) x[j] = *(const u32x4*)(XRH + ((size_t)blk * 6 + rel) * D + c0);
            else if ((blk & 63) == 0) x[j] = z;
            else x[j] = *(const u32x4*)(XRH + ((size_t)(blk - 1) * 6 + 6 + rel) * D + c0); }
        u32x4 o;
#pragma unroll
        for (int q = 0; q < 4; ++q) { float lo = a->in[I_LCB][jl * D + c0 + 2 * q], hi = a->in[I_LCB][jl * D + c0 + 2 * q + 1];
#pragma unroll
            for (int j = 0; j < 4; ++j) { lo += a->in[I_LCW][((size_t)jl * 4 + j) * D + c0 + 2 * q] * bflo(x[j][q]); hi += a->in[I_LCW][((size_t)jl * 4 + j) * D + c0 + 2 * q + 1] * bfhi(x[j][q]); }
            o[q] = pk2(lo, hi); }
        *(u32x4*)(XC + (size_t)(blk * 64 + i) * D + c0) = o;
    }
}
constexpr int SEGL = 128, NSEG = SEQ / SEGL;
DI void ph_scan(int wv) {
    const CArgs* a = kargs(); const Frame F = make_frame(wv);
    const bf16_t* LA = (const bf16_t*)(a->ws + WS_R + R_LA); const bf16_t* U = (const bf16_t*)(a->ws + WS_R + R_U);
    const bf16_t* GB = (const bf16_t*)(a->ws + WS_R + R_GB); bf16_t* Y = (bf16_t*)(a->ws + WS_R + R_XR);
    const f32x4* CAR = (const f32x4*)(a->ws + WS_MODP);
    for (int gid = F.vcu * NTHR + F.tid; gid < BATCH * NSEG * 256; gid += F.G * NTHR) {
        const int c4 = gid & 255, seg = (gid >> 8) & (NSEG - 1), b = gid >> 13;
        const size_t base = ((size_t)b * SEQ + seg * SEGL) * D + 4 * c4;
        f32x4 h = (f32x4){0.f, 0.f, 0.f, 0.f};
#pragma unroll 4
        for (int blk = 0; blk < 2 * seg; ++blk) { const f32x4 p = CAR[((size_t)(b * 64 + blk) * 256 + c4) * 2], q = CAR[((size_t)(b * 64 + blk) * 256 + c4) * 2 + 1];
            h[0] = p[0] * h[0] + p[1]; h[1] = p[2] * h[1] + p[3]; h[2] = q[0] * h[2] + q[1]; h[3] = q[2] * h[3] + q[3]; }
#pragma unroll 8
        for (int r = 0; r < SEGL; ++r) { const u32x2 la = *(const u32x2*)(LA + base + (size_t)r * D), uu = *(const u32x2*)(U + base + (size_t)r * D);
            h[0] = __expf(bflo(la.x)) * h[0] + bflo(uu.x); h[1] = __expf(bfhi(la.x)) * h[1] + bfhi(uu.x); h[2] = __expf(bflo(la.y)) * h[2] + bflo(uu.y); h[3] = __expf(bfhi(la.y)) * h[3] + bfhi(uu.y);
            const u32x2 g = *(const u32x2*)(GB + base + (size_t)r * D); u32x2 o; o.x = pk2(h[0] * bflo(g.x), h[1] * bfhi(g.x)); o.y = pk2(h[2] * bflo(g.y), h[3] * bfhi(g.y));
            *(u32x2*)(Y + base + (size_t)r * D) = o; }
    }
}

#define PH_COMMON(jl) const CArgs* a = kargs(); const Frame F = make_frame(wv); asm volatile("" : "+s"(jl)); unsigned char* ws = a->ws; unsigned char* R = ws + WS_R; \
    const bf16_t* Wj = (const bf16_t*)(ws + WS_W) + (size_t)jl * W_PER_J; const bf16_t* HN = (const bf16_t*)(ws + WS_HN); float* XS = a->out; const float* MOD = (const float*)(ws + WS_MOD); \
    int bx = blockIdx.x; asm volatile("" : "+s"(bx)); (void)R; (void)Wj; (void)HN; (void)XS; (void)MOD
DI void ph_mlstm_gates(int wv, int jl) {
    const CArgs* a = kargs(); const Frame F = make_frame(wv); asm volatile("" : "+s"(jl));
    const bf16_t* HN = (const bf16_t*)(a->ws + WS_HN); float* G = (float*)(a->ws + WS_GATES);
    const bf16_t* Wg = (const bf16_t*)(a->ws + WS_W) + (size_t)jl * W_PER_J + W_WIN + (size_t)3072 * D;
    const int lane = F.lane, fr = lane & 15, fq = lane >> 4;
    { const int row = F.tid >> 5, ch = F.tid & 31;
#pragma unroll
      for (int q = 0; q < 4; ++q) *(LAS u32x4*)(F.lds + row * 2064 + ch * 64 + q * 16) = *(const u32x4*)(Wg + (size_t)row * D + ch * 32 + q * 8); }
    __syncthreads();
    const float bias = a->in[I_MLGB][jl * 16 + fr];
    float ln2s = 0.69314718f; asm volatile("" : "+s"(ln2s));
    const LAS unsigned char* bp = F.lds + fr * 2064 + fq * 16;
    for (int tile = F.vcu; tile < T / 256; tile += F.G) {
        const int R0 = tile * 256 + F.wave * 32;
        const bf16_t* a0 = HN + (size_t)(R0 + fr) * D + fq * 8; const bf16_t* a1 = a0 + (size_t)16 * D;
        f32x4 acc0 = (f32x4){0.f, 0.f, 0.f, 0.f}, acc1 = (f32x4){0.f, 0.f, 0.f, 0.f};
#pragma unroll 8
        for (int s = 0; s < 32; ++s) {
            const bf16x8 af0 = *(const bf16x8*)(a0 + s * 32), af1 = *(const bf16x8*)(a1 + s * 32);
            const bf16x8 bf = *(const LAS bf16x8*)(bp + s * 64);
            acc0 = __builtin_amdgcn_mfma_f32_16x16x32_bf16(af0, bf, acc0, 0, 0, 0); acc1 = __builtin_amdgcn_mfma_f32_16x16x32_bf16(af1, bf, acc1, 0, 0, 0);
        }
#pragma unroll
        for (int r = 0; r < 4; ++r) { float x0 = acc0[r] + bias, x1 = acc1[r] + bias;
            if (fr >= 8) { x0 = fminf(x0, 0.f) - ln2s * __builtin_amdgcn_logf(1.f + __expf(-fabsf(x0))); x1 = fminf(x1, 0.f) - ln2s * __builtin_amdgcn_logf(1.f + __expf(-fabsf(x1))); }
            G[(size_t)(R0 + 4 * fq + r) * 16 + fr] = x0; G[(size_t)(R0 + 16 + 4 * fq + r) * 16 + fr] = x1; }
    }
    __syncthreads();
}
DI void ph_gemm_mlstm_in(int wv, int jl) { PH_COMMON(jl);
    pg8::Gemm g{HN, Wj + W_WIN, D, D, nullptr, 0, 0}; pg8::SchedPlain S; S.init(T / 256, 3072 / 256, F.G, bx);
    pg8::EpiMlstmIn E{(bf16_t*)(R + R_Q), (bf16_t*)(R + R_K), (bf16_t*)(R + R_V), (bf16_t*)(R + R_O), (float*)(ws + WS_GATES), a->in[I_MLGB] + jl * 16};
    pg8::gemm_phase<pg8::EpiMlstmIn, pg8::SchedPlain, false>(F.lds, F.tid, g, S, E); }
DI void ph_gemm_resid(int wv, int jl, int which) { PH_COMMON(jl); asm volatile("" : "+s"(which));
    const int layer = 2 * jl + (which == 2 ? 1 : 0);
    pg8::SchedPlain S; S.init(T / 256, D / 256, F.G, bx);
    if (which != 1) {
        pg8::Gemm g{which == 0 ? (const bf16_t*)(R + R_HS) : (const bf16_t*)(R + R_XR), Wj + (which == 0 ? W_WOUT : W_LOUT), D, D, nullptr, 0, 0};
        pg8::EpiMix E{(bf16_t*)(R + R_M1), MOD + (size_t)layer * 16 * 6144 + 2048};
        pg8::gemm_phase<pg8::EpiMix, pg8::SchedPlain, false>(F.lds, F.tid, g, S, E);
    } else {
#define RESID_ARGS a->in[I_X], (bf16_t*)(R + R_XSB), MOD + (size_t)layer * 16 * 6144 + 5120, (const bf16_t*)(R + R_M1), (const float*)(ws + WS_CA1) + (size_t)jl * 16 * D, (bf16_t*)(ws + WS_HN), (float*)(ws + WS_GATES), F.lds
        if (DENSE_FP8_AT(jl)) { pg8::Gemm g{(const bf16_t*)(R + R_ACT), Wj + W_W2, DFF / 2, DFF / 2, nullptr, pg8::E8_W2, pg8::E8_ACT};
            if (jl == 0) { pg8::EpiResidT<false> E{RESID_ARGS}; pg8::gemm_phase<pg8::EpiResidT<false>, pg8::SchedPlain, false, true>(F.lds, F.tid, g, S, E); }
            else { pg8::EpiResidT<true> E{RESID_ARGS}; pg8::gemm_phase<pg8::EpiResidT<true>, pg8::SchedPlain, false, true>(F.lds, F.tid, g, S, E); } }
        else { pg8::Gemm g{(const bf16_t*)(R + R_ACT), Wj + W_W2, DFF, DFF, nullptr, 0, 0};
            if (jl == 0) { pg8::EpiResidT<false> E{RESID_ARGS}; pg8::gemm_phase<pg8::EpiResidT<false>, pg8::SchedPlain, false>(F.lds, F.tid, g, S, E); }
            else { pg8::EpiResidT<true> E{RESID_ARGS}; pg8::gemm_phase<pg8::EpiResidT<true>, pg8::SchedPlain, false>(F.lds, F.tid, g, S, E); } }
#undef RESID_ARGS
    }
}
DI void ph_gemm_ffn_up(int wv, int jl) { PH_COMMON(jl);
    pg8::SchedPlain S; S.init(T / 256, 2 * DFF / 256, F.G, bx);
    if (DENSE_FP8_AT(jl)) { pg8::EpiSwigluT<true> E{(unsigned char*)(R + R_ACT)}; pg8::Gemm g{HN, Wj + W_W13, D / 2, D / 2, nullptr, pg8::E8_W13, pg8::E8_HN}; pg8::gemm_phase<pg8::EpiSwigluT<true>, pg8::SchedPlain, false, true>(F.lds, F.tid, g, S, E); }
    else { pg8::EpiSwigluT<false> E{(unsigned char*)(R + R_ACT)}; pg8::Gemm g{HN, Wj + W_W13, D, D, nullptr, 0, 0}; pg8::gemm_phase<pg8::EpiSwigluT<false>, pg8::SchedPlain, false, false>(F.lds, F.tid, g, S, E); } }
DI void ph_gemm_lru_in(int wv, int jl) { PH_COMMON(jl);
    pg8::Gemm g{HN, Wj + W_LIN, D, D, nullptr, 0, 0}; pg8::SchedPlain S; S.init(T / 256, 2 * D / 256, F.G, bx);
    pg8::EpiLruIn E{(bf16_t*)(R + R_GB), (bf16_t*)(R + R_XC), (bf16_t*)(R + R_XR), a->in[I_LCW] + (size_t)jl * 4 * D, a->in[I_LCB] + (size_t)jl * D, F.lds,
                     (const float*)(ws + WS_GATES), (const float*)(ws + WS_BIASP) + (size_t)jl * 8 * 16 * 2048};
    pg8::gemm_phase<pg8::EpiLruIn, pg8::SchedPlain, false>(F.lds, F.tid, g, S, E); }
DI void ph_gemm_lru_gate(int wv, int jl) { PH_COMMON(jl);
    pg8::Gemm g{(const bf16_t*)(R + R_XC), Wj + W_GW, D, 256, nullptr, 0, 0}; pg8::SchedLruGate S; S.init(T / 256, 8, F.G, bx);
    pg8::EpiLruGate E{(const bf16_t*)(R + R_XC), (bf16_t*)(R + R_LA), (bf16_t*)(R + R_U), a->in[I_LGB] + (size_t)jl * 4 * 512, (const float*)(ws + WS_SP) + jl * D, (float*)(ws + WS_MODP)};
    pg8::gemm_phase<pg8::EpiLruGate, pg8::SchedLruGate, false>(F.lds, F.tid, g, S, E); }
DI void moe_sched(pg8::SchedMoe& S, unsigned char* ws, int& nti) { unsigned* META = (unsigned*)(ws + WS_CTL) + CW_META;
    nti = (int)__hip_atomic_load(META + 0, __ATOMIC_RELAXED, __HIP_MEMORY_SCOPE_AGENT);
    S.ts1 = (int)__hip_atomic_load(META + 2, __ATOMIC_RELAXED, __HIP_MEMORY_SCOPE_AGENT); S.ts2 = (int)__hip_atomic_load(META + 3, __ATOMIC_RELAXED, __HIP_MEMORY_SCOPE_AGENT);
    S.ts3 = (int)__hip_atomic_load(META + 4, __ATOMIC_RELAXED, __HIP_MEMORY_SCOPE_AGENT); S.ts4 = (int)__hip_atomic_load(META + 5, __ATOMIC_RELAXED, __HIP_MEMORY_SCOPE_AGENT);
    S.ts5 = (int)__hip_atomic_load(META + 6, __ATOMIC_RELAXED, __HIP_MEMORY_SCOPE_AGENT); S.ts6 = (int)__hip_atomic_load(META + 7, __ATOMIC_RELAXED, __HIP_MEMORY_SCOPE_AGENT);
    S.ts7 = (int)__hip_atomic_load(META + 8, __ATOMIC_RELAXED, __HIP_MEMORY_SCOPE_AGENT);
    nti = __builtin_amdgcn_readfirstlane(nti); S.ts1 = __builtin_amdgcn_readfirstlane(S.ts1); S.ts2 = __builtin_amdgcn_readfirstlane(S.ts2); S.ts3 = __builtin_amdgcn_readfirstlane(S.ts3);
    S.ts4 = __builtin_amdgcn_readfirstlane(S.ts4); S.ts5 = __builtin_amdgcn_readfirstlane(S.ts5); S.ts6 = __builtin_amdgcn_readfirstlane(S.ts6); S.ts7 = __builtin_amdgcn_readfirstlane(S.ts7); }
DI void ph_gemm_moe_up(int wv, int jl) { PH_COMMON(jl);
    pg8::SchedMoe S; int nti; moe_sched(S, ws, nti);
    pg8::Gemm g{HN, Wj + W_MW13, D / 2, D / 2, (const int*)(ws + WS_SLOTTOK), pg8::E8_W13, pg8::E8_HN}; S.init(nti, 2 * DFF / 256, F.G, bx); S.estride = (size_t)DFF * D;
    pg8::EpiSwiglu E{(unsigned char*)(R + R_ACT)};
    pg8::gemm_phase<pg8::EpiSwiglu, pg8::SchedMoe, true, true>(F.lds, F.tid, g, S, E); }
DI void ph_gemm_moe_down(int wv, int jl) { PH_COMMON(jl);
    pg8::SchedMoe S; int nti; moe_sched(S, ws, nti);
    pg8::Gemm g{(const bf16_t*)(R + R_ACT), Wj + W_MW2, DFF / 2, DFF / 2, nullptr, pg8::E8_W2, pg8::E8_ACT}; S.init(nti, D / 256, F.G, bx); S.estride = (size_t)D * DFF / 2;
    pg8::EpiBf16 E{(bf16_t*)(R + R_YS), D};
    pg8::gemm_phase<pg8::EpiBf16, pg8::SchedMoe, false, true>(F.lds, F.tid, g, S, E); }

constexpr int N_PHASES = 3 + 2 * 18;
#ifndef ONLY
#define ONLY -1
#endif
#define EN(k) (ONLY < 0 || ONLY == (k))
#ifndef DUP_MASK
#define DUP_MASK 0ull
#endif
#define DUP(k) (((DUP_MASK) >> (k)) & 1ull)
DI void seam() { XcdBarrier b; b.bar = (unsigned*)(kargs()->ws + WS_CTL) + CW_BAR; b.x = xb_xcc_id(); b.st = (volatile LAS unsigned*)((LAS unsigned char*)lds_raw + MISC_OFF) + 8; xcd_barrier(b); }
__global__ void __launch_bounds__(NTHR, 2) fwd(Args args) {
    { volatile LAS unsigned* MISC = (volatile LAS unsigned*)((LAS unsigned char*)lds_raw + MISC_OFF);
      if (threadIdx.x < 64) MISC[threadIdx.x] = 0u;
      __syncthreads();
      if (!MK_PER_PHASE) (void)xcd_barrier_post((unsigned*)(args.ws + WS_CTL) + CW_BAR, MISC + 8); }
    const int wv = __builtin_amdgcn_readfirstlane((int)threadIdx.x >> 6);
    const int lo = args.ph_lo, hi = args.ph_hi;
#define IN(k) (lo <= (k) && (k) < hi)
#define SEAM(k) do { if (IN(k) && IN((k) + 1)) seam(); } while (0)
    if (EN(100) && IN(0)) { ph_prologue_a(wv); if (DUP(20)) { __syncthreads(); ph_prologue_a(wv); } }
    SEAM(0);
    if (EN(102) && IN(2)) { row_pass<0, false>(wv, 0, 0, 0, 0, 0, 0); if (DUP(22)) row_pass<0, false>(wv, 0, 0, 0, 0, 0, 0); }
    SEAM(2);
#pragma nounroll
    for (int jl = 0; jl < 2; ++jl) {
        const int P = 3 + 18 * jl, LA_ = 2 * jl, LB_ = 2 * jl + 1;
        if (EN(0) && IN(P + 0)) { ph_mlstm_gates(wv, jl); ph_gemm_mlstm_in(wv, jl); if (DUP(0)) ph_gemm_mlstm_in(wv, jl); }
        SEAM(P + 0);
        if (EN(1) && IN(P + 1)) { if (blockIdx.x >= BATCH * ML_H) { ph_moe_convert(wv, jl); if (DUP(2)) ph_moe_convert(wv, jl); } else { ph_mlstm(wv, jl); if (DUP(1)) { __syncthreads(); ph_mlstm(wv, jl); } } }
        SEAM(P + 1);
        if (EN(2) && IN(P + 2)) ph_gemm_resid(wv, jl, 0);
        SEAM(P + 2);
        if (EN(3) && IN(P + 3)) { ph_lru_tables(wv, jl); if (jl == 0) row_pass<0, false>(wv, 0, LA_ * 2 + 1, LA_, 1, jl, 1); else row_pass<0, true>(wv, 1, LA_ * 2 + 1, LA_, 1, jl, 1); }
        SEAM(P + 3);
        if (EN(4) && IN(P + 4)) { ph_gemm_ffn_up(wv, jl); if (DUP(4)) ph_gemm_ffn_up(wv, jl); }
        SEAM(P + 4);
        if (EN(2) && IN(P + 5)) ph_gemm_resid(wv, jl, 1);
        SEAM(P + 5);
        if (EN(7) && IN(P + 7)) { ph_gemm_lru_in(wv, jl); if (DUP(7)) ph_gemm_lru_in(wv, jl); }
        SEAM(P + 7);
        if (EN(8) && IN(P + 8)) { ph_conv(wv, jl); if (DUP(8)) ph_conv(wv, jl); }
        SEAM(P + 8);
        if (EN(9) && IN(P + 9)) { ph_gemm_lru_gate(wv, jl); if (DUP(9)) ph_gemm_lru_gate(wv, jl); }
        SEAM(P + 9);
        if (EN(11) && IN(P + 11)) { ph_scan(wv); if (DUP(11)) ph_scan(wv); }
        SEAM(P + 11);
        if (EN(2) && IN(P + 12)) ph_gemm_resid(wv, jl, 2);
        SEAM(P + 12);
        if (EN(13) && IN(P + 13)) { row_pass<1, true>(wv, 1, LB_ * 2 + 1, LB_, 1, jl, 1); if (DUP(13)) { __syncthreads(); row_pass<1, true>(wv, 1, LB_ * 2 + 1, LB_, 1, jl, 1); } }
        SEAM(P + 13);
        if (EN(14) && IN(P + 14)) { ph_slots(wv); if (DUP(14)) { __syncthreads(); ph_slots(wv); } }
        SEAM(P + 14);
        if (EN(15) && IN(P + 15)) { ph_gemm_moe_up(wv, jl); if (DUP(15)) ph_gemm_moe_up(wv, jl); }
        SEAM(P + 15);
        if (EN(16) && IN(P + 16)) { ph_gemm_moe_down(wv, jl); if (DUP(16)) ph_gemm_moe_down(wv, jl); }
        SEAM(P + 16);
        if (EN(17) && IN(P + 17)) { if (jl == 0) row_pass<2, true>(wv, 1, (LB_ + 1) * 2 + 0, LB_ + 1, 0, jl, 1); else row_pass<3, true>(wv, 1, -1, LB_, 0, jl, 1); }
        SEAM(P + 17);
    }
#undef IN
#undef SEAM
}

extern "C" void kernel_launch(void* const* d_in, const int* in_sizes, int n_in, void* d_out, int out_size, void* d_ws, size_t ws_size, hipStream_t stream) {
    static int grid = 0;
    if (grid == 0) {
        if (n_in != N_IN || out_size != T * D || ws_size < WS_END) { fprintf(stderr, "kernel_launch: unexpected problem (n_in %d out %d ws %zu, need %zu)\n", n_in, out_size, ws_size, (size_t)WS_END); grid = -1; return; }
        int dev = 0, cus = 0, per_cu = 0;
        if (hipGetDevice(&dev) != hipSuccess || hipDeviceGetAttribute(&cus, hipDeviceAttributeMultiprocessorCount, dev) != hipSuccess) { grid = -1; return; }
        if (hipFuncSetAttribute((const void*)fwd, hipFuncAttributeMaxDynamicSharedMemorySize, LDS_BYTES) != hipSuccess) { fprintf(stderr, "kernel_launch: hipFuncSetAttribute failed\n"); grid = -1; return; }
        if (hipOccupancyMaxActiveBlocksPerMultiprocessor(&per_cu, (const void*)fwd, NTHR, LDS_BYTES) != hipSuccess || per_cu < 1) fprintf(stderr, "kernel_launch: occupancy query says %d\n", per_cu);
        (void)hipGetLastError();
        grid = cus;
    }
    if (grid < 0) return;
    (void)hipMemsetAsync((char*)d_ws + WS_CTL, 0, CTL_ZERO_BYTES, stream);
    Args a{};
    for (int i = 0; i < N_IN; ++i) a.in[i] = (const float*)d_in[i];
    a.out = (float*)d_out; a.ws = (unsigned char*)d_ws;
#if MK_PER_PHASE
    for (int p = 0; p < N_PHASES; ++p) { a.ph_lo = p; a.ph_hi = p + 1; hipLaunchKernelGGL(fwd, dim3(grid), dim3(NTHR), LDS_BYTES, stream, a); }
#else
    a.ph_lo = 0; a.ph_hi = N_PHASES; hipLaunchKernelGGL(fwd, dim3(grid), dim3(NTHR), LDS_BYTES, stream, a);
#endif
}
```
